# Optimizing an MI355X kernel written in HIP

```python
import jax, jax.numpy as jnp
from jax import lax
import numpy as np

D_MODEL = 1024
BATCH = 8
SEQ = 2048
DEPTH = 4

PLE_DIM = 256
RMS_EPS = 1e-6
LB_FLOOR = 1e-30
HG_HEADS = 4
HG_HEAD_DIM = 128
HG_WIDTH = HG_HEADS * HG_HEAD_DIM
HG_CHUNK = 64
M2_HEADS = 8
M2_HEAD_DIM = 64
M2_INNER = M2_HEADS * M2_HEAD_DIM
M2_GROUPS = 2
M2_STATE = 128
M2_CONV = 5
M2_CHUNK = 128
M2_XBC = M2_INNER + 2 * M2_GROUPS * M2_STATE
EVEN_IN_WIDTH = 5 * HG_WIDTH + M2_INNER + M2_XBC + 2 * M2_HEADS
EVEN_MIX_WIDTH = HG_WIDTH + M2_INNER
S5_GROUP_SIZE = 16
S5_GROUPS = D_MODEL // S5_GROUP_SIZE
S5_STATE = 64
S5_DT_MIN = 1e-3
S5_DT_MAX = 1e-1
D_FF = 3584
N_EXPERTS = 8
TOP_K = 2
MOE_BLOCK = 128

kernel_name = 'hybrid_hgrn2_ssd_s5_moe_encoder'

F32 = jnp.float32


def rmsnorm(x, w):
    xf = x.astype(F32)
    y = xf * lax.rsqrt(jnp.mean(xf * xf, axis=-1, keepdims=True) + RMS_EPS)
    return (y * w.astype(F32)).astype(x.dtype)


def _flip(t):
    return jnp.flip(t, axis=1)


def _masked_exp(mask, t):
    return jnp.where(mask, jnp.exp(jnp.where(mask, t, 0.0)), 0.0)


def _hgrn2_one_direction(q, k, v, logf):
    b, s, h, dk = q.shape
    dv = v.shape[-1]
    nc = s // HG_CHUNK

    def chunks(t):
        return t.reshape(b, nc, HG_CHUNK, h, t.shape[-1]).transpose(1, 0, 3, 2, 4)

    qc, kc, vc = chunks(q), chunks(k), chunks(v)
    bc = jnp.cumsum(chunks(logf), axis=3)
    mask = jnp.tril(jnp.ones((HG_CHUNK, HG_CHUNK), bool))[:, :, None]

    def step(state, inp):
        qi, ki, vi, bi = inp
        diff = bi[:, :, :, None, :] - bi[:, :, None, :, :]
        decay = _masked_exp(mask, diff)
        scores = jnp.einsum('bhtsd,bhsd->bhts', decay * qi[:, :, :, None, :], ki)
        o = (jnp.einsum('bhts,bhsv->bhtv', scores, vi)
             + jnp.einsum('bhtd,bhdv->bhtv', qi * jnp.exp(bi), state))
        b_end = bi[:, :, -1, :]
        k_dec = ki * jnp.exp(b_end[:, :, None, :] - bi)
        state = jnp.exp(b_end)[..., None] * state + jnp.einsum('bhsd,bhsv->bhdv', k_dec, vi)
        return state, o

    state0 = jnp.zeros((b, h, dk, dv), q.dtype)
    _, out = lax.scan(step, state0, (qc, kc, vc, bc))
    return out.transpose(1, 0, 3, 2, 4).reshape(b, s, h, dv)


def hgrn2_mixer(q_pre, ff_pre, fb_pre, i_pre, g_pre, lb, norm_w):
    b, s, _ = q_pre.shape
    shp = (b, s, HG_HEADS, HG_HEAD_DIM)
    q = jax.nn.silu(q_pre.astype(F32)).reshape(shp)
    v = i_pre.astype(F32).reshape(shp)
    lb = lb.astype(F32).reshape(HG_HEADS, HG_HEAD_DIM)
    log_lb, log_1m_lb = jnp.log(jnp.maximum(lb, LB_FLOOR)), jnp.log1p(-lb)

    def forget(f_pre):
        logf = jnp.logaddexp(log_lb, log_1m_lb + jax.nn.log_sigmoid(f_pre.astype(F32).reshape(shp)))
        return logf, -jnp.expm1(logf)

    logf_f, k_f = forget(ff_pre)
    logf_b, k_b = forget(fb_pre)
    o = (_hgrn2_one_direction(q, k_f, v, logf_f)
         + _flip(_hgrn2_one_direction(_flip(q), _flip(k_b), _flip(v), _flip(logf_b))))
    o = o * lax.rsqrt(jnp.mean(o * o, axis=-1, keepdims=True) + RMS_EPS)
    return o.reshape(b, s, HG_WIDTH) * norm_w.astype(F32) * jax.nn.sigmoid(g_pre.astype(F32))


def _centred_depthwise_conv(x, w, bias):
    ch, width = x.shape[-1], w.shape[0]
    y = lax.conv_general_dilated(x, w[:, None, :].astype(x.dtype), window_strides=(1,),
                                 padding=[(width // 2, width // 2)],
                                 dimension_numbers=('NWC', 'WIO', 'NWC'),
                                 feature_group_count=ch)
    return y + bias.astype(x.dtype)


def _ssd_one_direction(x, dt, a, bm, cm):
    b, s, h, p = x.shape
    g, n = bm.shape[2], bm.shape[3]
    hg, l = h // g, M2_CHUNK
    nc = s // l
    xc = x.reshape(b, nc, l, g, hg, p)
    dtc = dt.reshape(b, nc, l, g, hg)
    bc = bm.reshape(b, nc, l, g, n)
    cc = cm.reshape(b, nc, l, g, n)
    acum = jnp.cumsum(dtc * a.reshape(g, hg), axis=2)
    mask = jnp.tril(jnp.ones((l, l), bool))[:, :, None, None]
    seg = acum[:, :, :, None] - acum[:, :, None, :]
    decay = _masked_exp(mask, seg)
    cb = jnp.einsum('bclgn,bcsgn->bclsg', cc, bc)
    w = cb[..., None] * decay * dtc[:, :, None]
    y_diag = jnp.einsum('bclsgh,bcsghp->bclghp', w, xc)
    to_end = jnp.exp(acum[:, :, -1:] - acum) * dtc
    states = jnp.einsum('bclgn,bclghp->bcghpn', bc, to_end[..., None] * xc)
    chunk_decay = jnp.exp(acum[:, :, -1])

    def step(hstate, inp):
        st, dc = inp
        return dc[..., None, None] * hstate + st, hstate

    h0 = jnp.zeros((b, g, hg, p, n), x.dtype)
    _, prev = lax.scan(step, h0, (jnp.moveaxis(states, 1, 0), jnp.moveaxis(chunk_decay, 1, 0)))
    prev = jnp.moveaxis(prev, 0, 1)
    y_off = jnp.einsum('bclgn,bcghpn->bclghp', cc, prev) * jnp.exp(acum)[..., None]
    return (y_diag + y_off).reshape(b, s, h, p)


def mamba2_mixer(z, xbc, dt_raw, conv_w, conv_b, dt_bias, a_log, d_skip, norm_w):
    b, s, _ = z.shape
    xbc = jax.nn.silu(_centred_depthwise_conv(xbc, conv_w, conv_b)).astype(F32)
    nb = M2_GROUPS * M2_STATE
    xs = xbc[..., :M2_INNER].reshape(b, s, M2_HEADS, M2_HEAD_DIM)
    bm = xbc[..., M2_INNER:M2_INNER + nb].reshape(b, s, M2_GROUPS, M2_STATE)
    cm = xbc[..., M2_INNER + nb:].reshape(b, s, M2_GROUPS, M2_STATE)
    dt = jax.nn.softplus(dt_raw.astype(F32).reshape(b, s, 2, M2_HEADS) + dt_bias.astype(F32))
    a = -jnp.exp(a_log.astype(F32))
    y = (_ssd_one_direction(xs, dt[:, :, 0], a[0], bm, cm)
         + _flip(_ssd_one_direction(_flip(xs), _flip(dt[:, :, 1]), a[1], _flip(bm), _flip(cm)))
         + d_skip.astype(F32)[:, None] * xs)
    y = y.reshape(b, s, M2_INNER) * jax.nn.silu(z.astype(F32))
    yg = y.reshape(b, s, M2_GROUPS, M2_INNER // M2_GROUPS)
    yg = yg * lax.rsqrt(jnp.mean(yg * yg, axis=-1, keepdims=True) + RMS_EPS)
    return yg.reshape(b, s, M2_INNER) * norm_w.astype(F32)


def even_mixer(hn, w_in, w_out, lb, hg_norm_w, conv_w, conv_b, dt_bias, a_log, d_skip, m2_norm_w):
    proj = hn @ w_in
    sizes = [HG_WIDTH] * 5 + [M2_INNER, M2_XBC, 2 * M2_HEADS]
    q, ff, fb, i, g, z, xbc, dt_raw = jnp.split(proj, list(np.cumsum(sizes)[:-1]), axis=-1)
    o_a = hgrn2_mixer(q, ff, fb, i, g, lb, hg_norm_w)
    o_b = mamba2_mixer(z, xbc, dt_raw, conv_w, conv_b, dt_bias, a_log, d_skip, m2_norm_w)
    return jnp.concatenate([o_a, o_b], axis=-1).astype(hn.dtype) @ w_out


def _complex_affine_combine(left, right):
    a1r, a1i, b1r, b1i = left
    a2r, a2i, b2r, b2i = right
    return (a2r * a1r - a2i * a1i, a2r * a1i + a2i * a1r,
            a2r * b1r - a2i * b1i + b2r, a2r * b1i + a2i * b1r + b2i)


def _s5_one_direction(ug, a_re, a_im, log_step, b_re, b_im, c_re, c_im):
    delta = jnp.exp(log_step)[:, None]
    mag = jnp.exp(a_re * delta)
    lam_re, lam_im = mag * jnp.cos(a_im * delta), mag * jnp.sin(a_im * delta)
    den = a_re * a_re + a_im * a_im
    num_re = lam_re - 1.0
    coef_re = (num_re * a_re + lam_im * a_im) / den
    coef_im = (lam_im * a_re - num_re * a_im) / den
    bb_re = coef_re[..., None] * b_re - coef_im[..., None] * b_im
    bb_im = coef_re[..., None] * b_im + coef_im[..., None] * b_re
    bu_re = jnp.einsum('bsgc,gnc->bsgn', ug, bb_re)
    bu_im = jnp.einsum('bsgc,gnc->bsgn', ug, bb_im)
    s = ug.shape[1]
    lam_re_s = jnp.broadcast_to(lam_re, (s,) + lam_re.shape)
    lam_im_s = jnp.broadcast_to(lam_im, (s,) + lam_im.shape)

    def scan_seq(br, bi):
        _, _, hr, hi = lax.associative_scan(_complex_affine_combine, (lam_re_s, lam_im_s, br, bi), axis=0)
        return hr, hi

    h_re, h_im = jax.vmap(scan_seq)(bu_re, bu_im)
    return jnp.einsum('bsgn,gcn->bsgc', h_re, c_re) - jnp.einsum('bsgn,gcn->bsgc', h_im, c_im)


def s5_mixer(hn, a_re, a_im, log_step, b_re, b_im, c_re, c_im, d_skip, glu_w):
    b, s, d = hn.shape
    hf = hn.astype(F32)
    u = hf.reshape(b, s, S5_GROUPS, S5_GROUP_SIZE)
    a_re, a_im, log_step = a_re.astype(F32), a_im.astype(F32), log_step.astype(F32)
    b_re, b_im, c_re, c_im = b_re.astype(F32), b_im.astype(F32), c_re.astype(F32), c_im.astype(F32)
    y = (_s5_one_direction(u, a_re[0], a_im[0], log_step[0], b_re, b_im, c_re[0], c_im[0])
         + _flip(_s5_one_direction(_flip(u), a_re[1], a_im[1], log_step[1], b_re, b_im, c_re[1], c_im[1])))
    y = y.reshape(b, s, d) + d_skip.astype(F32) * hf
    out, gate = jnp.split(jax.nn.gelu(y).astype(hn.dtype) @ glu_w, 2, axis=-1)
    return out * jax.nn.sigmoid(gate)


def swiglu(h, w_gu, w_down):
    g, u = jnp.split(h @ w_gu, 2, axis=-1)
    return (jax.nn.silu(g) * u) @ w_down


def moe_swiglu(h, w_router, w_gu, w_down):
    b, s, d = h.shape
    t = b * s
    xt = h.reshape(t, d)
    logits = (xt @ w_router).astype(F32)
    top_logit, top_e = lax.top_k(logits, TOP_K)
    gates = jax.nn.softmax(top_logit, axis=-1).astype(h.dtype)
    n_assign = t * TOP_K
    flat_e = top_e.reshape(-1)
    flat_tok = jnp.repeat(jnp.arange(t, dtype=jnp.int32), TOP_K)
    flat_w = gates.reshape(-1)
    order = jnp.argsort(flat_e)
    se, stok, sw = flat_e[order], flat_tok[order], flat_w[order]
    counts = jnp.bincount(flat_e, length=N_EXPERTS)
    start = jnp.cumsum(counts) - counts
    padded = (counts + MOE_BLOCK - 1) // MOE_BLOCK * MOE_BLOCK
    pend = jnp.cumsum(padded)
    pstart = pend - padded
    dest = pstart[se] + jnp.arange(n_assign, dtype=jnp.int32) - start[se]
    n_rows = (-(-n_assign // MOE_BLOCK) + N_EXPERTS) * MOE_BLOCK
    n_blocks = n_rows // MOE_BLOCK
    x_buf = jnp.zeros((n_rows, d), h.dtype).at[dest].set(xt[stok])
    w_buf = jnp.zeros((n_rows,), h.dtype).at[dest].set(sw)
    tok_buf = jnp.zeros((n_rows,), jnp.int32).at[dest].set(stok)
    blk_e = jnp.minimum(jnp.searchsorted(pend, jnp.arange(n_blocks, dtype=jnp.int32) * MOE_BLOCK, side='right'),
                        N_EXPERTS - 1)

    def expert_block(args):
        xb, e = args
        return swiglu(xb, w_gu[e], w_down[e])

    y_buf = lax.map(expert_block, (x_buf.reshape(n_blocks, MOE_BLOCK, d), blk_e)).reshape(n_rows, d)
    out = jnp.zeros((t, d), h.dtype).at[tok_buf].add(y_buf * w_buf[:, None])
    return out.reshape(b, s, d)


def setup_inputs(seed: int = 0) -> dict:
    key = jax.random.key(seed)
    ks = iter(jax.random.split(key, 48))
    n_even, n_odd = (DEPTH + 1) // 2, DEPTH // 2

    def nrm(shape, scale):
        return scale * jax.random.normal(next(ks), shape, F32)

    def gain(shape):
        return 1.0 + 0.02 * jax.random.normal(next(ks), shape, F32)

    def unif(shape, lo, hi):
        return jax.random.uniform(next(ks), shape, F32, lo, hi)

    dt0 = jnp.exp(unif((n_even, 2, M2_HEADS), float(np.log(1e-3)), float(np.log(1e-1))))
    s5_a_re = -0.5 * jnp.exp(nrm((n_odd, 2, S5_GROUPS, S5_STATE), 0.02))
    s5_a_im = jnp.pi * jnp.arange(S5_STATE, dtype=F32) + nrm((n_odd, 2, S5_GROUPS, S5_STATE), 0.02)
    return {
        'x': nrm((BATCH, SEQ, D_MODEL), 1.0),
        'p': nrm((DEPTH, BATCH, SEQ, PLE_DIM), 1.0),
        'norm_mix': gain((DEPTH, D_MODEL)),
        'norm_ffn': gain((DEPTH, D_MODEL)),
        'norm_ple': gain((DEPTH, D_MODEL)),
        'final_norm': gain((D_MODEL,)),
        'ple_gate': nrm((DEPTH, D_MODEL, D_MODEL), D_MODEL ** -0.5),
        'ple_proj': nrm((DEPTH, PLE_DIM, D_MODEL), PLE_DIM ** -0.5),
        'ev_w_in': nrm((n_even, D_MODEL, EVEN_IN_WIDTH), D_MODEL ** -0.5),
        'ev_w_out': nrm((n_even, EVEN_MIX_WIDTH, D_MODEL), EVEN_MIX_WIDTH ** -0.5),
        'hg_lb_logits': 1.0 + nrm((n_even, HG_WIDTH), 0.1),
        'hg_norm_w': gain((n_even, HG_WIDTH)),
        'm2_conv_w': nrm((n_even, M2_CONV, M2_XBC), M2_CONV ** -0.5),
        'm2_conv_b': nrm((n_even, M2_XBC), 0.01),
        'm2_dt_bias': dt0 + jnp.log(-jnp.expm1(-dt0)),
        'm2_a_log': jnp.log(unif((n_even, 2, M2_HEADS), 1.0, 16.0)),
        'm2_d': gain((n_even, M2_HEADS)),
        'm2_norm_w': gain((n_even, M2_INNER)),
        's5_a_re': s5_a_re,
        's5_a_im': s5_a_im,
        's5_log_step': unif((n_odd, 2, S5_GROUPS), float(np.log(S5_DT_MIN)), float(np.log(S5_DT_MAX))),
        's5_b_re': nrm((n_odd, S5_GROUPS, S5_STATE, S5_GROUP_SIZE), (2 * S5_GROUP_SIZE) ** -0.5),
        's5_b_im': nrm((n_odd, S5_GROUPS, S5_STATE, S5_GROUP_SIZE), (2 * S5_GROUP_SIZE) ** -0.5),
        's5_c_re': nrm((n_odd, 2, S5_GROUPS, S5_GROUP_SIZE, S5_STATE), (2 * S5_STATE) ** -0.5),
        's5_c_im': nrm((n_odd, 2, S5_GROUPS, S5_GROUP_SIZE, S5_STATE), (2 * S5_STATE) ** -0.5),
        's5_d': nrm((n_odd, D_MODEL), 1.0),
        's5_glu_w': nrm((n_odd, D_MODEL, 2 * D_MODEL), D_MODEL ** -0.5),
        'ffn_w_gu': nrm((n_even, D_MODEL, 2 * D_FF), D_MODEL ** -0.5),
        'ffn_w_down': nrm((n_even, D_FF, D_MODEL), D_FF ** -0.5),
        'moe_router': nrm((n_odd, D_MODEL, N_EXPERTS), D_MODEL ** -0.5),
        'moe_w_gu': nrm((n_odd, N_EXPERTS, D_MODEL, 2 * D_FF), D_MODEL ** -0.5),
        'moe_w_down': nrm((n_odd, N_EXPERTS, D_FF, D_MODEL), D_FF ** -0.5),
    }


def reference(x, p, norm_mix, norm_ffn, norm_ple, final_norm, ple_gate, ple_proj, ev_w_in, ev_w_out,
              hg_lb_logits, hg_norm_w, m2_conv_w, m2_conv_b, m2_dt_bias, m2_a_log, m2_d, m2_norm_w,
              s5_a_re, s5_a_im, s5_log_step, s5_b_re, s5_b_im, s5_c_re, s5_c_im, s5_d, s5_glu_w,
              ffn_w_gu, ffn_w_down, moe_router, moe_w_gu, moe_w_down):
    lb_soft = jax.nn.softmax(hg_lb_logits.astype(F32), axis=0)
    hg_lb = jnp.cumsum(lb_soft, axis=0) - lb_soft[0]
    h = x
    for layer in range(DEPTH):
        j = layer // 2
        hn = rmsnorm(h, norm_mix[layer])
        if layer % 2 == 0:
            h = h + even_mixer(hn, ev_w_in[j], ev_w_out[j], hg_lb[j], hg_norm_w[j], m2_conv_w[j], m2_conv_b[j],
                               m2_dt_bias[j], m2_a_log[j], m2_d[j], m2_norm_w[j])
            h = h + swiglu(rmsnorm(h, norm_ffn[layer]), ffn_w_gu[j], ffn_w_down[j])
        else:
            h = h + s5_mixer(hn, s5_a_re[j], s5_a_im[j], s5_log_step[j], s5_b_re[j], s5_b_im[j],
                             s5_c_re[j], s5_c_im[j], s5_d[j], s5_glu_w[j])
            h = h + moe_swiglu(rmsnorm(h, norm_ffn[layer]), moe_router[j], moe_w_gu[j], moe_w_down[j])
        gate = jax.nn.sigmoid(rmsnorm(h, norm_ple[layer]) @ ple_gate[layer])
        h = h + gate * (p[layer] @ ple_proj[layer])
    return rmsnorm(h, final_norm)
```

```cpp
#include <hip/hip_runtime.h>
#include <cstdio>
#include <cstdint>

namespace pg8 {
#define PG8_LAS __attribute__((address_space(3)))
typedef unsigned short bf16_t;
typedef short bf16x8 __attribute__((ext_vector_type(8)));
typedef float f32x4 __attribute__((ext_vector_type(4)));
typedef float f32x2 __attribute__((ext_vector_type(2)));
typedef unsigned u32x4 __attribute__((ext_vector_type(4)));
typedef unsigned u32x2 __attribute__((ext_vector_type(2)));
constexpr int BM = 256, BK = 64, HALF = 128, HTB = HALF * BK * 2  , STAGE_BYTES = 8 * HTB, NXCD = 8, WGM = 8;

__host__ __device__ __forceinline__ int lds_byte(int r, int c) { const int st = (r >> 4) * 2 + (c >> 5), rr = r & 15, cc = c & 31, ob = rr * 64 + cc * 2; return st * 1024 + (ob ^ (((ob >> 9) & 1) << 5)); }
__host__ __device__ __forceinline__ void stage_rc(int b, int& R, int& C) { const int st = b / 1024, sb = b % 1024, swz = sb ^ (((sb >> 9) & 1) << 5); R = (st >> 1) * 16 + swz / 64; C = (st & 1) * 32 + (swz % 64) / 2; }
__host__ __device__ __forceinline__ int perm32(int rho) { const int n = rho >> 4, i = rho & 15; return 8 * (i >> 2) + 4 * n + (i & 3); }

struct Unit { int pm, pn; const char* A; const char* B; };

struct StaticOrder {
    int nM, nN, nwg, G, c; const char* A; const char* Bt; size_t tstep;
    __device__ void init(const bf16_t* A_, const bf16_t* Bt_, int M, int N, int K, int G_, int c_) { nM = M / BM; nN = N / BM; nwg = nM * nN; G = G_; c = c_; A = (const char*)A_; Bt = (const char*)Bt_; tstep = (size_t)BM * K * 2; }
    __device__ bool next(int i, Unit& u) const {
        const long L = (long)i * G + c; if (L >= nwg) return false;
        int wgid = (int)L; { const int q = nwg / NXCD, r = nwg % NXCD, xcd = wgid % NXCD, off = wgid / NXCD; wgid = (xcd < r ? xcd * (q + 1) : r * (q + 1) + (xcd - r) * q) + off; }
        const int nig = WGM * nN, gid = wgid / nig, fm = gid * WGM, gsz = (nM - fm) < WGM ? (nM - fm) : WGM;
        u.pm = fm + ((wgid % nig) % gsz); u.pn = (wgid % nig) / gsz; u.A = A + (size_t)u.pm * tstep; u.B = Bt + (size_t)u.pn * tstep; return true;
    }
    __device__ __forceinline__ void a_ready(const Unit&) const {}
    __device__ __forceinline__ void done(const Unit&) const {}
};
struct MoeOrder {
    int nM, nN, nwg, G, c; const char* A; const char* Bt; size_t tstep, estride; int s1, s2, s3, s4, s5, s6, s7;
    __device__ void init(const bf16_t* A_, const bf16_t* Bt_, const int* seg, int N, int K, int G_, int c_) { nM = __builtin_amdgcn_readfirstlane(seg[8]) / BM; nN = N / BM; nwg = nM * nN; G = G_; c = c_; A = (const char*)A_; Bt = (const char*)Bt_; tstep = (size_t)BM * K * 2; estride = (size_t)N * K * 2;
        s1 = __builtin_amdgcn_readfirstlane(seg[1]); s2 = __builtin_amdgcn_readfirstlane(seg[2]); s3 = __builtin_amdgcn_readfirstlane(seg[3]); s4 = __builtin_amdgcn_readfirstlane(seg[4]);
        s5 = __builtin_amdgcn_readfirstlane(seg[5]); s6 = __builtin_amdgcn_readfirstlane(seg[6]); s7 = __builtin_amdgcn_readfirstlane(seg[7]); }
    __device__ bool next(int i, Unit& u) const {
        const long L = (long)i * G + c; if (L >= nwg) return false;
        int wgid = (int)L; { const int q = nwg / NXCD, r = nwg % NXCD, xcd = wgid % NXCD, off = wgid / NXCD; wgid = (xcd < r ? xcd * (q + 1) : r * (q + 1) + (xcd - r) * q) + off; }
        const int nig = WGM * nN, gid = wgid / nig, fm = gid * WGM, gsz = (nM - fm) < WGM ? (nM - fm) : WGM;
        u.pm = fm + ((wgid % nig) % gsz); u.pn = (wgid % nig) / gsz;
        const int r0 = u.pm * BM; const int e = (r0 >= s1) + (r0 >= s2) + (r0 >= s3) + (r0 >= s4) + (r0 >= s5) + (r0 >= s6) + (r0 >= s7);
        u.A = A + (size_t)u.pm * tstep; u.B = Bt + (size_t)e * estride + (size_t)u.pn * tstep; return true;
    }
    __device__ __forceinline__ void a_ready(const Unit&) const {}
    __device__ __forceinline__ void done(const Unit&) const {}
};

struct StackOrder {
    int nM, nN, nwg, G, c, tpl; const char* A; const char* Bt; size_t tstep, lstride;
    __device__ void init(const bf16_t* A_, const bf16_t* Bt_, int M, int N, int K, int log2TilesPerL, int G_, int c_) { nM = M / BM; nN = N / BM; nwg = nM * nN; G = G_; c = c_; tpl = log2TilesPerL; A = (const char*)A_; Bt = (const char*)Bt_; tstep = (size_t)BM * K * 2; lstride = (size_t)N * K * 2; }
    __device__ bool next(int i, Unit& u) const {
        const long L = (long)i * G + c; if (L >= nwg) return false;
        int wgid = (int)L; { const int q = nwg / NXCD, r = nwg % NXCD, xcd = wgid % NXCD, off = wgid / NXCD; wgid = (xcd < r ? xcd * (q + 1) : r * (q + 1) + (xcd - r) * q) + off; }
        const int nig = WGM * nN, gid = wgid / nig, fm = gid * WGM, gsz = (nM - fm) < WGM ? (nM - fm) : WGM;
        u.pm = fm + ((wgid % nig) % gsz); u.pn = (wgid % nig) / gsz;
        u.A = A + (size_t)u.pm * tstep; u.B = Bt + (size_t)(u.pm >> tpl) * lstride + (size_t)u.pn * tstep; return true;
    }
    __device__ __forceinline__ void a_ready(const Unit&) const {}
    __device__ __forceinline__ void done(const Unit&) const {}
};

__device__ __forceinline__ unsigned cvt_pk_bf16(float lo, float hi) { unsigned r; asm volatile("v_cvt_pk_bf16_f32 %0, %1, %2" : "=v"(r) : "v"(lo), "v"(hi)); return r; }
__device__ __forceinline__ float sigmoid_f(float x) { return 1.0f / (1.0f + __expf(-x)); }

struct EpiBf16 {
    static constexpr bool PERM = true, AFTER_DRAIN = false;
    bf16_t* O; int ldc;
    __device__ __forceinline__ void operator()(const f32x4 (&acc)[2][2][4][2], const Unit& u, int wr, int wc, int fr, int fq) const {
        const int row0 = u.pm * BM + wr * 64 + fr, col0 = u.pn * BM + wc * 32 + 8 * fq;
#pragma unroll
        for (int ai = 0; ai < 2; ++ai)
#pragma unroll
            for (int m = 0; m < 4; ++m) { bf16_t* rowp = O + (size_t)(row0 + ai * HALF + m * 16) * ldc + col0;
#pragma unroll
                for (int bj = 0; bj < 2; ++bj) { const f32x4 v0 = acc[ai][bj][m][0], v1 = acc[ai][bj][m][1];
                    u32x4 w; w.x = cvt_pk_bf16(v0[0], v0[1]); w.y = cvt_pk_bf16(v0[2], v0[3]); w.z = cvt_pk_bf16(v1[0], v1[1]); w.w = cvt_pk_bf16(v1[2], v1[3]);
                    *(u32x4*)(rowp + bj * HALF) = w; } }
    }
};
struct EpiSwiGLU {
    static constexpr bool PERM = true, AFTER_DRAIN = false;
    bf16_t* O; int ldc;
    __device__ __forceinline__ void operator()(const f32x4 (&acc)[2][2][4][2], const Unit& u, int wr, int wc, int fr, int fq) const {
        const int row0 = u.pm * BM + wr * 64 + fr, col0 = u.pn * HALF + wc * 32 + 8 * fq;
#pragma unroll
        for (int ai = 0; ai < 2; ++ai)
#pragma unroll
            for (int m = 0; m < 4; ++m) { bf16_t* rowp = O + (size_t)(row0 + ai * HALF + m * 16) * ldc + col0;
                f32x4 v[2];
#pragma unroll
                for (int n = 0; n < 2; ++n) { const f32x4 g = acc[ai][0][m][n], uu = acc[ai][1][m][n];
#pragma unroll
                    for (int j = 0; j < 4; ++j) v[n][j] = g[j] * sigmoid_f(g[j]) * uu[j]; }
                u32x4 w; w.x = cvt_pk_bf16(v[0][0], v[0][1]); w.y = cvt_pk_bf16(v[0][2], v[0][3]); w.z = cvt_pk_bf16(v[1][0], v[1][1]); w.w = cvt_pk_bf16(v[1][2], v[1][3]);
                *(u32x4*)rowp = w; }
    }
};
struct EpiResF32 {
    static constexpr bool PERM = false, AFTER_DRAIN = false;
    float* C; const float* res; int ldc;
    __device__ __forceinline__ void operator()(const f32x4 (&acc)[2][2][4][2], const Unit& u, int wr, int wc, int fr, int fq) const {
        const int row0 = u.pm * BM + wr * 64 + fr, col0 = u.pn * BM + wc * 32 + 4 * fq;
#pragma unroll
        for (int ai = 0; ai < 2; ++ai)
#pragma unroll
            for (int m = 0; m < 4; ++m) { const size_t off = (size_t)(row0 + ai * HALF + m * 16) * ldc + col0;
#pragma unroll
                for (int bj = 0; bj < 2; ++bj)
#pragma unroll
                    for (int n = 0; n < 2; ++n) { f32x4 o = acc[ai][bj][m][n]; if (res) o += *(const f32x4*)(res + off + bj * HALF + n * 16); *(f32x4*)(C + off + bj * HALF + n * 16) = o; }
                asm volatile("" ::: "memory"); }
    }
};
struct EpiGluRes {
    static constexpr bool PERM = false, AFTER_DRAIN = false;
    float* C; int ldc; float scl;
    __device__ __forceinline__ void operator()(const f32x4 (&acc)[2][2][4][2], const Unit& u, int wr, int wc, int fr, int fq) const {
        const int row0 = u.pm * BM + wr * 64 + fr, col0 = u.pn * HALF + wc * 32 + 4 * fq;
#pragma unroll
        for (int ai = 0; ai < 2; ++ai)
#pragma unroll
            for (int m = 0; m < 4; ++m) { float* rowp = C + (size_t)(row0 + ai * HALF + m * 16) * ldc + col0;
#pragma unroll
                for (int n = 0; n < 2; ++n) { const f32x4 o = acc[ai][0][m][n], g = acc[ai][1][m][n]; f32x4 h = *(const f32x4*)(rowp + n * 16);
#pragma unroll
                    for (int j = 0; j < 4; ++j) h[j] += o[j] * sigmoid_f(g[j]) * scl;
                    *(f32x4*)(rowp + n * 16) = h; }
                asm volatile("" ::: "memory"); }
    }
};
struct EpiPle {
    static constexpr bool PERM = false, AFTER_DRAIN = false;
    float* C; const bf16_t* P; int ldc; float scl;
    __device__ __forceinline__ void operator()(const f32x4 (&acc)[2][2][4][2], const Unit& u, int wr, int wc, int fr, int fq) const {
        const int row0 = u.pm * BM + wr * 64 + fr, col0 = u.pn * BM + wc * 32 + 4 * fq;
#pragma unroll
        for (int ai = 0; ai < 2; ++ai)
#pragma unroll
            for (int m = 0; m < 4; ++m) { const size_t off = (size_t)(row0 + ai * HALF + m * 16) * ldc + col0;
#pragma unroll
                for (int bj = 0; bj < 2; ++bj)
#pragma unroll
                    for (int n = 0; n < 2; ++n) { const f32x4 a = acc[ai][bj][m][n]; const u32x2 pw = *(const u32x2*)(P + off + bj * HALF + n * 16); f32x4 h = *(const f32x4*)(C + off + bj * HALF + n * 16);
                        h[0] += sigmoid_f(a[0]) * __uint_as_float(pw.x << 16) * scl; h[1] += sigmoid_f(a[1]) * __uint_as_float(pw.x & 0xffff0000u) * scl;
                        h[2] += sigmoid_f(a[2]) * __uint_as_float(pw.y << 16) * scl; h[3] += sigmoid_f(a[3]) * __uint_as_float(pw.y & 0xffff0000u) * scl;
                        *(f32x4*)(C + off + bj * HALF + n * 16) = h; }
                asm volatile("" ::: "memory"); }
    }
};

template <class Epi, class Sched, bool ALIGN_EPI = false, bool SP2 = false>
__device__ __forceinline__ void gemm_phase(PG8_LAS unsigned char* lds, const int K, const Sched& S, const Epi& E, const int wave_s  ) {
    int tid_ = wave_s * 64 + (int)__builtin_amdgcn_mbcnt_hi(~0u, __builtin_amdgcn_mbcnt_lo(~0u, 0u)); asm volatile("" : "+v"(tid_));
    const int tid = tid_, wid = wave_s, lane = tid & 63, wr = wid >> 2, wc = wid & 3, fr = lane & 15, fq = lane >> 4;
    const int nt = K / BK;
    unsigned voffA[2], voffB[2];
#pragma unroll
    for (int i = 0; i < 2; ++i) { int R, C; stage_rc(tid * 16 + i * 8192, R, C); const int Rb = Epi::PERM ? ((R & ~31) + perm32(R & 31)) : R;
        voffA[i] = (unsigned)(R * K + C) * 2u; voffB[i] = (unsigned)(Rb * K + C) * 2u; }
    const size_t kstep = (size_t)(BK * 2);
    const size_t hstep = (size_t)HALF * K * 2;
    const unsigned ldsw = (unsigned)wid * 1024u;
    const int aoff = lds_byte(wr * 64 + fr, fq * 8), boff = lds_byte(wc * 32 + fr, fq * 8);
#define PG8_SA(b, h) (((b) * 2 + (h)) * HTB)
#define PG8_SB(b, h) ((4 + (b) * 2 + (h)) * HTB)
#define PG8_STAGE(bufoff, gbase, voff) do { _Pragma("unroll") for (int _i = 0; _i < 2; ++_i) \
        __builtin_amdgcn_global_load_lds((const unsigned*)((const char*)(gbase) + (voff)[_i]), (PG8_LAS unsigned*)(lds + (bufoff) + ldsw + _i * 8192), 16, 0, 0); } while (0)
#define PG8_LDA(dst, b, h) do { _Pragma("unroll") for (int m = 0; m < 4; ++m) _Pragma("unroll") for (int k = 0; k < 2; ++k) dst[m][k] = *(const PG8_LAS bf16x8*)(lds + PG8_SA(b, h) + aoff + m * 2048 + k * 1024); } while (0)
#define PG8_LDB(dst, b, h) do { _Pragma("unroll") for (int n = 0; n < 2; ++n) _Pragma("unroll") for (int k = 0; k < 2; ++k) dst[n][k] = *(const PG8_LAS bf16x8*)(lds + PG8_SB(b, h) + boff + n * 2048 + k * 1024); } while (0)
#define PG8_MMA(ai, bj, At, Bt) do { __builtin_amdgcn_s_setprio(1); _Pragma("unroll") for (int m = 0; m < 4; ++m) _Pragma("unroll") for (int n = 0; n < 2; ++n) _Pragma("unroll") for (int k = 0; k < 2; ++k) \
        acc[ai][bj][m][n] = __builtin_amdgcn_mfma_f32_16x16x32_bf16(Bt[n][k], At[m][k], acc[ai][bj][m][n], 0, 0, 0); __builtin_amdgcn_s_setprio(0); } while (0)
#define PG8_WAIT_V(n) asm volatile("s_waitcnt vmcnt(" #n ")" ::: "memory")
#define PG8_WAIT_L(n) asm volatile("s_waitcnt lgkmcnt(" #n ")" ::: "memory")
#define PG8_BAR __builtin_amdgcn_s_barrier()
#define PG8_SCHED __builtin_amdgcn_sched_barrier(0)
    Unit cur, nxt; int ui = 0;
    if (!S.next(0, cur)) return;
    f32x4 acc[2][2][4][2];
#pragma unroll
    for (int a = 0; a < 2; ++a)
#pragma unroll
        for (int b = 0; b < 2; ++b)
#pragma unroll
            for (int m = 0; m < 4; ++m)
#pragma unroll
                for (int n = 0; n < 2; ++n) acc[a][b][m][n] = (f32x4){0.f, 0.f, 0.f, 0.f};
    bf16x8 At[4][2], B0[2][2], B1[2][2];
    const char* cA = cur.A; const char* cB = cur.B;
    S.a_ready(cur);
    if constexpr (SP2) {
        PG8_STAGE(PG8_SB(0, 0), cB, voffB); PG8_STAGE(PG8_SB(0, 1), cB + hstep, voffB); PG8_STAGE(PG8_SA(0, 0), cA, voffA); PG8_STAGE(PG8_SA(0, 1), cA + hstep, voffA);
        if (wr == 1) PG8_BAR;
        PG8_WAIT_V(2); PG8_BAR;
        PG8_STAGE(PG8_SB(1, 0), cB + kstep, voffB); PG8_STAGE(PG8_SA(1, 0), cA + kstep, voffA); PG8_STAGE(PG8_SB(1, 1), cB + hstep + kstep, voffB);
        PG8_WAIT_V(6); PG8_BAR;
    } else {
        PG8_STAGE(PG8_SB(0, 0), cB, voffB); PG8_STAGE(PG8_SA(0, 0), cA, voffA); PG8_STAGE(PG8_SB(0, 1), cB + hstep, voffB); PG8_STAGE(PG8_SA(0, 1), cA + hstep, voffA);
        if (wr == 1) PG8_BAR;
        PG8_WAIT_V(4); PG8_BAR;
        PG8_STAGE(PG8_SB(1, 0), cB + kstep, voffB); PG8_STAGE(PG8_SA(1, 0), cA + kstep, voffA); PG8_STAGE(PG8_SB(1, 1), cB + hstep + kstep, voffB);
        PG8_WAIT_V(6); PG8_BAR;
    }
    for (;;) {
        const bool has_next = S.next(ui + 1, nxt);
        const char* nA = has_next ? nxt.A : cA; const char* nB = has_next ? nxt.B : cB;
        for (int t = 0; t < nt; t += 2) {
            const bool last = (t == nt - 2);
            const char* a1 = cA + (size_t)(t + 1) * kstep;
            const char* a2 = last ? nA : cA + (size_t)(t + 2) * kstep; const char* b2 = last ? nB : cB + (size_t)(t + 2) * kstep;
            const char* a3 = a2 + kstep; const char* b3 = b2 + kstep;
            if (last && has_next) S.a_ready(nxt);
            if constexpr (SP2) {
            PG8_LDB(B0, 0, 0); PG8_LDB(B1, 0, 1); PG8_SCHED; PG8_LDA(At, 0, 0); PG8_STAGE(PG8_SA(1, 1), a1 + hstep, voffA);
            PG8_WAIT_V(8); PG8_WAIT_L(0); PG8_BAR; PG8_MMA(0, 0, At, B0); PG8_MMA(0, 1, At, B1); PG8_BAR; PG8_SCHED;
            PG8_LDA(At, 0, 1); PG8_STAGE(PG8_SB(0, 0), b2, voffB); PG8_STAGE(PG8_SB(0, 1), b2 + hstep, voffB); PG8_STAGE(PG8_SA(0, 0), a2, voffA);
            PG8_WAIT_V(8); PG8_WAIT_L(0); PG8_BAR; PG8_MMA(1, 0, At, B0); PG8_MMA(1, 1, At, B1); PG8_BAR; PG8_SCHED;
            PG8_LDB(B0, 1, 0); PG8_LDB(B1, 1, 1); PG8_SCHED; PG8_LDA(At, 1, 0); PG8_STAGE(PG8_SA(0, 1), a2 + hstep, voffA);
            PG8_WAIT_V(8); PG8_WAIT_L(0); PG8_BAR; PG8_MMA(0, 0, At, B0); PG8_MMA(0, 1, At, B1); PG8_BAR; PG8_SCHED;
            PG8_LDA(At, 1, 1); PG8_STAGE(PG8_SB(1, 0), b3, voffB); PG8_STAGE(PG8_SB(1, 1), b3 + hstep, voffB); PG8_STAGE(PG8_SA(1, 0), a3, voffA);
            PG8_WAIT_V(8); PG8_WAIT_L(0); PG8_BAR; PG8_MMA(1, 0, At, B0); PG8_MMA(1, 1, At, B1); PG8_BAR; PG8_SCHED;
            } else {
            PG8_LDB(B0, 0, 0); PG8_SCHED; PG8_LDA(At, 0, 0); PG8_STAGE(PG8_SA(1, 1), a1 + hstep, voffA);
            PG8_WAIT_L(8); PG8_BAR; PG8_WAIT_L(0); PG8_MMA(0, 0, At, B0); PG8_BAR; PG8_SCHED;
            PG8_LDB(B1, 0, 1); PG8_STAGE(PG8_SB(0, 0), b2, voffB);
            PG8_BAR; PG8_WAIT_L(0); PG8_MMA(0, 1, At, B1); PG8_BAR;
            PG8_LDA(At, 0, 1); PG8_STAGE(PG8_SA(0, 0), a2, voffA);
            PG8_BAR; PG8_WAIT_L(0); PG8_MMA(1, 0, At, B0); PG8_BAR; PG8_SCHED;
            PG8_STAGE(PG8_SB(0, 1), b2 + hstep, voffB);
            PG8_WAIT_V(6); PG8_BAR; PG8_MMA(1, 1, At, B1); PG8_BAR;
            PG8_LDB(B0, 1, 0); PG8_SCHED; PG8_LDA(At, 1, 0); PG8_STAGE(PG8_SA(0, 1), a2 + hstep, voffA);
            PG8_WAIT_L(8); PG8_BAR; PG8_WAIT_L(0); PG8_MMA(0, 0, At, B0); PG8_BAR; PG8_SCHED;
            PG8_LDB(B1, 1, 1); PG8_STAGE(PG8_SB(1, 0), b3, voffB);
            PG8_BAR; PG8_WAIT_L(0); PG8_MMA(0, 1, At, B1); PG8_BAR;
            PG8_LDA(At, 1, 1); PG8_STAGE(PG8_SA(1, 0), a3, voffA);
            PG8_BAR; PG8_WAIT_L(0); PG8_MMA(1, 0, At, B0); PG8_BAR; PG8_SCHED;
            PG8_STAGE(PG8_SB(1, 1), b3 + hstep, voffB);
            PG8_WAIT_V(6); PG8_BAR; PG8_MMA(1, 1, At, B1); PG8_BAR;
            }
        }
        if constexpr (ALIGN_EPI) { if (wr == 0) PG8_BAR; }
        if constexpr (!Epi::AFTER_DRAIN) { E(acc, cur, wr, wc, fr, fq); S.done(cur); }
        if (!has_next) break;
#pragma unroll
        for (int a = 0; a < 2; ++a)
#pragma unroll
            for (int b = 0; b < 2; ++b)
#pragma unroll
                for (int m = 0; m < 4; ++m)
#pragma unroll
                    for (int n = 0; n < 2; ++n) acc[a][b][m][n] = (f32x4){0.f, 0.f, 0.f, 0.f};
        cur = nxt; cA = nA; cB = nB; ++ui;
        if constexpr (ALIGN_EPI) { if (wr == 1) PG8_BAR; }
    }
    PG8_WAIT_V(0);
    if constexpr (!ALIGN_EPI) { if (wr == 0) PG8_BAR; }
    PG8_BAR;
    if constexpr (Epi::AFTER_DRAIN) { E.fused(acc, cur, wr, wc, fr, fq, lds, wid, lane); S.done(cur); }
#undef PG8_SA
#undef PG8_SB
#undef PG8_STAGE
#undef PG8_LDA
#undef PG8_LDB
#undef PG8_MMA
#undef PG8_WAIT_V
#undef PG8_WAIT_L
#undef PG8_BAR
#undef PG8_SCHED
}
}

#ifndef EXP_ZERO_HG
#define EXP_ZERO_HG 0
#endif
#ifndef EXP_ZERO_S5
#define EXP_ZERO_S5 0
#endif
#ifndef EXP_ZERO_MOE
#define EXP_ZERO_MOE 0
#endif
#ifndef EXP_ZERO_FFN
#define EXP_ZERO_FFN 0
#endif
#ifndef EXP_PROBE
#define EXP_PROBE 0
#endif
#ifndef EXP_ZERO_GLU
#define EXP_ZERO_GLU 0
#endif
#ifndef EXP_ZERO_PLE
#define EXP_ZERO_PLE 0
#endif
#ifndef EXP_PROBE_LAYER
#define EXP_PROBE_LAYER 1
#endif
#ifndef EXP_ZERO_SSD
#define EXP_ZERO_SSD 0
#endif
constexpr int NB = 8, SEQ = 2048, D = 1024, T = NB * SEQ, DEPTH = 4, PLE = 256;
constexpr int HGH = 4, HGD = 128, HGW = 512;
constexpr int M2H = 8, M2P = 64, M2I = 512, M2N = 128, M2XBC = 1024;
constexpr int EIN = 4112, EINP = 4096;
constexpr int S5G = 64, S5N = 64, S5C = 16;
constexpr int FF = 3584, NE = 8;
constexpr int MOE_ROWS = 2 * T + NE * 256;
constexpr float EPS = 1e-6f;
constexpr int NWAVES = 8, NTHR = 512;

constexpr size_t MiB = 1u << 20;
constexpr size_t WS_CTL = 0, CTL_ZERO_BYTES = 1 * MiB;
constexpr size_t WS_WIN = 1 * MiB;
constexpr size_t WS_WOUT = WS_WIN + 16 * MiB;
constexpr size_t WS_WGU = WS_WOUT + 4 * MiB;
constexpr size_t WS_WDN = WS_WGU + 28 * MiB;
constexpr size_t WS_WGLU = WS_WDN + 14 * MiB;
constexpr size_t WS_WPG = WS_WGLU + 8 * MiB;
constexpr size_t WS_WPP = WS_WPG + 8 * MiB;
constexpr size_t WS_WMGU = WS_WPP + 2 * MiB;
constexpr size_t WS_WMDN = WS_WMGU + 224 * MiB;
constexpr size_t WS_WDT = WS_WMDN + 112 * MiB;
constexpr size_t WS_H = WS_WDT + 1 * MiB;
constexpr size_t WS_HN = WS_H + 64 * MiB;
constexpr size_t WS_MIX = WS_HN + 32 * MiB;
constexpr size_t WS_PB = WS_MIX + 32 * MiB;
constexpr size_t WS_PP = WS_PB + 32 * MiB;
constexpr size_t WS_XBUF = WS_PP + 128 * MiB;
constexpr size_t WS_YBUF = WS_XBUF + 68 * MiB;
constexpr size_t WS_DT = WS_YBUF + 136 * MiB;
constexpr size_t WS_ROUTE = WS_DT + 1 * MiB;
constexpr size_t WS_R = WS_ROUTE + 1 * MiB;
constexpr size_t WS_PROJ = WS_R, WS_XBC = WS_R + 128 * MiB, WS_OA = WS_R + 160 * MiB, WS_YA = WS_R + 224 * MiB, WS_ACT = WS_R, WS_YS = WS_R;
constexpr size_t WS_END = WS_R + 288 * MiB;
static_assert((size_t)MOE_ROWS * FF * 2 <= 288 * MiB && (size_t)MOE_ROWS * D * 2 <= 68 * MiB && (size_t)MOE_ROWS * D * 4 <= 136 * MiB, "ws map");
constexpr int CW_BAR = 4096;

constexpr int RING_BYTES = 131072;
constexpr int MISC_OFF = RING_BYTES;
constexpr int LDS_BYTES = 147456;

#define GAS __attribute__((address_space(1)))
#define LAS __attribute__((address_space(3)))
typedef unsigned short bf16;
typedef unsigned v4u __attribute__((ext_vector_type(4)));
typedef unsigned v2u __attribute__((ext_vector_type(2)));
typedef float f32x4 __attribute__((ext_vector_type(4)));
typedef int v4i __attribute__((ext_vector_type(4)));
#define LDS_WAIT() asm volatile("s_waitcnt lgkmcnt(0)" ::: "memory")
__device__ __forceinline__ unsigned f2bf(float f) { unsigned u = __builtin_bit_cast(unsigned, f); return (u + 0x7fffu + ((u >> 16) & 1u)) >> 16; }
__device__ __forceinline__ unsigned pk2(float lo, float hi) { return f2bf(lo) | (f2bf(hi) << 16); }
__device__ __forceinline__ float bflo(unsigned w) { return __uint_as_float(w << 16); }
__device__ __forceinline__ float bfhi(unsigned w) { return __uint_as_float(w & 0xffff0000u); }
__device__ __forceinline__ float bf1(bf16 b) { return __uint_as_float((unsigned)b << 16); }
__device__ __forceinline__ float sigm(float x) { return 1.0f / (1.0f + __expf(-x)); }
__device__ __forceinline__ float silu_f(float x) { return x * sigm(x); }
__device__ __forceinline__ float softplus_f(float x) { return x > 20.f ? x : log1pf(__expf(x)); }
__device__ __forceinline__ float gelu_tanh(float x) { const float u = 0.7978845608028654f * (x + 0.044715f * x * x * x); return 0.5f * x * (1.0f + tanhf(u)); }
__device__ __forceinline__ float sx(float v, int o, int lane) { return __builtin_bit_cast(float, __builtin_amdgcn_ds_bpermute((lane ^ o) << 2, __builtin_bit_cast(int, v))); }
__device__ __forceinline__ float wave_sum(float v, int lane) {
#pragma unroll
    for (int o = 1; o < 64; o <<= 1) v += sx(v, o, lane);
    return v;
}
#define XB_TMO      128
#define XB_XCNT(j)  (256  + 64 * (j))
#define XB_XSUB(j)  (1280 + 64 * (j))
#define XB_XGEN(j)  (2304 + 64 * (j))
#define XB_TOP      3328
#define XB_TOPGEN   3392
#define XCD_BAR_WORDS 3456
#define XB_SPIN_CAP (1u << 18)

__device__ __forceinline__ unsigned xb_ld(unsigned* p)              { return __hip_atomic_load(p, __ATOMIC_RELAXED, __HIP_MEMORY_SCOPE_AGENT); }
__device__ __forceinline__ unsigned xb_add(unsigned* p, unsigned v) { return __hip_atomic_fetch_add(p, v, __ATOMIC_RELAXED, __HIP_MEMORY_SCOPE_AGENT); }
__device__ __forceinline__ unsigned xb_xcc_id() { return (unsigned)__builtin_amdgcn_s_getreg((3 << 11) | 20) & 0xFu; }
#define XB_SPIN(cond, bar) do { unsigned _sp = 0; while (cond) { __builtin_amdgcn_s_sleep(1); \
    if ((++_sp & 255u) == 0u) { if (xb_ld(&(bar)[XB_TMO])) break; if (_sp > XB_SPIN_CAP) { atomicAdd(&(bar)[XB_TMO], 1u); break; } } } } while (0)

struct XcdBarrier {
    unsigned* bar; unsigned x;
    volatile LAS unsigned* st;
};

__device__ __forceinline__ XcdBarrier xcd_barrier_post(unsigned* bar, volatile LAS unsigned* st) {
    XcdBarrier b; b.bar = bar; b.x = xb_xcc_id(); b.st = st;
    if (threadIdx.x == 0) (void)xb_add(&bar[XB_XCNT(b.x)], 1u);
    return b;
}
__device__ __forceinline__ void xcd_barrier_complete(unsigned* bar, unsigned x, unsigned& nloc, unsigned& nx) {
    const unsigned G = gridDim.x * gridDim.y * gridDim.z;
    unsigned sum, cnt, mine, sp = 0u;
    for (;;) {
        sum = 0u; cnt = 0u; mine = 0u;
#pragma unroll
        for (unsigned j = 0; j < 16; ++j) { const unsigned c = xb_ld(&bar[XB_XCNT(j)]); sum += c; cnt += (c > 0u) ? 1u : 0u; mine = (j == x) ? c : mine; }
        if (sum == G) break;
        __builtin_amdgcn_s_sleep(1);
        if ((++sp & 255u) == 0u) { if (xb_ld(&bar[XB_TMO])) break; if (sp > XB_SPIN_CAP) { atomicAdd(&bar[XB_TMO], 1u); break; } }
    }
    nloc = mine > 0u ? mine : 1u; nx = cnt > 0u ? cnt : 1u;
}

__device__ __forceinline__ void xcd_barrier(const XcdBarrier& b) {
    asm volatile("s_waitcnt vmcnt(0)" ::: "memory");
    __syncthreads();
    if (threadIdx.x == 0) {
        unsigned* bar = b.bar;
        __builtin_amdgcn_s_waitcnt(0);
        unsigned nloc = b.st[0], nx = b.st[1];
        if (nloc == 0u) { xcd_barrier_complete(bar, b.x, nloc, nx); b.st[0] = nloc; b.st[1] = nx; }
        const unsigned old = xb_add(&bar[XB_XSUB(b.x)], 1u);
        const unsigned gen = old / nloc;
        if (old + 1u == (gen + 1u) * nloc) {
            __builtin_amdgcn_fence(__ATOMIC_RELEASE, "agent");
            asm volatile("s_waitcnt vmcnt(0)" ::: "memory");
            const unsigned og = xb_add(&bar[XB_TOP], 1u);
            const unsigned tg = og / nx;
            if (og + 1u == (tg + 1u) * nx) xb_add(&bar[XB_TOPGEN], 1u);
            else XB_SPIN(xb_ld(&bar[XB_TOPGEN]) == tg, bar);
            __builtin_amdgcn_fence(__ATOMIC_ACQUIRE, "agent");
            xb_add(&bar[XB_XGEN(b.x)], 1u);
            asm volatile("s_waitcnt vmcnt(0)" ::: "memory");
        } else {
            XB_SPIN(xb_ld(&bar[XB_XGEN(b.x)]) == gen, bar);
            __builtin_amdgcn_fence(__ATOMIC_ACQUIRE, "agent");
            asm volatile("s_waitcnt vmcnt(0)" ::: "memory");
        }
    }
    __syncthreads();
}


enum { I_X = 0, I_P, I_NORM_MIX, I_NORM_FFN, I_NORM_PLE, I_FINAL_NORM, I_PLE_GATE, I_PLE_PROJ, I_EV_W_IN, I_EV_W_OUT, I_HG_LB, I_HG_NORM_W, I_M2_CONV_W, I_M2_CONV_B, I_M2_DT_BIAS, I_M2_A_LOG, I_M2_D,
       I_M2_NORM_W, I_S5_A_RE, I_S5_A_IM, I_S5_LOG_STEP, I_S5_B_RE, I_S5_B_IM, I_S5_C_RE, I_S5_C_IM, I_S5_D, I_S5_GLU_W, I_FFN_W_GU, I_FFN_W_DOWN, I_MOE_ROUTER, I_MOE_W_GU, I_MOE_W_DOWN, N_IN };
struct Args { const float* in[N_IN]; float* out; unsigned char* ws; int ph_lo, ph_hi; };

__device__ __forceinline__ void transpose_item(const float* W, int K, int ldw, bf16* WT, int Ndst, int half, const float* scale, LAS float* scr, int item, int lane) {
    const int nblk = Ndst / 32, kb = item / nblk, nb = item % nblk, k0 = 64 * kb, n0 = 32 * nb;
    int s0 = n0;
    if (half) { const int tile = n0 >> 8, w = n0 & 255; s0 = (w < 128) ? (128 * tile + w) : (half + 128 * tile + (w - 128)); }
#pragma unroll 8
    for (int i = 0; i < 32; ++i) { const int kk = 2 * i + (lane >> 5); float x = W[(size_t)(k0 + kk) * ldw + s0 + (lane & 31)]; if (scale) x *= scale[k0 + kk]; scr[kk * 33 + (lane & 31)] = x; }
    LDS_WAIT(); asm volatile("" ::: "memory");
    const int c = lane & 7;
#pragma unroll
    for (int j = 0; j < 4; ++j) { const int n = (lane >> 3) + 8 * j; const LAS float* s = scr + (8 * c) * 33 + n;
        v4u o; o.x = pk2(s[0 * 33], s[1 * 33]); o.y = pk2(s[2 * 33], s[3 * 33]); o.z = pk2(s[4 * 33], s[5 * 33]); o.w = pk2(s[6 * 33], s[7 * 33]);
        *(v4u*)(WT + (size_t)(n0 + n) * K + k0 + 8 * c) = o; }
    LDS_WAIT(); asm volatile("" ::: "memory");
}
__device__ __forceinline__ void prologue_phase(const Args& a, unsigned char* ws, LAS unsigned char* lds, int tid, int lane, int wave, int bid, int G) {
    LAS float* scr = (LAS float*)(lds + wave * 16384);
    const int gw = bid * NWAVES + wave, NGW = G * NWAVES;
    constexpr int I_IN = 16 * 128, I_OUT = 16 * 32, I_GU = 16 * 224, I_DN = 56 * 32, I_GLU = 16 * 64, I_PG = 16 * 32, I_PPJ = 4 * 32;
    constexpr int N0 = 2 * I_IN, N1 = 2 * I_OUT, N2 = 2 * I_GU, N3 = 2 * I_DN, N4 = 2 * I_GLU, N5 = 4 * I_PG, N6 = 4 * I_PPJ, N7 = 16 * I_GU, N8 = 16 * I_DN;
    constexpr int NTOT = N0 + N1 + N2 + N3 + N4 + N5 + N6 + N7 + N8;
    for (int it = gw; it < NTOT; it += NGW) {
        int r = it;
        if (r < N0) { const int j = r / I_IN; transpose_item(a.in[I_EV_W_IN] + (size_t)j * D * EIN, D, EIN, (bf16*)(ws + WS_WIN) + (size_t)j * EINP * D, EINP, 0, a.in[I_NORM_MIX] + (2 * j) * D, scr, r % I_IN, lane); continue; } r -= N0;
        if (r < N1) { const int j = r / I_OUT; transpose_item(a.in[I_EV_W_OUT] + (size_t)j * D * D, D, D, (bf16*)(ws + WS_WOUT) + (size_t)j * D * D, D, 0, nullptr, scr, r % I_OUT, lane); continue; } r -= N1;
        if (r < N2) { const int j = r / I_GU; transpose_item(a.in[I_FFN_W_GU] + (size_t)j * D * 2 * FF, D, 2 * FF, (bf16*)(ws + WS_WGU) + (size_t)j * 2 * FF * D, 2 * FF, FF, a.in[I_NORM_FFN] + (2 * j) * D, scr, r % I_GU, lane); continue; } r -= N2;
        if (r < N3) { const int j = r / I_DN; transpose_item(a.in[I_FFN_W_DOWN] + (size_t)j * FF * D, FF, D, (bf16*)(ws + WS_WDN) + (size_t)j * D * FF, D, 0, nullptr, scr, r % I_DN, lane); continue; } r -= N3;
        if (r < N4) { const int j = r / I_GLU; transpose_item(a.in[I_S5_GLU_W] + (size_t)j * D * 2 * D, D, 2 * D, (bf16*)(ws + WS_WGLU) + (size_t)j * 2 * D * D, 2 * D, D, nullptr, scr, r % I_GLU, lane); continue; } r -= N4;
        if (r < N5) { const int l = r / I_PG; transpose_item(a.in[I_PLE_GATE] + (size_t)l * D * D, D, D, (bf16*)(ws + WS_WPG) + (size_t)l * D * D, D, 0, a.in[I_NORM_PLE] + l * D, scr, r % I_PG, lane); continue; } r -= N5;
        if (r < N6) { const int l = r / I_PPJ; transpose_item(a.in[I_PLE_PROJ] + (size_t)l * PLE * D, PLE, D, (bf16*)(ws + WS_WPP) + (size_t)l * D * PLE, D, 0, nullptr, scr, r % I_PPJ, lane); continue; } r -= N6;
        if (r < N7) { const int je = r / I_GU, j = je >> 3; transpose_item(a.in[I_MOE_W_GU] + (size_t)je * D * 2 * FF, D, 2 * FF, (bf16*)(ws + WS_WMGU) + (size_t)je * 2 * FF * D, 2 * FF, FF, a.in[I_NORM_FFN] + (2 * j + 1) * D, scr, r % I_GU, lane); continue; } r -= N7;
        { const int je = r / I_DN; transpose_item(a.in[I_MOE_W_DOWN] + (size_t)je * FF * D, FF, D, (bf16*)(ws + WS_WMDN) + (size_t)je * D * FF, D, 0, nullptr, scr, r % I_DN, lane); }
    }
    const int gt = bid * NTHR + tid, NT = G * NTHR;
    { const f32x4* src = (const f32x4*)a.in[I_P]; v4u* dst = (v4u*)(ws + WS_PB);
      for (int i = gt; i < DEPTH * T * PLE / 8; i += NT) { const f32x4 x0 = src[2 * (size_t)i], x1 = src[2 * (size_t)i + 1]; v4u o; o.x = pk2(x0[0], x0[1]); o.y = pk2(x0[2], x0[3]); o.z = pk2(x1[0], x1[1]); o.w = pk2(x1[2], x1[3]); dst[i] = o; } }
    { float* wdt = (float*)(ws + WS_WDT);
      for (int i = gt; i < 2 * D * 16; i += NT) { const int j = i / (D * 16), c = (i / 16) % D, o = i % 16; wdt[i] = a.in[I_NORM_MIX][(2 * j) * D + c] * a.in[I_EV_W_IN][(size_t)j * D * EIN + (size_t)c * EIN + EINP + o]; }
      float* wr = (float*)(ws + WS_WDT + 256 * 1024);
      for (int i = gt; i < 2 * D * 8; i += NT) { const int j = i / (D * 8), c = (i / 8) % D, e = i % 8; wr[i] = a.in[I_NORM_FFN][(2 * j + 1) * D + c] * a.in[I_MOE_ROUTER][(size_t)j * D * 8 + c * 8 + e]; }
      float* lb = (float*)(ws + WS_WDT + 512 * 1024);
      for (int i = gt; i < HGW; i += NT) { const float l0 = a.in[I_HG_LB][i], l1 = a.in[I_HG_LB][HGW + i], m = fmaxf(l0, l1), e0 = expf(l0 - m), e1 = expf(l1 - m), s0 = e0 / (e0 + e1), s1 = e1 / (e0 + e1);
          lb[i] = s0 - s0; lb[HGW + i] = (s0 + s1) - s0; } }
}

__device__ __forceinline__ float load_row_rstd(const float* row, int lane, f32x4 (&v)[4]) {
    const f32x4* xr = (const f32x4*)row + lane; float s = 0.f;
#pragma unroll
    for (int j = 0; j < 4; ++j) { v[j] = xr[64 * j]; s += (v[j][0] * v[j][0] + v[j][1] * v[j][1]) + (v[j][2] * v[j][2] + v[j][3] * v[j][3]); }
    return 1.0f / sqrtf(wave_sum(s, lane) * (1.0f / D) + EPS);
}
__device__ __forceinline__ void store_row_bf16(bf16* orow, int lane, const f32x4 (&v)[4], float rstd) {
    unsigned long long* o8 = (unsigned long long*)orow + lane;
#pragma unroll
    for (int j = 0; j < 4; ++j) o8[64 * j] = (unsigned long long)pk2(v[j][0] * rstd, v[j][1] * rstd) | ((unsigned long long)pk2(v[j][2] * rstd, v[j][3] * rstd) << 32);
}
__device__ __forceinline__ void norm_phase(const float* src, bf16* HN, int lane, int wave, int bid, int G) {
    const int gw = bid * NWAVES + wave, NGW = G * NWAVES;
    for (int row = gw; row < T; row += NGW) { f32x4 v[4]; const float rstd = load_row_rstd(src + (size_t)row * D, lane, v); store_row_bf16(HN + (size_t)row * D, lane, v, rstd); }
}
__device__ __forceinline__ void norm_even_phase(const float* src, bf16* HN, const float* wdt  , const float* dt_bias  , float* DT, LAS unsigned char* lds, int tid, int lane, int wave, int bid, int G) {
    LAS float* wl = (LAS float*)lds;
    for (int i = tid; i < D * 16; i += NTHR) wl[(i & 15) * D + (i >> 4)] = wdt[i];
    __syncthreads();
    const int gw = bid * NWAVES + wave, NGW = G * NWAVES;
    for (int row = gw; row < T; row += NGW) {
        f32x4 v[4]; const float rstd = load_row_rstd(src + (size_t)row * D, lane, v); store_row_bf16(HN + (size_t)row * D, lane, v, rstd);
        float mine = 0.f;
#pragma nounroll
        for (int o = 0; o < 16; ++o) { float s = 0.f;
#pragma unroll
            for (int j = 0; j < 4; ++j) { const f32x4 w = *(const LAS f32x4*)(wl + o * D + 256 * j + 4 * lane); s += (v[j][0] * w[0] + v[j][1] * w[1]) + (v[j][2] * w[2] + v[j][3] * w[3]); }
            s = wave_sum(s, lane); mine = (lane == o) ? s : mine; }
        if (lane < 16) DT[(size_t)row * 16 + lane] = softplus_f(mine * rstd + dt_bias[lane]);
    }
    __syncthreads();
}
__device__ __forceinline__ void final_phase(const float* H, const float* w, float* out, int lane, int wave, int bid, int G, const int* diag = nullptr) {
    const int gw = bid * NWAVES + wave, NGW = G * NWAVES;
    for (int row = gw; row < T; row += NGW) { f32x4 v[4]; const float rstd = load_row_rstd(H + (size_t)row * D, lane, v);
        f32x4* o = (f32x4*)(out + (size_t)row * D) + lane; const f32x4* wv = (const f32x4*)w + lane;
#pragma unroll
        for (int j = 0; j < 4; ++j) o[64 * j] = v[j] * rstd * wv[64 * j] * (EXP_PROBE ? (float)(1 + diag[0]) : 1.0f); }
}

__device__ __forceinline__ void conv_phase(const bf16* PROJ, const float* cw, const float* cb, bf16* XBC, int tid, int bid, int G) {
    const size_t gt = (size_t)bid * NTHR + tid, NT = (size_t)G * NTHR;
    for (size_t idx = gt; idx < (size_t)T * 128; idx += NT) {
        const int t = (int)(idx >> 7), c = 8 * (int)(idx & 127), s = t & (SEQ - 1);
        float acc[8]; { const f32x4 b0 = *(const f32x4*)(cb + c), b1 = *(const f32x4*)(cb + c + 4); acc[0] = b0[0]; acc[1] = b0[1]; acc[2] = b0[2]; acc[3] = b0[3]; acc[4] = b1[0]; acc[5] = b1[1]; acc[6] = b1[2]; acc[7] = b1[3]; }
#pragma unroll
        for (int w = 0; w < 5; ++w) { const int ts = s + w - 2;
            if (ts >= 0 && ts < SEQ) { const v4u x = *(const v4u*)(PROJ + (size_t)(t + w - 2) * EINP + 3072 + c); const f32x4 k0 = *(const f32x4*)(cw + w * M2XBC + c), k1 = *(const f32x4*)(cw + w * M2XBC + c + 4);
                acc[0] += bflo(x.x) * k0[0]; acc[1] += bfhi(x.x) * k0[1]; acc[2] += bflo(x.y) * k0[2]; acc[3] += bfhi(x.y) * k0[3];
                acc[4] += bflo(x.z) * k1[0]; acc[5] += bfhi(x.z) * k1[1]; acc[6] += bflo(x.w) * k1[2]; acc[7] += bfhi(x.w) * k1[3]; } }
        v4u o; o.x = pk2(silu_f(acc[0]), silu_f(acc[1])); o.y = pk2(silu_f(acc[2]), silu_f(acc[3])); o.z = pk2(silu_f(acc[4]), silu_f(acc[5])); o.w = pk2(silu_f(acc[6]), silu_f(acc[7]));
        *(v4u*)(XBC + (size_t)t * M2XBC + c) = o;
    }
}
constexpr int TB = 16;
template <int MODE>
__device__ __forceinline__ void scan_item(int item, const bf16* PROJ, const bf16* XBC, const float* DT, const float* lbv  , const float* a_log  , float* OUT  , LAS unsigned char* lds, int tid) {
    LAS float* qs = (LAS float*)lds;
    LAS float* fs = qs + 2 * TB * 128;
    LAS float* ks = fs + 2 * TB * 128;
    LAS float* vs = ks + 2 * TB * 128;
    LAS float* sc = vs + 2 * TB * 32;
    LAS float* op = sc + 2 * TB * 2;
    const int part = MODE == 0 ? (item & 3) : (item & 1), dir = MODE == 0 ? ((item >> 2) & 1) : ((item >> 1) & 1), head = MODE == 0 ? ((item >> 3) & 3) : ((item >> 2) & 7), b = item >> 5;
    const int vv = tid & 31, dg = tid >> 5;
    const int si = tid >> 5, seg = tid & 31;
    const int colq = MODE == 0 ? head * 128 + 4 * seg : 3072 + 768 + (head >> 2) * 128 + 4 * seg;
    const int colf = MODE == 0 ? (dir == 0 ? 512 : 1024) + head * 128 + 4 * seg : 3072 + 512 + (head >> 2) * 128 + 4 * seg;
    const int colv = MODE == 0 ? 1536 + head * 128 + part * 32 + seg : 3072 + head * 64 + part * 32 + seg;
    float lb4[4] = {0.f, 0.f, 0.f, 0.f}; float Aneg = 0.f;
    if (MODE == 0) {
#pragma unroll
        for (int e = 0; e < 4; ++e) lb4[e] = lbv[head * 128 + 4 * seg + e];
    } else Aneg = -expf(a_log[dir * 8 + head]);
    float S[8];
#pragma unroll
    for (int e = 0; e < 8; ++e) S[e] = 0.f;
    constexpr int NBLK = SEQ / TB;
    v2u rq, rf; bf16 rv; float rdt = 0.f;
#define SCAN_TROW(blk, i) ((size_t)b * SEQ + (dir == 0 ? ((blk) * TB + (i)) : (SEQ - 1 - ((blk) * TB + (i)))))
#define SCAN_LOAD(blk) do { const size_t tr = SCAN_TROW(blk, si); \
        if (MODE == 0) { rq = *(const v2u*)(PROJ + tr * EINP + colq); rf = *(const v2u*)(PROJ + tr * EINP + colf); rv = PROJ[tr * EINP + colv]; } \
        else { rq = *(const v2u*)(XBC + tr * M2XBC + (colq - 3072)); rf = *(const v2u*)(XBC + tr * M2XBC + (colf - 3072)); rv = XBC[tr * M2XBC + (colv - 3072)]; if (seg == 0) rdt = DT[tr * 16 + dir * 8 + head]; } } while (0)
#define SCAN_STAGE(buf) do { const int o4 = ((buf) * TB + si) * 128 + 4 * seg; \
        const float q0 = bflo(rq.x), q1 = bfhi(rq.x), q2 = bflo(rq.y), q3 = bfhi(rq.y), f0 = bflo(rf.x), f1 = bfhi(rf.x), f2 = bflo(rf.y), f3 = bfhi(rf.y); \
        if (MODE == 0) { const float g0 = sigm(f0), g1 = sigm(f1), g2 = sigm(f2), g3 = sigm(f3); \
            *(LAS f32x4*)(qs + o4) = (f32x4){silu_f(q0), silu_f(q1), silu_f(q2), silu_f(q3)}; \
            *(LAS f32x4*)(fs + o4) = (f32x4){fmaxf(lb4[0], 1e-30f) + (1.f - lb4[0]) * g0, fmaxf(lb4[1], 1e-30f) + (1.f - lb4[1]) * g1, fmaxf(lb4[2], 1e-30f) + (1.f - lb4[2]) * g2, fmaxf(lb4[3], 1e-30f) + (1.f - lb4[3]) * g3}; \
            *(LAS f32x4*)(ks + o4) = (f32x4){(1.f - lb4[0]) * (1.f - g0), (1.f - lb4[1]) * (1.f - g1), (1.f - lb4[2]) * (1.f - g2), (1.f - lb4[3]) * (1.f - g3)}; } \
        else { *(LAS f32x4*)(qs + o4) = (f32x4){q0, q1, q2, q3}; *(LAS f32x4*)(ks + o4) = (f32x4){f0, f1, f2, f3}; if (seg == 0) { sc[((buf) * TB + si) * 2] = __expf(rdt * Aneg); sc[((buf) * TB + si) * 2 + 1] = rdt; } } \
        vs[((buf) * TB + si) * 32 + seg] = bf1(rv); } while (0)
    SCAN_LOAD(0); SCAN_STAGE(0);
    __syncthreads();
    for (int blk = 0; blk < NBLK; ++blk) {
        const int cur = blk & 1;
        if (blk + 1 < NBLK) SCAN_LOAD(blk + 1);
#pragma unroll
        for (int i = 0; i < TB; ++i) {
            const int o8 = (cur * TB + i) * 128 + 8 * dg;
            const f32x4 qa = *(const LAS f32x4*)(qs + o8), qb = *(const LAS f32x4*)(qs + o8 + 4), ka = *(const LAS f32x4*)(ks + o8), kb = *(const LAS f32x4*)(ks + o8 + 4);
            const float vt = vs[(cur * TB + i) * 32 + vv];
            float acc = 0.f;
            if (MODE == 0) {
                const f32x4 fa = *(const LAS f32x4*)(fs + o8), fb = *(const LAS f32x4*)(fs + o8 + 4);
#pragma unroll
                for (int e = 0; e < 4; ++e) { S[e] = fa[e] * S[e] + ka[e] * vt; acc += qa[e] * S[e]; S[4 + e] = fb[e] * S[4 + e] + kb[e] * vt; acc += qb[e] * S[4 + e]; }
            } else {
                const float dec = sc[(cur * TB + i) * 2], dtx = sc[(cur * TB + i) * 2 + 1] * vt;
#pragma unroll
                for (int e = 0; e < 4; ++e) { S[e] = dec * S[e] + ka[e] * dtx; acc += qa[e] * S[e]; S[4 + e] = dec * S[4 + e] + kb[e] * dtx; acc += qb[e] * S[4 + e]; }
            }
            op[(i * 16 + dg) * 32 + vv] = acc;
        }
        __syncthreads();
        { float s = 0.f;
#pragma unroll
          for (int g = 0; g < 16; ++g) s += op[(si * 16 + g) * 32 + seg];
          const size_t tr = SCAN_TROW(blk, si);
          OUT[((size_t)dir * T + tr) * 512 + (MODE == 0 ? head * 128 + part * 32 : head * 64 + part * 32) + seg] = s; }
        if (blk + 1 < NBLK) SCAN_STAGE(cur ^ 1);
        __syncthreads();
    }
#undef SCAN_TROW
#undef SCAN_LOAD
#undef SCAN_STAGE
}
__device__ __forceinline__ void combine_even_phase(const bf16* PROJ, const bf16* XBC, const float* OA, const float* YA, const float* hg_nw, const float* m2_d, const float* m2_nw, bf16* MIX, int lane, int wave, int bid, int G) {
    const int gw = bid * NWAVES + wave, NGW = G * NWAVES, c0 = 8 * lane;
    for (int row = gw; row < T; row += NGW) {
        float o[8], y[8];
        { const f32x4 a0 = *(const f32x4*)(OA + (size_t)row * 512 + c0), a1 = *(const f32x4*)(OA + (size_t)row * 512 + c0 + 4), b0 = *(const f32x4*)(OA + ((size_t)T + row) * 512 + c0), b1 = *(const f32x4*)(OA + ((size_t)T + row) * 512 + c0 + 4);
#pragma unroll
          for (int e = 0; e < 4; ++e) { o[e] = a0[e] + b0[e]; o[4 + e] = a1[e] + b1[e]; } }
        float ss = 0.f;
#pragma unroll
        for (int e = 0; e < 8; ++e) ss += o[e] * o[e];
        ss += sx(ss, 1, lane); ss += sx(ss, 2, lane); ss += sx(ss, 4, lane); ss += sx(ss, 8, lane);
        const float r1 = 1.0f / sqrtf(ss * (1.0f / 128.0f) + EPS);
        { const v4u g = *(const v4u*)(PROJ + (size_t)row * EINP + 2048 + c0); const f32x4 w0 = *(const f32x4*)(hg_nw + c0), w1 = *(const f32x4*)(hg_nw + c0 + 4);
          const float gg[8] = {bflo(g.x), bfhi(g.x), bflo(g.y), bfhi(g.y), bflo(g.z), bfhi(g.z), bflo(g.w), bfhi(g.w)}; const float ww[8] = {w0[0], w0[1], w0[2], w0[3], w1[0], w1[1], w1[2], w1[3]};
#pragma unroll
          for (int e = 0; e < 8; ++e) o[e] = o[e] * r1 * ww[e] * sigm(gg[e]) * (float)(1 - EXP_ZERO_HG);
          v4u w; w.x = pk2(o[0], o[1]); w.y = pk2(o[2], o[3]); w.z = pk2(o[4], o[5]); w.w = pk2(o[6], o[7]); *(v4u*)(MIX + (size_t)row * D + c0) = w; }
        { const f32x4 a0 = *(const f32x4*)(YA + (size_t)row * 512 + c0), a1 = *(const f32x4*)(YA + (size_t)row * 512 + c0 + 4), b0 = *(const f32x4*)(YA + ((size_t)T + row) * 512 + c0), b1 = *(const f32x4*)(YA + ((size_t)T + row) * 512 + c0 + 4);
          const v4u x = *(const v4u*)(XBC + (size_t)row * M2XBC + c0), z = *(const v4u*)(PROJ + (size_t)row * EINP + 2560 + c0); const float dsk = m2_d[lane >> 3];
          const float xx[8] = {bflo(x.x), bfhi(x.x), bflo(x.y), bfhi(x.y), bflo(x.z), bfhi(x.z), bflo(x.w), bfhi(x.w)}; const float zz[8] = {bflo(z.x), bfhi(z.x), bflo(z.y), bfhi(z.y), bflo(z.z), bfhi(z.z), bflo(z.w), bfhi(z.w)};
#pragma unroll
          for (int e = 0; e < 4; ++e) { y[e] = (a0[e] + b0[e] + dsk * xx[e]) * silu_f(zz[e]); y[4 + e] = (a1[e] + b1[e] + dsk * xx[4 + e]) * silu_f(zz[4 + e]); } }
        float s2 = 0.f;
#pragma unroll
        for (int e = 0; e < 8; ++e) s2 += y[e] * y[e];
        s2 += sx(s2, 1, lane); s2 += sx(s2, 2, lane); s2 += sx(s2, 4, lane); s2 += sx(s2, 8, lane); s2 += sx(s2, 16, lane);
        const float r2 = 1.0f / sqrtf(s2 * (1.0f / 256.0f) + EPS);
        { const f32x4 w0 = *(const f32x4*)(m2_nw + c0), w1 = *(const f32x4*)(m2_nw + c0 + 4);
          if (EXP_ZERO_SSD) { for (int e = 0; e < 8; ++e) y[e] = 0.f; }
          v4u w; w.x = pk2(y[0] * r2 * w0[0], y[1] * r2 * w0[1]); w.y = pk2(y[2] * r2 * w0[2], y[3] * r2 * w0[3]); w.z = pk2(y[4] * r2 * w1[0], y[5] * r2 * w1[1]); w.w = pk2(y[6] * r2 * w1[2], y[7] * r2 * w1[3]);
          *(v4u*)(MIX + (size_t)row * D + 512 + c0) = w; }
    }
}

__device__ __forceinline__ void s5_item(int item, int j, const Args& a, const float* nw  , const bf16* HN, float* YS  , int lane) {
    const int dir = item & 1, g = (item >> 1) & 63, b = item >> 7, n = lane;
    const size_t pg = ((size_t)(j * 2 + dir) * S5G + g);
    const float a_re = a.in[I_S5_A_RE][pg * S5N + n], a_im = a.in[I_S5_A_IM][pg * S5N + n];
    const float delta = expf(a.in[I_S5_LOG_STEP][pg]);
    const float mag = expf(a_re * delta); float sn, cs; sincosf(a_im * delta, &sn, &cs);
    const float lam_re = mag * cs, lam_im = mag * sn;
    const float den = a_re * a_re + a_im * a_im, num_re = lam_re - 1.0f;
    const float coef_re = (num_re * a_re + lam_im * a_im) / den, coef_im = (lam_im * a_re - num_re * a_im) / den;
    float bbr[16], bbi[16], cr[16], ci[16];
#pragma unroll
    for (int c = 0; c < 16; ++c) {
        const size_t bi_ = (((size_t)j * S5G + g) * S5N + n) * S5C + c;
        const float br = a.in[I_S5_B_RE][bi_], bi = a.in[I_S5_B_IM][bi_], w = nw[g * 16 + c];
        bbr[c] = (coef_re * br - coef_im * bi) * w; bbi[c] = (coef_re * bi + coef_im * br) * w;
        const size_t ci_ = (pg * S5C + c) * S5N + n;
        cr[c] = a.in[I_S5_C_RE][ci_]; ci[c] = a.in[I_S5_C_IM][ci_];
    }
    float hr = 0.f, hi = 0.f;
    for (int blk = 0; blk < SEQ / 64; ++blk) {
        const size_t tl = (size_t)b * SEQ + (dir == 0 ? (blk * 64 + lane) : (SEQ - 1 - (blk * 64 + lane)));
        const v4u u0 = *(const v4u*)(HN + tl * D + g * 16), u1 = *(const v4u*)(HN + tl * D + g * 16 + 8);
        const float uv[16] = {bflo(u0.x), bfhi(u0.x), bflo(u0.y), bfhi(u0.y), bflo(u0.z), bfhi(u0.z), bflo(u0.w), bfhi(u0.w), bflo(u1.x), bfhi(u1.x), bflo(u1.y), bfhi(u1.y), bflo(u1.z), bfhi(u1.z), bflo(u1.w), bfhi(u1.w)};
        for (int i = 0; i < 64; ++i) {
            float bur = 0.f, bui = 0.f;
#pragma unroll
            for (int c = 0; c < 16; ++c) { const float u = __builtin_bit_cast(float, __builtin_amdgcn_readlane(__builtin_bit_cast(int, uv[c]), i)); bur += bbr[c] * u; bui += bbi[c] * u; }
            const float nhr = lam_re * hr - lam_im * hi + bur, nhi = lam_re * hi + lam_im * hr + bui; hr = nhr; hi = nhi;
            float y[16];
#pragma unroll
            for (int c = 0; c < 16; ++c) y[c] = cr[c] * hr - ci[c] * hi;
            const bool b5 = (lane & 32) != 0, b4 = (lane & 16) != 0, b3 = (lane & 8) != 0, b2 = (lane & 4) != 0;
            float a8[8], a4[4], a2[2], a1;
#pragma unroll
            for (int k = 0; k < 8; ++k) { const float send = b5 ? y[k] : y[k + 8], keep = b5 ? y[k + 8] : y[k]; a8[k] = keep + sx(send, 32, lane); }
#pragma unroll
            for (int k = 0; k < 4; ++k) { const float send = b4 ? a8[k] : a8[k + 4], keep = b4 ? a8[k + 4] : a8[k]; a4[k] = keep + sx(send, 16, lane); }
#pragma unroll
            for (int k = 0; k < 2; ++k) { const float send = b3 ? a4[k] : a4[k + 2], keep = b3 ? a4[k + 2] : a4[k]; a2[k] = keep + sx(send, 8, lane); }
            { const float send = b2 ? a2[0] : a2[1], keep = b2 ? a2[1] : a2[0]; a1 = keep + sx(send, 4, lane); }
            a1 += sx(a1, 2, lane); a1 += sx(a1, 1, lane);
            const size_t ti = (size_t)b * SEQ + (dir == 0 ? (blk * 64 + i) : (SEQ - 1 - (blk * 64 + i)));
            if ((lane & 3) == 0) YS[((size_t)dir * T + ti) * D + g * 16 + (lane >> 2)] = a1;
        }
    }
}
__device__ __forceinline__ void combine_s5_phase(const float* H, const float* nw, const float* dsk, const float* YS, bf16* MIX, int lane, int wave, int bid, int G) {
    const int gw = bid * NWAVES + wave, NGW = G * NWAVES;
    for (int row = gw; row < T; row += NGW) {
        f32x4 v[4]; const float rstd = load_row_rstd(H + (size_t)row * D, lane, v);
        const f32x4* yf = (const f32x4*)(YS + (size_t)row * D) + lane; const f32x4* yb = (const f32x4*)(YS + ((size_t)T + row) * D) + lane;
        const f32x4* wv = (const f32x4*)nw + lane; const f32x4* dv = (const f32x4*)dsk + lane;
        unsigned long long* o8 = (unsigned long long*)(MIX + (size_t)row * D) + lane;
#pragma unroll
        for (int jj = 0; jj < 4; ++jj) { const f32x4 y = (yf[64 * jj] + yb[64 * jj]) * (float)(1 - EXP_ZERO_S5) + dv[64 * jj] * (v[jj] * rstd * wv[64 * jj]);
            o8[64 * jj] = (unsigned long long)pk2(gelu_tanh(y[0]), gelu_tanh(y[1])) | ((unsigned long long)pk2(gelu_tanh(y[2]), gelu_tanh(y[3])) << 32); }
    }
}
__device__ __forceinline__ void router_phase(const float* H, bf16* HN, const float* wr  , v4i* SEL, float* GATE, int* CNT, LAS unsigned char* lds, int tid, int lane, int wave, int bid, int G) {
    LAS float* wl = (LAS float*)lds;
    LAS int* lcnt = (LAS int*)(lds + 32768);
    for (int i = tid; i < D * 8; i += NTHR) wl[(i & 7) * D + (i >> 3)] = wr[i];
    for (int grp = bid; grp < T / 64; grp += G) {
        if (tid < 8) lcnt[tid] = 0;
        __syncthreads();
        for (int r = 0; r < 8; ++r) {
            const int row = grp * 64 + wave * 8 + r;
            f32x4 v[4]; const float rstd = load_row_rstd(H + (size_t)row * D, lane, v); store_row_bf16(HN + (size_t)row * D, lane, v, rstd);
            float lg[8];
#pragma unroll
            for (int e = 0; e < 8; ++e) { float s = 0.f;
#pragma unroll
                for (int jj = 0; jj < 4; ++jj) { const f32x4 w = *(const LAS f32x4*)(wl + e * D + 256 * jj + 4 * lane); s += (v[jj][0] * w[0] + v[jj][1] * w[1]) + (v[jj][2] * w[2] + v[jj][3] * w[3]); }
                lg[e] = wave_sum(s, lane) * rstd; }
            int e0 = 0; float l0 = lg[0];
#pragma unroll
            for (int e = 1; e < 8; ++e) if (lg[e] > l0) { l0 = lg[e]; e0 = e; }
            int e1 = -1; float l1 = -3.0e38f;
#pragma unroll
            for (int e = 0; e < 8; ++e) if (e != e0 && lg[e] > l1) { l1 = lg[e]; e1 = e; }
            const float g1 = 1.0f / (1.0f + expf(l0 - l1)), g0 = 1.0f - g1;
            if (lane == 0) { SEL[row] = (v4i){e0, e1, __builtin_bit_cast(int, g0), __builtin_bit_cast(int, g1)}; GATE[(size_t)row * 2] = g0; GATE[(size_t)row * 2 + 1] = g1; atomicAdd((int*)&lcnt[e0], 1); atomicAdd((int*)&lcnt[e1], 1); }
        }
        __syncthreads();
        if (tid < 8) CNT[grp * 8 + tid] = lcnt[tid];
        __syncthreads();
    }
}
__device__ __forceinline__ void scatter_phase(const bf16* HN, const v4i* SEL, const int* CNT, int* SLOT, int* SEGB, bf16* XBUF, LAS unsigned char* lds, int tid, int lane, int wave, int bid, int G) {
    LAS int* ltot = (LAS int*)lds;
    LAS int* lbef = ltot + 8;
    LAS int* base = lbef + 8;
    LAS int* wcnt = base + 8;
    for (int grp = bid; grp < T / 64; grp += G) {
        if (tid < 16) ltot[tid] = 0;
        __syncthreads();
        { const int e = tid & 7, q = tid >> 3; int tot = 0, bef = 0;
#pragma unroll
          for (int k = 0; k < 4; ++k) { const int g2 = q + 64 * k; const int c = CNT[g2 * 8 + e]; tot += c; bef += (g2 < grp) ? c : 0; }
          atomicAdd((int*)&ltot[e], tot); atomicAdd((int*)&lbef[e], bef); }
        __syncthreads();
        if (tid == 0) { int sb = 0;
            for (int e = 0; e < 8; ++e) { base[e] = sb + lbef[e]; if (grp == 0) SEGB[e] = sb; sb += (ltot[e] + 255) & ~255; }
            if (grp == 0) SEGB[8] = sb; }
        const int r0 = grp * 64 + wave * 8;
        int myE = -1;
        if (lane < 16) { const v4i s = SEL[r0 + (lane >> 1)]; myE = (lane & 1) ? s[1] : s[0]; }
        int rank = 0, cntMine = 0;
#pragma unroll
        for (int e = 0; e < 8; ++e) { const unsigned long long m = __ballot(myE == e); const int c = __popcll(m); if (lane == e) cntMine = c; if (myE == e) rank = __popcll(m & ((1ull << lane) - 1ull)); }
        if (lane < 8) wcnt[wave * 8 + lane] = cntMine;
        __syncthreads();
        int slot = 0;
        if (lane < 16) { int pre = 0; for (int w = 0; w < wave; ++w) pre += wcnt[w * 8 + myE]; slot = base[myE] + pre + rank; SLOT[(size_t)(r0 + (lane >> 1)) * 2 + (lane & 1)] = slot; }
        for (int i = 0; i < 16; ++i) { const int sl = __builtin_amdgcn_readlane(slot, i); const int row = r0 + (i >> 1);
            const v4u* src = (const v4u*)(HN + (size_t)row * D); v4u* dst = (v4u*)(XBUF + (size_t)sl * D);
            dst[lane] = src[lane]; dst[64 + lane] = src[64 + lane]; }
        __syncthreads();
    }
}

#if EXP_PROBE
__device__ __forceinline__ void probe_moe(const float* H, const float* nw, const float* router, const float* w_gu, const float* w_down, const v4i* SEL, const int* SLOT, const float* YBUF, int* diag,
                                          LAS unsigned char* lds, int tid, int lane, int wave, int bid) {
    LAS float* xt = (LAS float*)lds;
    LAS float* act = xt + 1024;
    LAS float* red = act + 3584;
    const int t = (bid * 61 + 7) & (T - 1);
    if (wave == 0) { f32x4 v[4]; const float rstd = load_row_rstd(H + (size_t)t * D, lane, v);
#pragma unroll
        for (int j = 0; j < 4; ++j) { const f32x4 w = ((const f32x4*)nw)[64 * j + lane]; *(LAS f32x4*)(xt + 256 * j + 4 * lane) = v[j] * rstd * w; } }
    __syncthreads();
    if (tid < 8) { float s = 0.f; for (int c = 0; c < D; ++c) s += xt[c] * router[c * 8 + tid]; red[tid] = s; }
    __syncthreads();
    int e0 = 0; float l0 = red[0];
    for (int e = 1; e < 8; ++e) if (red[e] > l0) { l0 = red[e]; e0 = e; }
    int e1 = -1; float l1 = -3.0e38f;
    for (int e = 0; e < 8; ++e) if (e != e0 && red[e] > l1) { l1 = red[e]; e1 = e; }
    const v4i sel = SEL[t];
    int code = 0;
    if (sel[0] != e0 || sel[1] != e1) code = 10;
    const float g1 = 1.0f / (1.0f + expf(l0 - l1)), g0 = 1.0f - g1;
    if (code == 0 && (fabsf(g0 - __builtin_bit_cast(float, sel[2])) > 1e-3f || fabsf(g1 - __builtin_bit_cast(float, sel[3])) > 1e-3f)) code = 9;
    __syncthreads();
    int cc[2] = {0, 0};
    for (int k = 0; k < 2; ++k) {
        const int e = k == 0 ? e0 : e1; const float* wg = w_gu + (size_t)e * D * 2 * FF; const float* wd = w_down + (size_t)e * FF * D;
        float ag[7], au[7];
        for (int q = 0; q < 7; ++q) { ag[q] = 0.f; au[q] = 0.f; }
        for (int c = 0; c < D; ++c) { const float x = xt[c];
#pragma unroll
            for (int q = 0; q < 7; ++q) { ag[q] += x * wg[(size_t)c * 2 * FF + tid + 512 * q]; au[q] += x * wg[(size_t)c * 2 * FF + FF + tid + 512 * q]; } }
#pragma unroll
        for (int q = 0; q < 7; ++q) act[tid + 512 * q] = ag[q] * sigm(ag[q]) * au[q];
        __syncthreads();
        float y0 = 0.f, y1 = 0.f;
        for (int f = 0; f < FF; ++f) { const float a = act[f]; y0 += a * wd[(size_t)f * D + tid]; y1 += a * wd[(size_t)f * D + 512 + tid]; }
        const int slot = SLOT[(size_t)t * 2 + k];
        const float m0 = YBUF[(size_t)slot * D + tid], m1 = YBUF[(size_t)slot * D + 512 + tid];
        float er = (m0 - y0) * (m0 - y0) + (m1 - y1) * (m1 - y1), rf = y0 * y0 + y1 * y1;
        er = wave_sum(er, lane); rf = wave_sum(rf, lane);
        __syncthreads();
        if (lane == 0) { red[16 + wave] = er; red[32 + wave] = rf; }
        __syncthreads();
        float E = 0.f, R = 0.f; for (int w = 0; w < 8; ++w) { E += red[16 + w]; R += red[32 + w]; }
        const float rel = E / (R + 1e-20f);
        cc[k] = rel < 1e-3f ? 0 : (rel < 0.1f ? 1 : 2);
        __syncthreads();
    }
    if (code == 0) code = cc[0] * 3 + cc[1];
    { const float sg0 = __builtin_bit_cast(float, sel[2]), sg1 = __builtin_bit_cast(float, sel[3]); int c2 = (int)(sg0 * 10.f); if (c2 < 0) c2 = 0; if (c2 > 12) c2 = 12;
      if (fabsf(sg0 + sg1 - 1.f) > 1e-3f) { int c3 = (int)((sg0 + sg1) * 5.f); if (c3 < 0) c3 = 0; if (c3 > 9) c3 = 9; c2 = 13 + c3; }
      code = c2; }
    if (tid == 0 && bid == 0) atomicMax(diag, code);
}
#endif
__device__ __forceinline__ void moe_combine_norm_phase(float* H, const float* YBUF, const float* GATE, const int* SLOT, bf16* HN, int lane, int wave, int bid, int G, const int* SEGBp = nullptr, int* diag = nullptr, float mscl = 1.f) {
    const int gw = bid * NWAVES + wave, NGW = G * NWAVES;
    for (int row = gw; row < T; row += NGW) {
        const int s0 = SLOT[(size_t)row * 2], s1 = SLOT[(size_t)row * 2 + 1]; const float g0 = GATE[(size_t)row * 2], g1 = GATE[(size_t)row * 2 + 1];
        f32x4* hr = (f32x4*)(H + (size_t)row * D) + lane; const f32x4* y0 = (const f32x4*)(YBUF + (size_t)s0 * D) + lane; const f32x4* y1 = (const f32x4*)(YBUF + (size_t)s1 * D) + lane;
        f32x4 v[4]; float ss = 0.f;
#pragma unroll
        for (int jj = 0; jj < 4; ++jj) { v[jj] = hr[64 * jj] + (g0 * y0[64 * jj] + g1 * y1[64 * jj]) * mscl; hr[64 * jj] = v[jj]; ss += (v[jj][0] * v[jj][0] + v[jj][1] * v[jj][1]) + (v[jj][2] * v[jj][2] + v[jj][3] * v[jj][3]); }
        const float rstd = 1.0f / sqrtf(wave_sum(ss, lane) * (1.0f / D) + EPS);
        store_row_bf16(HN + (size_t)row * D, lane, v, rstd);
    }
}

#ifndef MK_ONE_LAUNCH
#define MK_ONE_LAUNCH 0
#endif
constexpr int PH_PER_LAYER = 11, PH_LAYER0 = 2, N_PHASES = PH_LAYER0 + 4 * PH_PER_LAYER + 1;

#define H ((float*)(ws + WS_H))
#define HN ((bf16*)(ws + WS_HN))
#define MIX ((bf16*)(ws + WS_MIX))
#define PB ((bf16*)(ws + WS_PB))
#define PP ((bf16*)(ws + WS_PP))
#define XBUF ((bf16*)(ws + WS_XBUF))
#define YBUF ((float*)(ws + WS_YBUF))
#define DT ((float*)(ws + WS_DT))
#define SEL ((v4i*)(ws + WS_ROUTE))
#define SLOT ((int*)(ws + WS_ROUTE + 256 * 1024))
#define GATE ((float*)(ws + WS_ROUTE + 512 * 1024))
#define CNT ((int*)(ws + WS_ROUTE + 384 * 1024))
#define SEGB ((int*)(ws + WS_ROUTE + 400 * 1024))
#define PROJ ((bf16*)(ws + WS_PROJ))
#define XBC ((bf16*)(ws + WS_XBC))
#define OA ((float*)(ws + WS_OA))
#define YA ((float*)(ws + WS_YA))
#define ACT ((bf16*)(ws + WS_ACT))
#define YS ((float*)(ws + WS_YS))
__global__ void __launch_bounds__(NTHR, 2) fwd(Args args) {
    extern __shared__ __attribute__((aligned(16))) unsigned char lds_raw[];
    LAS unsigned char* lds = (LAS unsigned char*)lds_raw;
    volatile LAS unsigned* MISC = (volatile LAS unsigned*)(lds + MISC_OFF);
    const int G = gridDim.x, bid = blockIdx.x, wave_s = __builtin_amdgcn_readfirstlane((int)threadIdx.x >> 6);
    if (threadIdx.x < 32) MISC[threadIdx.x] = 0u;
#if defined(__HIP_DEVICE_COMPILE__)
#define ASSUME_GLOBAL(p) do { __builtin_assume(!__builtin_amdgcn_is_shared((const __attribute__((address_space(0))) void*)(p))); __builtin_assume(!__builtin_amdgcn_is_private((const __attribute__((address_space(0))) void*)(p))); } while (0)
#else
#define ASSUME_GLOBAL(p) do { } while (0)
#endif
#define PHASE_IDS() unsigned char* ws = args.ws; asm volatile("" : "+s"(ws) :: "memory"); ASSUME_GLOBAL(ws); int lane = (int)__builtin_amdgcn_mbcnt_hi(~0u, __builtin_amdgcn_mbcnt_lo(~0u, 0u)); asm volatile("" : "+v"(lane)); const int wave = wave_s, tid = wave * 64 + lane; (void)tid
    __syncthreads();
    XcdBarrier bar; bar.bar = (unsigned*)(args.ws + WS_CTL) + CW_BAR; bar.x = 0; bar.st = nullptr;
    if (MK_ONE_LAUNCH) bar = xcd_barrier_post((unsigned*)(args.ws + WS_CTL) + CW_BAR, MISC + 8);
#define SEAM() do { if (MK_ONE_LAUNCH) xcd_barrier(bar); } while (0)
    const int lo = args.ph_lo, hi = args.ph_hi;
#define IN(k) (lo <= (k) && (k) < hi)
    const float* x = args.in[I_X];

    if (IN(0)) { PHASE_IDS(); prologue_phase(args, ws, lds, tid, lane, wave, bid, G); SEAM(); }
    if (IN(1)) { PHASE_IDS();
        pg8::StackOrder S; S.init(PB, (const bf16*)(ws + WS_WPP), DEPTH * T, D, PLE, 6  , G, bid);
        pg8::EpiBf16 E{PP, D};
        int Kp = PLE; asm volatile("" : "+s"(Kp));
        pg8::gemm_phase<pg8::EpiBf16, pg8::StackOrder, true, true>(lds, Kp, S, E, wave_s);
        SEAM();
    }
    for (int l = 0; l < DEPTH; ++l) {
        const int pb = PH_LAYER0 + PH_PER_LAYER * l, j = l >> 1;
        if ((l & 1) == 0) {
            if (IN(pb + 0)) { PHASE_IDS(); norm_even_phase((l == 0) ? x : H, HN, (const float*)(ws + WS_WDT) + (size_t)j * D * 16, args.in[I_M2_DT_BIAS] + j * 16, DT, lds, tid, lane, wave, bid, G); SEAM(); }
            if (IN(pb + 1)) { PHASE_IDS();
                pg8::StaticOrder S; S.init(HN, (const bf16*)(ws + WS_WIN) + (size_t)j * EINP * D, T, EINP, D, G, bid);
                pg8::EpiBf16 E{PROJ, EINP};
                pg8::gemm_phase<pg8::EpiBf16, pg8::StaticOrder, true, true>(lds, D, S, E, wave_s);
                SEAM();
            }
            if (IN(pb + 2)) { PHASE_IDS(); conv_phase(PROJ, args.in[I_M2_CONV_W] + (size_t)j * 5 * M2XBC, args.in[I_M2_CONV_B] + (size_t)j * M2XBC, XBC, tid, bid, G); SEAM(); }
            if (IN(pb + 3)) { PHASE_IDS();
                for (int it = bid; it < 512; it += G) {
                    if (it < 256) scan_item<0>(it, PROJ, XBC, DT, (const float*)(ws + WS_WDT + 512 * 1024) + j * HGW, nullptr, OA, lds, tid);
                    else scan_item<1>(it - 256, PROJ, XBC, DT, nullptr, args.in[I_M2_A_LOG] + j * 16, YA, lds, tid);
                }
                SEAM();
            }
            if (IN(pb + 4)) { PHASE_IDS(); combine_even_phase(PROJ, XBC, OA, YA, args.in[I_HG_NORM_W] + j * HGW, args.in[I_M2_D] + j * M2H, args.in[I_M2_NORM_W] + j * M2I, MIX, lane, wave, bid, G); SEAM(); }
            if (IN(pb + 5)) { PHASE_IDS();
                pg8::StaticOrder S; S.init(MIX, (const bf16*)(ws + WS_WOUT) + (size_t)j * D * D, T, D, D, G, bid);
                pg8::EpiResF32 E{H, (l == 0) ? x : H, D};
                pg8::gemm_phase<pg8::EpiResF32, pg8::StaticOrder, true, true>(lds, D, S, E, wave_s);
                SEAM();
            }
            if (IN(pb + 6)) { PHASE_IDS(); norm_phase(H, HN, lane, wave, bid, G); SEAM(); }
            if (IN(pb + 7)) { PHASE_IDS();
                pg8::StaticOrder S; S.init(HN, (const bf16*)(ws + WS_WGU) + (size_t)j * 2 * FF * D, T, 2 * FF, D, G, bid);
                pg8::EpiSwiGLU E{ACT, FF};
                pg8::gemm_phase<pg8::EpiSwiGLU, pg8::StaticOrder, true, true>(lds, D, S, E, wave_s);
                SEAM();
            }
            if (IN(pb + 8) && !EXP_ZERO_FFN) { PHASE_IDS();
                pg8::StaticOrder S; S.init(ACT, (const bf16*)(ws + WS_WDN) + (size_t)j * D * FF, T, D, FF, G, bid);
                pg8::EpiResF32 E{H, H, D};
                pg8::gemm_phase<pg8::EpiResF32, pg8::StaticOrder, true, true>(lds, FF, S, E, wave_s);
                SEAM();
            }
            if (IN(pb + 9)) { PHASE_IDS(); norm_phase(H, HN, lane, wave, bid, G); SEAM(); }
        } else {
            if (IN(pb + 0)) { PHASE_IDS(); norm_phase(H, HN, lane, wave, bid, G); SEAM(); }
            if (IN(pb + 1)) { PHASE_IDS();
                for (int it = wave * G + bid; it < NB * S5G * 2; it += G * NWAVES) s5_item(it, j, args, args.in[I_NORM_MIX] + l * D, HN, YS, lane);
                SEAM();
            }
            if (IN(pb + 2)) { PHASE_IDS(); combine_s5_phase(H, args.in[I_NORM_MIX] + l * D, args.in[I_S5_D] + j * D, YS, MIX, lane, wave, bid, G); SEAM(); }
            if (IN(pb + 3)) { PHASE_IDS();
                pg8::StaticOrder S; S.init(MIX, (const bf16*)(ws + WS_WGLU) + (size_t)j * 2 * D * D, T, 2 * D, D, G, bid);
                float sclg = EXP_ZERO_GLU ? 0.f : 1.f; asm volatile("" : "+s"(sclg)); pg8::EpiGluRes E{H, D, sclg};
                pg8::gemm_phase<pg8::EpiGluRes, pg8::StaticOrder, true, true>(lds, D, S, E, wave_s);
                SEAM();
            }
            if (IN(pb + 4)) { PHASE_IDS(); router_phase(H, HN, (const float*)(ws + WS_WDT + 256 * 1024) + (size_t)j * D * 8, SEL, GATE, CNT, lds, tid, lane, wave, bid, G); SEAM(); }
            if (IN(pb + 5)) { PHASE_IDS(); scatter_phase(HN, SEL, CNT, SLOT, SEGB, XBUF, lds, tid, lane, wave, bid, G); SEAM(); }
            if (IN(pb + 6)) { PHASE_IDS();
                pg8::MoeOrder S; S.init(XBUF, (const bf16*)(ws + WS_WMGU) + (size_t)j * NE * 2 * FF * D, SEGB, 2 * FF, D, G, bid);
                pg8::EpiSwiGLU E{ACT, FF};
                pg8::gemm_phase<pg8::EpiSwiGLU, pg8::MoeOrder, true, true>(lds, D, S, E, wave_s);
                SEAM();
            }
            if (IN(pb + 7)) { PHASE_IDS();
                pg8::MoeOrder S; S.init(ACT, (const bf16*)(ws + WS_WMDN) + (size_t)j * NE * D * FF, SEGB, D, FF, G, bid);
                pg8::EpiResF32 E{YBUF, nullptr, D};
                pg8::gemm_phase<pg8::EpiResF32, pg8::MoeOrder, true, true>(lds, FF, S, E, wave_s);
                SEAM();
            }
#if EXP_PROBE
            if (IN(pb + 8) && l == EXP_PROBE_LAYER) { PHASE_IDS(); probe_moe(H, args.in[I_NORM_FFN] + l * D, args.in[I_MOE_ROUTER] + (size_t)j * D * 8, args.in[I_MOE_W_GU] + (size_t)j * NE * D * 2 * FF, args.in[I_MOE_W_DOWN] + (size_t)j * NE * FF * D, SEL, SLOT, YBUF, (int*)(ws + WS_CTL) + 64, lds, tid, lane, wave, bid); __syncthreads(); }
#endif
            if (IN(pb + 9)) { PHASE_IDS(); moe_combine_norm_phase(H, YBUF, GATE, SLOT, HN, lane, wave, bid, G, SEGB, (int*)(ws + WS_CTL) + 64, ((EXP_ZERO_MOE >> j) & 1) ? 0.f : 1.f); SEAM(); }
        }
        if (IN(pb + 10)) { PHASE_IDS();
            pg8::StaticOrder S; S.init(HN, (const bf16*)(ws + WS_WPG) + (size_t)l * D * D, T, D, D, G, bid);
            float sclp = EXP_ZERO_PLE ? 0.f : 1.f; asm volatile("" : "+s"(sclp)); pg8::EpiPle E{H, PP + (size_t)l * T * D, D, sclp};
            pg8::gemm_phase<pg8::EpiPle, pg8::StaticOrder, true, true>(lds, D, S, E, wave_s);
            SEAM();
        }
    }
    if (IN(N_PHASES - 1)) { PHASE_IDS(); final_phase(H, args.in[I_FINAL_NORM], args.out, lane, wave, bid, G, (const int*)(ws + WS_CTL) + 64); }
#undef IN
#undef SEAM
#undef PHASE_IDS
}
#undef H
#undef HN
#undef MIX
#undef PB
#undef PP
#undef XBUF
#undef YBUF
#undef DT
#undef SEL
#undef SLOT
#undef GATE
#undef CNT
#undef SEGB
#undef PROJ
#undef XBC
#undef OA
#undef YA
#undef ACT
#undef YS


extern "C" void kernel_launch(void* const* d_in, const int* in_sizes, int n_in, void* d_out, int out_size, void* d_ws, size_t ws_size, hipStream_t stream) {
    static int grid = 0;
    if (grid == 0) {
        if (n_in != N_IN || in_sizes[0] != T * D || out_size != T * D || ws_size < WS_END) { fprintf(stderr, "kernel_launch: unexpected problem (n_in %d, in0 %d, out %d, ws %zu < %zu); nothing launched\n", n_in, n_in > 0 ? in_sizes[0] : -1, out_size, ws_size, (size_t)WS_END); grid = -1; return; }
        int dev = 0, cus = 0, per_cu = 0;
        if (hipGetDevice(&dev) != hipSuccess || hipDeviceGetAttribute(&cus, hipDeviceAttributeMultiprocessorCount, dev) != hipSuccess) { fprintf(stderr, "kernel_launch: device query failed\n"); grid = -1; return; }
        if (hipFuncSetAttribute((const void*)fwd, hipFuncAttributeMaxDynamicSharedMemorySize, LDS_BYTES) != hipSuccess) { fprintf(stderr, "kernel_launch: hipFuncSetAttribute failed\n"); grid = -1; return; }
        if (hipOccupancyMaxActiveBlocksPerMultiprocessor(&per_cu, (const void*)fwd, NTHR, LDS_BYTES) != hipSuccess || per_cu < 1) { fprintf(stderr, "kernel_launch: occupancy query reports %d workgroups per CU\n", per_cu); (void)hipGetLastError(); per_cu = 1; }
        grid = cus;
    }
    if (grid < 0) return;
    if (hipMemsetAsync((char*)d_ws + WS_CTL, 0, CTL_ZERO_BYTES, stream) != hipSuccess) { fprintf(stderr, "kernel_launch: memset failed\n"); return; }
    Args a{};
    for (int i = 0; i < N_IN; ++i) a.in[i] = (const float*)d_in[i];
    a.out = (float*)d_out; a.ws = (unsigned char*)d_ws;
#if MK_ONE_LAUNCH
    a.ph_lo = 0; a.ph_hi = N_PHASES;
    hipLaunchKernelGGL(fwd, dim3(grid), dim3(NTHR), LDS_BYTES, stream, a);
    { const hipError_t le = hipPeekAtLastError(); if (le != hipSuccess) fprintf(stderr, "kernel_launch: launch failed: %s\n", hipGetErrorName(le)); }
#else
    for (int ph = 0; ph < N_PHASES; ++ph) {
        const int rel = ph - PH_LAYER0, l = rel >= 0 ? rel / PH_PER_LAYER : -1, slot = rel >= 0 ? rel % PH_PER_LAYER : -1;
        if (l >= 0 && l < DEPTH) { if ((l & 1) && slot == 8 && !(EXP_PROBE && l == EXP_PROBE_LAYER)) continue; }
        a.ph_lo = ph; a.ph_hi = ph + 1;
        hipLaunchKernelGGL(fwd, dim3(grid), dim3(NTHR), LDS_BYTES, stream, a);
        const hipError_t le = hipPeekAtLastError(); if (le != hipSuccess) { fprintf(stderr, "kernel_launch: launch of phase %d failed: %s\n", ph, hipGetErrorName(le)); break; }
    }
#endif
}
```

```cpp
#include <hip/hip_runtime.h>
#include <cstdio>
#include <cstdint>

namespace pg8 {
#define PG8_LAS __attribute__((address_space(3)))
typedef unsigned short bf16_t;
typedef short bf16x8 __attribute__((ext_vector_type(8)));
typedef float f32x4 __attribute__((ext_vector_type(4)));
typedef float f32x2 __attribute__((ext_vector_type(2)));
typedef unsigned u32x4 __attribute__((ext_vector_type(4)));
typedef unsigned u32x2 __attribute__((ext_vector_type(2)));
constexpr int BM = 256, BK = 64, HALF = 128, HTB = HALF * BK * 2  , STAGE_BYTES = 8 * HTB, NXCD = 8, WGM = 8;

__host__ __device__ __forceinline__ int lds_byte(int r, int c) { const int st = (r >> 4) * 2 + (c >> 5), rr = r & 15, cc = c & 31, ob = rr * 64 + cc * 2; return st * 1024 + (ob ^ (((ob >> 9) & 1) << 5)); }
__host__ __device__ __forceinline__ void stage_rc(int b, int& R, int& C) { const int st = b / 1024, sb = b % 1024, swz = sb ^ (((sb >> 9) & 1) << 5); R = (st >> 1) * 16 + swz / 64; C = (st & 1) * 32 + (swz % 64) / 2; }
__host__ __device__ __forceinline__ int perm32(int rho) { const int n = rho >> 4, i = rho & 15; return 8 * (i >> 2) + 4 * n + (i & 3); }

struct Unit { int pm, pn; const char* A; const char* B; };

struct StaticOrder {
    int nM, nN, nwg, G, c; const char* A; const char* Bt; size_t tstep;
    __device__ void init(const bf16_t* A_, const bf16_t* Bt_, int M, int N, int K, int G_, int c_) { nM = M / BM; nN = N / BM; nwg = nM * nN; G = G_; c = c_; A = (const char*)A_; Bt = (const char*)Bt_; tstep = (size_t)BM * K * 2; }
    __device__ bool next(int i, Unit& u) const {
        const long L = (long)i * G + c; if (L >= nwg) return false;
        int wgid = (int)L; { const int q = nwg / NXCD, r = nwg % NXCD, xcd = wgid % NXCD, off = wgid / NXCD; wgid = (xcd < r ? xcd * (q + 1) : r * (q + 1) + (xcd - r) * q) + off; }
        const int nig = WGM * nN, gid = wgid / nig, fm = gid * WGM, gsz = (nM - fm) < WGM ? (nM - fm) : WGM;
        u.pm = fm + ((wgid % nig) % gsz); u.pn = (wgid % nig) / gsz; u.A = A + (size_t)u.pm * tstep; u.B = Bt + (size_t)u.pn * tstep; return true;
    }
    __device__ __forceinline__ void a_ready(const Unit&) const {}
    __device__ __forceinline__ void done(const Unit&) const {}
};
struct MoeOrder {
    int nM, nN, nwg, G, c; const char* A; const char* Bt; size_t tstep, estride; int s1, s2, s3, s4, s5, s6, s7;
    __device__ void init(const bf16_t* A_, const bf16_t* Bt_, const int* seg, int N, int K, int G_, int c_) { nM = __builtin_amdgcn_readfirstlane(seg[8]) / BM; nN = N / BM; nwg = nM * nN; G = G_; c = c_; A = (const char*)A_; Bt = (const char*)Bt_; tstep = (size_t)BM * K * 2; estride = (size_t)N * K * 2;
        s1 = __builtin_amdgcn_readfirstlane(seg[1]); s2 = __builtin_amdgcn_readfirstlane(seg[2]); s3 = __builtin_amdgcn_readfirstlane(seg[3]); s4 = __builtin_amdgcn_readfirstlane(seg[4]);
        s5 = __builtin_amdgcn_readfirstlane(seg[5]); s6 = __builtin_amdgcn_readfirstlane(seg[6]); s7 = __builtin_amdgcn_readfirstlane(seg[7]); }
    __device__ bool next(int i, Unit& u) const {
        const long L = (long)i * G + c; if (L >= nwg) return false;
        int wgid = (int)L; { const int q = nwg / NXCD, r = nwg % NXCD, xcd = wgid % NXCD, off = wgid / NXCD; wgid = (xcd < r ? xcd * (q + 1) : r * (q + 1) + (xcd - r) * q) + off; }
        const int nig = WGM * nN, gid = wgid / nig, fm = gid * WGM, gsz = (nM - fm) < WGM ? (nM - fm) : WGM;
        u.pm = fm + ((wgid % nig) % gsz); u.pn = (wgid % nig) / gsz;
        const int r0 = u.pm * BM; const int e = (r0 >= s1) + (r0 >= s2) + (r0 >= s3) + (r0 >= s4) + (r0 >= s5) + (r0 >= s6) + (r0 >= s7);
        u.A = A + (size_t)u.pm * tstep; u.B = Bt + (size_t)e * estride + (size_t)u.pn * tstep; return true;
    }
    __device__ __forceinline__ void a_ready(const Unit&) const {}
    __device__ __forceinline__ void done(const Unit&) const {}
};

struct StackOrder {
    int nM, nN, nwg, G, c, tpl; const char* A; const char* Bt; size_t tstep, lstride;
    __device__ void init(const bf16_t* A_, const bf16_t* Bt_, int M, int N, int K, int log2TilesPerL, int G_, int c_) { nM = M / BM; nN = N / BM; nwg = nM * nN; G = G_; c = c_; tpl = log2TilesPerL; A = (const char*)A_; Bt = (const char*)Bt_; tstep = (size_t)BM * K * 2; lstride = (size_t)N * K * 2; }
    __device__ bool next(int i, Unit& u) const {
        const long L = (long)i * G + c; if (L >= nwg) return false;
        int wgid = (int)L; { const int q = nwg / NXCD, r = nwg % NXCD, xcd = wgid % NXCD, off = wgid / NXCD; wgid = (xcd < r ? xcd * (q + 1) : r * (q + 1) + (xcd - r) * q) + off; }
        const int nig = WGM * nN, gid = wgid / nig, fm = gid * WGM, gsz = (nM - fm) < WGM ? (nM - fm) : WGM;
        u.pm = fm + ((wgid % nig) % gsz); u.pn = (wgid % nig) / gsz;
        u.A = A + (size_t)u.pm * tstep; u.B = Bt + (size_t)(u.pm >> tpl) * lstride + (size_t)u.pn * tstep; return true;
    }
    __device__ __forceinline__ void a_ready(const Unit&) const {}
    __device__ __forceinline__ void done(const Unit&) const {}
};

__device__ __forceinline__ unsigned cvt_pk_bf16(float lo, float hi) { unsigned r; asm volatile("v_cvt_pk_bf16_f32 %0, %1, %2" : "=v"(r) : "v"(lo), "v"(hi)); return r; }
__device__ __forceinline__ float sigmoid_f(float x) { return 1.0f / (1.0f + __expf(-x)); }

struct EpiBf16 {
    static constexpr bool PERM = true, AFTER_DRAIN = false;
    bf16_t* O; int ldc;
    __device__ __forceinline__ void operator()(const f32x4 (&acc)[2][2][4][2], const Unit& u, int wr, int wc, int fr, int fq) const {
        const int row0 = u.pm * BM + wr * 64 + fr, col0 = u.pn * BM + wc * 32 + 8 * fq;
#pragma unroll
        for (int ai = 0; ai < 2; ++ai)
#pragma unroll
            for (int m = 0; m < 4; ++m) { bf16_t* rowp = O + (size_t)(row0 + ai * HALF + m * 16) * ldc + col0;
#pragma unroll
                for (int bj = 0; bj < 2; ++bj) { const f32x4 v0 = acc[ai][bj][m][0], v1 = acc[ai][bj][m][1];
                    u32x4 w; w.x = cvt_pk_bf16(v0[0], v0[1]); w.y = cvt_pk_bf16(v0[2], v0[3]); w.z = cvt_pk_bf16(v1[0], v1[1]); w.w = cvt_pk_bf16(v1[2], v1[3]);
                    *(u32x4*)(rowp + bj * HALF) = w; } }
    }
};
struct EpiSwiGLU {
    static constexpr bool PERM = true, AFTER_DRAIN = false;
    bf16_t* O; int ldc;
    __device__ __forceinline__ void operator()(const f32x4 (&acc)[2][2][4][2], const Unit& u, int wr, int wc, int fr, int fq) const {
        const int row0 = u.pm * BM + wr * 64 + fr, col0 = u.pn * HALF + wc * 32 + 8 * fq;
#pragma unroll
        for (int ai = 0; ai < 2; ++ai)
#pragma unroll
            for (int m = 0; m < 4; ++m) { bf16_t* rowp = O + (size_t)(row0 + ai * HALF + m * 16) * ldc + col0;
                f32x4 v[2];
#pragma unroll
                for (int n = 0; n < 2; ++n) { const f32x4 g = acc[ai][0][m][n], uu = acc[ai][1][m][n];
#pragma unroll
                    for (int j = 0; j < 4; ++j) v[n][j] = g[j] * sigmoid_f(g[j]) * uu[j]; }
                u32x4 w; w.x = cvt_pk_bf16(v[0][0], v[0][1]); w.y = cvt_pk_bf16(v[0][2], v[0][3]); w.z = cvt_pk_bf16(v[1][0], v[1][1]); w.w = cvt_pk_bf16(v[1][2], v[1][3]);
                *(u32x4*)rowp = w; }
    }
};
struct EpiResF32 {
    static constexpr bool PERM = false, AFTER_DRAIN = false;
    float* C; const float* res; int ldc;
    __device__ __forceinline__ void operator()(const f32x4 (&acc)[2][2][4][2], const Unit& u, int wr, int wc, int fr, int fq) const {
        const int row0 = u.pm * BM + wr * 64 + fr, col0 = u.pn * BM + wc * 32 + 4 * fq;
#pragma unroll
        for (int ai = 0; ai < 2; ++ai)
#pragma unroll
            for (int m = 0; m < 4; ++m) { const size_t off = (size_t)(row0 + ai * HALF + m * 16) * ldc + col0;
#pragma unroll
                for (int bj = 0; bj < 2; ++bj)
#pragma unroll
                    for (int n = 0; n < 2; ++n) { f32x4 o = acc[ai][bj][m][n]; if (res) o += *(const f32x4*)(res + off + bj * HALF + n * 16); *(f32x4*)(C + off + bj * HALF + n * 16) = o; }
                asm volatile("" ::: "memory"); }
    }
};
struct EpiGluRes {
    static constexpr bool PERM = false, AFTER_DRAIN = false;
    float* C; int ldc; float scl;
    __device__ __forceinline__ void operator()(const f32x4 (&acc)[2][2][4][2], const Unit& u, int wr, int wc, int fr, int fq) const {
        const int row0 = u.pm * BM + wr * 64 + fr, col0 = u.pn * HALF + wc * 32 + 4 * fq;
#pragma unroll
        for (int ai = 0; ai < 2; ++ai)
#pragma unroll
            for (int m = 0; m < 4; ++m) { float* rowp = C + (size_t)(row0 + ai * HALF + m * 16) * ldc + col0;
#pragma unroll
                for (int n = 0; n < 2; ++n) { const f32x4 o = acc[ai][0][m][n], g = acc[ai][1][m][n]; f32x4 h = *(const f32x4*)(rowp + n * 16);
#pragma unroll
                    for (int j = 0; j < 4; ++j) h[j] += o[j] * sigmoid_f(g[j]) * scl;
                    *(f32x4*)(rowp + n * 16) = h; }
                asm volatile("" ::: "memory"); }
    }
};
struct EpiPle {
    static constexpr bool PERM = false, AFTER_DRAIN = false;
    float* C; const bf16_t* P; int ldc; float scl;
    __device__ __forceinline__ void operator()(const f32x4 (&acc)[2][2][4][2], const Unit& u, int wr, int wc, int fr, int fq) const {
        const int row0 = u.pm * BM + wr * 64 + fr, col0 = u.pn * BM + wc * 32 + 4 * fq;
#pragma unroll
        for (int ai = 0; ai < 2; ++ai)
#pragma unroll
            for (int m = 0; m < 4; ++m) { const size_t off = (size_t)(row0 + ai * HALF + m * 16) * ldc + col0;
#pragma unroll
                for (int bj = 0; bj < 2; ++bj)
#pragma unroll
                    for (int n = 0; n < 2; ++n) { const f32x4 a = acc[ai][bj][m][n]; const u32x2 pw = *(const u32x2*)(P + off + bj * HALF + n * 16); f32x4 h = *(const f32x4*)(C + off + bj * HALF + n * 16);
                        h[0] += sigmoid_f(a[0]) * __uint_as_float(pw.x << 16) * scl; h[1] += sigmoid_f(a[1]) * __uint_as_float(pw.x & 0xffff0000u) * scl;
                        h[2] += sigmoid_f(a[2]) * __uint_as_float(pw.y << 16) * scl; h[3] += sigmoid_f(a[3]) * __uint_as_float(pw.y & 0xffff0000u) * scl;
                        *(f32x4*)(C + off + bj * HALF + n * 16) = h; }
                asm volatile("" ::: "memory"); }
    }
};

template <class Epi, class Sched, bool ALIGN_EPI = false, bool SP2 = false>
__device__ __forceinline__ void gemm_phase(PG8_LAS unsigned char* lds, const int K, const Sched& S, const Epi& E, const int wave_s  ) {
    int tid_ = wave_s * 64 + (int)__builtin_amdgcn_mbcnt_hi(~0u, __builtin_amdgcn_mbcnt_lo(~0u, 0u)); asm volatile("" : "+v"(tid_));
    const int tid = tid_, wid = wave_s, lane = tid & 63, wr = wid >> 2, wc = wid & 3, fr = lane & 15, fq = lane >> 4;
    const int nt = K / BK;
    unsigned voffA[2], voffB[2];
#pragma unroll
    for (int i = 0; i < 2; ++i) { int R, C; stage_rc(tid * 16 + i * 8192, R, C); const int Rb = Epi::PERM ? ((R & ~31) + perm32(R & 31)) : R;
        voffA[i] = (unsigned)(R * K + C) * 2u; voffB[i] = (unsigned)(Rb * K + C) * 2u; }
    const size_t kstep = (size_t)(BK * 2);
    const size_t hstep = (size_t)HALF * K * 2;
    const unsigned ldsw = (unsigned)wid * 1024u;
    const int aoff = lds_byte(wr * 64 + fr, fq * 8), boff = lds_byte(wc * 32 + fr, fq * 8);
#define PG8_SA(b, h) (((b) * 2 + (h)) * HTB)
#define PG8_SB(b, h) ((4 + (b) * 2 + (h)) * HTB)
#define PG8_STAGE(bufoff, gbase, voff) do { _Pragma("unroll") for (int _i = 0; _i < 2; ++_i) \
        __builtin_amdgcn_global_load_lds((const unsigned*)((const char*)(gbase) + (voff)[_i]), (PG8_LAS unsigned*)(lds + (bufoff) + ldsw + _i * 8192), 16, 0, 0); } while (0)
#define PG8_LDA(dst, b, h) do { _Pragma("unroll") for (int m = 0; m < 4; ++m) _Pragma("unroll") for (int k = 0; k < 2; ++k) dst[m][k] = *(const PG8_LAS bf16x8*)(lds + PG8_SA(b, h) + aoff + m * 2048 + k * 1024); } while (0)
#define PG8_LDB(dst, b, h) do { _Pragma("unroll") for (int n = 0; n < 2; ++n) _Pragma("unroll") for (int k = 0; k < 2; ++k) dst[n][k] = *(const PG8_LAS bf16x8*)(lds + PG8_SB(b, h) + boff + n * 2048 + k * 1024); } while (0)
#define PG8_MMA(ai, bj, At, Bt) do { __builtin_amdgcn_s_setprio(1); _Pragma("unroll") for (int m = 0; m < 4; ++m) _Pragma("unroll") for (int n = 0; n < 2; ++n) _Pragma("unroll") for (int k = 0; k < 2; ++k) \
        acc[ai][bj][m][n] = __builtin_amdgcn_mfma_f32_16x16x32_bf16(Bt[n][k], At[m][k], acc[ai][bj][m][n], 0, 0, 0); __builtin_amdgcn_s_setprio(0); } while (0)
#define PG8_WAIT_V(n) asm volatile("s_waitcnt vmcnt(" #n ")" ::: "memory")
#define PG8_WAIT_L(n) asm volatile("s_waitcnt lgkmcnt(" #n ")" ::: "memory")
#define PG8_BAR __builtin_amdgcn_s_barrier()
#define PG8_SCHED __builtin_amdgcn_sched_barrier(0)
    Unit cur, nxt; int ui = 0;
    if (!S.next(0, cur)) return;
    f32x4 acc[2][2][4][2];
#pragma unroll
    for (int a = 0; a < 2; ++a)
#pragma unroll
        for (int b = 0; b < 2; ++b)
#pragma unroll
            for (int m = 0; m < 4; ++m)
#pragma unroll
                for (int n = 0; n < 2; ++n) acc[a][b][m][n] = (f32x4){0.f, 0.f, 0.f, 0.f};
    bf16x8 At[4][2], B0[2][2], B1[2][2];
    const char* cA = cur.A; const char* cB = cur.B;
    S.a_ready(cur);
    if constexpr (SP2) {
        PG8_STAGE(PG8_SB(0, 0), cB, voffB); PG8_STAGE(PG8_SB(0, 1), cB + hstep, voffB); PG8_STAGE(PG8_SA(0, 0), cA, voffA); PG8_STAGE(PG8_SA(0, 1), cA + hstep, voffA);
        if (wr == 1) PG8_BAR;
        PG8_WAIT_V(2); PG8_BAR;
        PG8_STAGE(PG8_SB(1, 0), cB + kstep, voffB); PG8_STAGE(PG8_SA(1, 0), cA + kstep, voffA); PG8_STAGE(PG8_SB(1, 1), cB + hstep + kstep, voffB);
        PG8_WAIT_V(6); PG8_BAR;
    } else {
        PG8_STAGE(PG8_SB(0, 0), cB, voffB); PG8_STAGE(PG8_SA(0, 0), cA, voffA); PG8_STAGE(PG8_SB(0, 1), cB + hstep, voffB); PG8_STAGE(PG8_SA(0, 1), cA + hstep, voffA);
        if (wr == 1) PG8_BAR;
        PG8_WAIT_V(4); PG8_BAR;
        PG8_STAGE(PG8_SB(1, 0), cB + kstep, voffB); PG8_STAGE(PG8_SA(1, 0), cA + kstep, voffA); PG8_STAGE(PG8_SB(1, 1), cB + hstep + kstep, voffB);
        PG8_WAIT_V(6); PG8_BAR;
    }
    for (;;) {
        const bool has_next = S.next(ui + 1, nxt);
        const char* nA = has_next ? nxt.A : cA; const char* nB = has_next ? nxt.B : cB;
        for (int t = 0; t < nt; t += 2) {
            const bool last = (t == nt - 2);
            const char* a1 = cA + (size_t)(t + 1) * kstep;
            const char* a2 = last ? nA : cA + (size_t)(t + 2) * kstep; const char* b2 = last ? nB : cB + (size_t)(t + 2) * kstep;
            const char* a3 = a2 + kstep; const char* b3 = b2 + kstep;
            if (last && has_next) S.a_ready(nxt);
            if constexpr (SP2) {
            PG8_LDB(B0, 0, 0); PG8_LDB(B1, 0, 1); PG8_SCHED; PG8_LDA(At, 0, 0); PG8_STAGE(PG8_SA(1, 1), a1 + hstep, voffA);
            PG8_WAIT_V(8); PG8_WAIT_L(0); PG8_BAR; PG8_MMA(0, 0, At, B0); PG8_MMA(0, 1, At, B1); PG8_BAR; PG8_SCHED;
            PG8_LDA(At, 0, 1); PG8_STAGE(PG8_SB(0, 0), b2, voffB); PG8_STAGE(PG8_SB(0, 1), b2 + hstep, voffB); PG8_STAGE(PG8_SA(0, 0), a2, voffA);
            PG8_WAIT_V(8); PG8_WAIT_L(0); PG8_BAR; PG8_MMA(1, 0, At, B0); PG8_MMA(1, 1, At, B1); PG8_BAR; PG8_SCHED;
            PG8_LDB(B0, 1, 0); PG8_LDB(B1, 1, 1); PG8_SCHED; PG8_LDA(At, 1, 0); PG8_STAGE(PG8_SA(0, 1), a2 + hstep, voffA);
            PG8_WAIT_V(8); PG8_WAIT_L(0); PG8_BAR; PG8_MMA(0, 0, At, B0); PG8_MMA(0, 1, At, B1); PG8_BAR; PG8_SCHED;
            PG8_LDA(At, 1, 1); PG8_STAGE(PG8_SB(1, 0), b3, voffB); PG8_STAGE(PG8_SB(1, 1), b3 + hstep, voffB); PG8_STAGE(PG8_SA(1, 0), a3, voffA);
            PG8_WAIT_V(8); PG8_WAIT_L(0); PG8_BAR; PG8_MMA(1, 0, At, B0); PG8_MMA(1, 1, At, B1); PG8_BAR; PG8_SCHED;
            } else {
            PG8_LDB(B0, 0, 0); PG8_SCHED; PG8_LDA(At, 0, 0); PG8_STAGE(PG8_SA(1, 1), a1 + hstep, voffA);
            PG8_WAIT_L(8); PG8_BAR; PG8_WAIT_L(0); PG8_MMA(0, 0, At, B0); PG8_BAR; PG8_SCHED;
            PG8_LDB(B1, 0, 1); PG8_STAGE(PG8_SB(0, 0), b2, voffB);
            PG8_BAR; PG8_WAIT_L(0); PG8_MMA(0, 1, At, B1); PG8_BAR;
            PG8_LDA(At, 0, 1); PG8_STAGE(PG8_SA(0, 0), a2, voffA);
            PG8_BAR; PG8_WAIT_L(0); PG8_MMA(1, 0, At, B0); PG8_BAR; PG8_SCHED;
            PG8_STAGE(PG8_SB(0, 1), b2 + hstep, voffB);
            PG8_WAIT_V(6); PG8_BAR; PG8_MMA(1, 1, At, B1); PG8_BAR;
            PG8_LDB(B0, 1, 0); PG8_SCHED; PG8_LDA(At, 1, 0); PG8_STAGE(PG8_SA(0, 1), a2 + hstep, voffA);
            PG8_WAIT_L(8); PG8_BAR; PG8_WAIT_L(0); PG8_MMA(0, 0, At, B0); PG8_BAR; PG8_SCHED;
            PG8_LDB(B1, 1, 1); PG8_STAGE(PG8_SB(1, 0), b3, voffB);
            PG8_BAR; PG8_WAIT_L(0); PG8_MMA(0, 1, At, B1); PG8_BAR;
            PG8_LDA(At, 1, 1); PG8_STAGE(PG8_SA(1, 0), a3, voffA);
            PG8_BAR; PG8_WAIT_L(0); PG8_MMA(1, 0, At, B0); PG8_BAR; PG8_SCHED;
            PG8_STAGE(PG8_SB(1, 1), b3 + hstep, voffB);
            PG8_WAIT_V(6); PG8_BAR; PG8_MMA(1, 1, At, B1); PG8_BAR;
            }
        }
        if constexpr (ALIGN_EPI) { if (wr == 0) PG8_BAR; }
        if constexpr (!Epi::AFTER_DRAIN) { E(acc, cur, wr, wc, fr, fq); S.done(cur); }
        if (!has_next) break;
#pragma unroll
        for (int a = 0; a < 2; ++a)
#pragma unroll
            for (int b = 0; b < 2; ++b)
#pragma unroll
                for (int m = 0; m < 4; ++m)
#pragma unroll
                    for (int n = 0; n < 2; ++n) acc[a][b][m][n] = (f32x4){0.f, 0.f, 0.f, 0.f};
        cur = nxt; cA = nA; cB = nB; ++ui;
        if constexpr (ALIGN_EPI) { if (wr == 1) PG8_BAR; }
    }
    PG8_WAIT_V(0);
    if constexpr (!ALIGN_EPI) { if (wr == 0) PG8_BAR; }
    PG8_BAR;
    if constexpr (Epi::AFTER_DRAIN) { E.fused(acc, cur, wr, wc, fr, fq, lds, wid, lane); S.done(cur); }
#undef PG8_SA
#undef PG8_SB
#undef PG8_STAGE
#undef PG8_LDA
#undef PG8_LDB
#undef PG8_MMA
#undef PG8_WAIT_V
#undef PG8_WAIT_L
#undef PG8_BAR
#undef PG8_SCHED
}
}

#ifndef EXP_ZERO_HG
#define EXP_ZERO_HG 0
#endif
#ifndef EXP_ZERO_S5
#define EXP_ZERO_S5 0
#endif
#ifndef EXP_ZERO_MOE
#define EXP_ZERO_MOE 0
#endif
#ifndef EXP_ZERO_FFN
#define EXP_ZERO_FFN 0
#endif
#ifndef EXP_PROBE
#define EXP_PROBE 0
#endif
#ifndef EXP_ZERO_GLU
#define EXP_ZERO_GLU 0
#endif
#ifndef EXP_ZERO_PLE
#define EXP_ZERO_PLE 0
#endif
#ifndef EXP_PROBE_LAYER
#define EXP_PROBE_LAYER 1
#endif
#ifndef EXP_ZERO_SSD
#define EXP_ZERO_SSD 0
#endif
constexpr int NB = 8, SEQ = 2048, D = 1024, T = NB * SEQ, DEPTH = 4, PLE = 256;
constexpr int HGH = 4, HGD = 128, HGW = 512;
constexpr int M2H = 8, M2P = 64, M2I = 512, M2N = 128, M2XBC = 1024;
constexpr int EIN = 4112, EINP = 4096;
constexpr int S5G = 64, S5N = 64, S5C = 16;
constexpr int FF = 3584, NE = 8;
constexpr int MOE_ROWS = 2 * T + NE * 256;
constexpr float EPS = 1e-6f;
constexpr int NWAVES = 8, NTHR = 512;

constexpr size_t MiB = 1u << 20;
constexpr size_t WS_CTL = 0, CTL_ZERO_BYTES = 1 * MiB;
constexpr size_t WS_WIN = 1 * MiB;
constexpr size_t WS_WOUT = WS_WIN + 16 * MiB;
constexpr size_t WS_WGU = WS_WOUT + 4 * MiB;
constexpr size_t WS_WDN = WS_WGU + 28 * MiB;
constexpr size_t WS_WGLU = WS_WDN + 14 * MiB;
constexpr size_t WS_WPG = WS_WGLU + 8 * MiB;
constexpr size_t WS_WPP = WS_WPG + 8 * MiB;
constexpr size_t WS_WMGU = WS_WPP + 2 * MiB;
constexpr size_t WS_WMDN = WS_WMGU + 224 * MiB;
constexpr size_t WS_WDT = WS_WMDN + 112 * MiB;
constexpr size_t WS_H = WS_WDT + 1 * MiB;
constexpr size_t WS_HN = WS_H + 64 * MiB;
constexpr size_t WS_MIX = WS_HN + 32 * MiB;
constexpr size_t WS_PB = WS_MIX + 32 * MiB;
constexpr size_t WS_PP = WS_PB + 32 * MiB;
constexpr size_t WS_XBUF = WS_PP + 128 * MiB;
constexpr size_t WS_YBUF = WS_XBUF + 68 * MiB;
constexpr size_t WS_DT = WS_YBUF + 136 * MiB;
constexpr size_t WS_ROUTE = WS_DT + 1 * MiB;
constexpr size_t WS_R = WS_ROUTE + 1 * MiB;
constexpr size_t WS_PROJ = WS_R, WS_XBC = WS_R + 128 * MiB, WS_OA = WS_R + 160 * MiB, WS_YA = WS_R + 224 * MiB, WS_ACT = WS_R, WS_YS = WS_R;
constexpr size_t WS_END = WS_R + 288 * MiB;
static_assert((size_t)MOE_ROWS * FF * 2 <= 288 * MiB && (size_t)MOE_ROWS * D * 2 <= 68 * MiB && (size_t)MOE_ROWS * D * 4 <= 136 * MiB, "ws map");
constexpr int CW_BAR = 4096;

constexpr int RING_BYTES = 131072;
constexpr int MISC_OFF = RING_BYTES;
constexpr int LDS_BYTES = 147456;

#define GAS __attribute__((address_space(1)))
#define LAS __attribute__((address_space(3)))
typedef unsigned short bf16;
typedef unsigned v4u __attribute__((ext_vector_type(4)));
typedef unsigned v2u __attribute__((ext_vector_type(2)));
typedef float f32x4 __attribute__((ext_vector_type(4)));
typedef int v4i __attribute__((ext_vector_type(4)));
#define LDS_WAIT() asm volatile("s_waitcnt lgkmcnt(0)" ::: "memory")
__device__ __forceinline__ unsigned f2bf(float f) { unsigned u = __builtin_bit_cast(unsigned, f); return (u + 0x7fffu + ((u >> 16) & 1u)) >> 16; }
__device__ __forceinline__ unsigned pk2(float lo, float hi) { return f2bf(lo) | (f2bf(hi) << 16); }
__device__ __forceinline__ float bflo(unsigned w) { return __uint_as_float(w << 16); }
__device__ __forceinline__ float bfhi(unsigned w) { return __uint_as_float(w & 0xffff0000u); }
__device__ __forceinline__ float bf1(bf16 b) { return __uint_as_float((unsigned)b << 16); }
__device__ __forceinline__ float sigm(float x) { return 1.0f / (1.0f + __expf(-x)); }
__device__ __forceinline__ float silu_f(float x) { return x * sigm(x); }
__device__ __forceinline__ float softplus_f(float x) { return x > 20.f ? x : log1pf(__expf(x)); }
__device__ __forceinline__ float gelu_tanh(float x) { const float u = 0.7978845608028654f * (x + 0.044715f * x * x * x); return 0.5f * x * (1.0f + tanhf(u)); }
__device__ __forceinline__ float sx(float v, int o, int lane) { return __builtin_bit_cast(float, __builtin_amdgcn_ds_bpermute((lane ^ o) << 2, __builtin_bit_cast(int, v))); }
__device__ __forceinline__ float wave_sum(float v, int lane) {
#pragma unroll
    for (int o = 1; o < 64; o <<= 1) v += sx(v, o, lane);
    return v;
}
#define XB_TMO      128
#define XB_XCNT(j)  (256  + 64 * (j))
#define XB_XSUB(j)  (1280 + 64 * (j))
#define XB_XGEN(j)  (2304 + 64 * (j))
#define XB_TOP      3328
#define XB_TOPGEN   3392
#define XCD_BAR_WORDS 3456
#define XB_SPIN_CAP (1u << 18)

__device__ __forceinline__ unsigned xb_ld(unsigned* p)              { return __hip_atomic_load(p, __ATOMIC_RELAXED, __HIP_MEMORY_SCOPE_AGENT); }
__device__ __forceinline__ unsigned xb_add(unsigned* p, unsigned v) { return __hip_atomic_fetch_add(p, v, __ATOMIC_RELAXED, __HIP_MEMORY_SCOPE_AGENT); }
__device__ __forceinline__ unsigned xb_xcc_id() { return (unsigned)__builtin_amdgcn_s_getreg((3 << 11) | 20) & 0xFu; }
#define XB_SPIN(cond, bar) do { unsigned _sp = 0; while (cond) { __builtin_amdgcn_s_sleep(1); \
    if ((++_sp & 255u) == 0u) { if (xb_ld(&(bar)[XB_TMO])) break; if (_sp > XB_SPIN_CAP) { atomicAdd(&(bar)[XB_TMO], 1u); break; } } } } while (0)

struct XcdBarrier {
    unsigned* bar; unsigned x;
    volatile LAS unsigned* st;
};

__device__ __forceinline__ XcdBarrier xcd_barrier_post(unsigned* bar, volatile LAS unsigned* st) {
    XcdBarrier b; b.bar = bar; b.x = xb_xcc_id(); b.st = st;
    if (threadIdx.x == 0) (void)xb_add(&bar[XB_XCNT(b.x)], 1u);
    return b;
}
__device__ __forceinline__ void xcd_barrier_complete(unsigned* bar, unsigned x, unsigned& nloc, unsigned& nx) {
    const unsigned G = gridDim.x * gridDim.y * gridDim.z;
    unsigned sum, cnt, mine, sp = 0u;
    for (;;) {
        sum = 0u; cnt = 0u; mine = 0u;
#pragma unroll
        for (unsigned j = 0; j < 16; ++j) { const unsigned c = xb_ld(&bar[XB_XCNT(j)]); sum += c; cnt += (c > 0u) ? 1u : 0u; mine = (j == x) ? c : mine; }
        if (sum == G) break;
        __builtin_amdgcn_s_sleep(1);
        if ((++sp & 255u) == 0u) { if (xb_ld(&bar[XB_TMO])) break; if (sp > XB_SPIN_CAP) { atomicAdd(&bar[XB_TMO], 1u); break; } }
    }
    nloc = mine > 0u ? mine : 1u; nx = cnt > 0u ? cnt : 1u;
}

__device__ __forceinline__ void xcd_barrier(const XcdBarrier& b) {
    asm volatile("s_waitcnt vmcnt(0)" ::: "memory");
    __syncthreads();
    if (threadIdx.x == 0) {
        unsigned* bar = b.bar;
        __builtin_amdgcn_s_waitcnt(0);
        unsigned nloc = b.st[0], nx = b.st[1];
        if (nloc == 0u) { xcd_barrier_complete(bar, b.x, nloc, nx); b.st[0] = nloc; b.st[1] = nx; }
        const unsigned old = xb_add(&bar[XB_XSUB(b.x)], 1u);
        const unsigned gen = old / nloc;
        if (old + 1u == (gen + 1u) * nloc) {
            __builtin_amdgcn_fence(__ATOMIC_RELEASE, "agent");
            asm volatile("s_waitcnt vmcnt(0)" ::: "memory");
            const unsigned og = xb_add(&bar[XB_TOP], 1u);
            const unsigned tg = og / nx;
            if (og + 1u == (tg + 1u) * nx) xb_add(&bar[XB_TOPGEN], 1u);
            else XB_SPIN(xb_ld(&bar[XB_TOPGEN]) == tg, bar);
            __builtin_amdgcn_fence(__ATOMIC_ACQUIRE, "agent");
            xb_add(&bar[XB_XGEN(b.x)], 1u);
            asm volatile("s_waitcnt vmcnt(0)" ::: "memory");
        } else {
            XB_SPIN(xb_ld(&bar[XB_XGEN(b.x)]) == gen, bar);
            __builtin_amdgcn_fence(__ATOMIC_ACQUIRE, "agent");
            asm volatile("s_waitcnt vmcnt(0)" ::: "memory");
        }
    }
    __syncthreads();
}


enum { I_X = 0, I_P, I_NORM_MIX, I_NORM_FFN, I_NORM_PLE, I_FINAL_NORM, I_PLE_GATE, I_PLE_PROJ, I_EV_W_IN, I_EV_W_OUT, I_HG_LB, I_HG_NORM_W, I_M2_CONV_W, I_M2_CONV_B, I_M2_DT_BIAS, I_M2_A_LOG, I_M2_D,
       I_M2_NORM_W, I_S5_A_RE, I_S5_A_IM, I_S5_LOG_STEP, I_S5_B_RE, I_S5_B_IM, I_S5_C_RE, I_S5_C_IM, I_S5_D, I_S5_GLU_W, I_FFN_W_GU, I_FFN_W_DOWN, I_MOE_ROUTER, I_MOE_W_GU, I_MOE_W_DOWN, N_IN };
struct Args { const float* in[N_IN]; float* out; unsigned char* ws; int ph_lo, ph_hi; };

__device__ __forceinline__ void transpose_item(const float* W, int K, int ldw, bf16* WT, int Ndst, int half, const float* scale, LAS float* scr, int item, int lane) {
    const int nblk = Ndst / 32, kb = item / nblk, nb = item % nblk, k0 = 64 * kb, n0 = 32 * nb;
    int s0 = n0;
    if (half) { const int tile = n0 >> 8, w = n0 & 255; s0 = (w < 128) ? (128 * tile + w) : (half + 128 * tile + (w - 128)); }
#pragma unroll 8
    for (int i = 0; i < 32; ++i) { const int kk = 2 * i + (lane >> 5); float x = W[(size_t)(k0 + kk) * ldw + s0 + (lane & 31)]; if (scale) x *= scale[k0 + kk]; scr[kk * 33 + (lane & 31)] = x; }
    LDS_WAIT(); asm volatile("" ::: "memory");
    const int c = lane & 7;
#pragma unroll
    for (int j = 0; j < 4; ++j) { const int n = (lane >> 3) + 8 * j; const LAS float* s = scr + (8 * c) * 33 + n;
        v4u o; o.x = pk2(s[0 * 33], s[1 * 33]); o.y = pk2(s[2 * 33], s[3 * 33]); o.z = pk2(s[4 * 33], s[5 * 33]); o.w = pk2(s[6 * 33], s[7 * 33]);
        *(v4u*)(WT + (size_t)(n0 + n) * K + k0 + 8 * c) = o; }
    LDS_WAIT(); asm volatile("" ::: "memory");
}
__device__ __forceinline__ void prologue_phase(const Args& a, unsigned char* ws, LAS unsigned char* lds, int tid, int lane, int wave, int bid, int G) {
    LAS float* scr = (LAS float*)(lds + wave * 16384);
    const int gw = bid * NWAVES + wave, NGW = G * NWAVES;
    constexpr int I_IN = 16 * 128, I_OUT = 16 * 32, I_GU = 16 * 224, I_DN = 56 * 32, I_GLU = 16 * 64, I_PG = 16 * 32, I_PPJ = 4 * 32;
    constexpr int N0 = 2 * I_IN, N1 = 2 * I_OUT, N2 = 2 * I_GU, N3 = 2 * I_DN, N4 = 2 * I_GLU, N5 = 4 * I_PG, N6 = 4 * I_PPJ, N7 = 16 * I_GU, N8 = 16 * I_DN;
    constexpr int NTOT = N0 + N1 + N2 + N3 + N4 + N5 + N6 + N7 + N8;
    for (int it = gw; it < NTOT; it += NGW) {
        int r = it;
        if (r < N0) { const int j = r / I_IN; transpose_item(a.in[I_EV_W_IN] + (size_t)j * D * EIN, D, EIN, (bf16*)(ws + WS_WIN) + (size_t)j * EINP * D, EINP, 0, a.in[I_NORM_MIX] + (2 * j) * D, scr, r % I_IN, lane); continue; } r -= N0;
        if (r < N1) { const int j = r / I_OUT; transpose_item(a.in[I_EV_W_OUT] + (size_t)j * D * D, D, D, (bf16*)(ws + WS_WOUT) + (size_t)j * D * D, D, 0, nullptr, scr, r % I_OUT, lane); continue; } r -= N1;
        if (r < N2) { const int j = r / I_GU; transpose_item(a.in[I_FFN_W_GU] + (size_t)j * D * 2 * FF, D, 2 * FF, (bf16*)(ws + WS_WGU) + (size_t)j * 2 * FF * D, 2 * FF, FF, a.in[I_NORM_FFN] + (2 * j) * D, scr, r % I_GU, lane); continue; } r -= N2;
        if (r < N3) { const int j = r / I_DN; transpose_item(a.in[I_FFN_W_DOWN] + (size_t)j * FF * D, FF, D, (bf16*)(ws + WS_WDN) + (size_t)j * D * FF, D, 0, nullptr, scr, r % I_DN, lane); continue; } r -= N3;
        if (r < N4) { const int j = r / I_GLU; transpose_item(a.in[I_S5_GLU_W] + (size_t)j * D * 2 * D, D, 2 * D, (bf16*)(ws + WS_WGLU) + (size_t)j * 2 * D * D, 2 * D, D, nullptr, scr, r % I_GLU, lane); continue; } r -= N4;
        if (r < N5) { const int l = r / I_PG; transpose_item(a.in[I_PLE_GATE] + (size_t)l * D * D, D, D, (bf16*)(ws + WS_WPG) + (size_t)l * D * D, D, 0, a.in[I_NORM_PLE] + l * D, scr, r % I_PG, lane); continue; } r -= N5;
        if (r < N6) { const int l = r / I_PPJ; transpose_item(a.in[I_PLE_PROJ] + (size_t)l * PLE * D, PLE, D, (bf16*)(ws + WS_WPP) + (size_t)l * D * PLE, D, 0, nullptr, scr, r % I_PPJ, lane); continue; } r -= N6;
        if (r < N7) { const int je = r / I_GU, j = je >> 3; transpose_item(a.in[I_MOE_W_GU] + (size_t)je * D * 2 * FF, D, 2 * FF, (bf16*)(ws + WS_WMGU) + (size_t)je * 2 * FF * D, 2 * FF, FF, a.in[I_NORM_FFN] + (2 * j + 1) * D, scr, r % I_GU, lane); continue; } r -= N7;
        { const int je = r / I_DN; transpose_item(a.in[I_MOE_W_DOWN] + (size_t)je * FF * D, FF, D, (bf16*)(ws + WS_WMDN) + (size_t)je * D * FF, D, 0, nullptr, scr, r % I_DN, lane); }
    }
    const int gt = bid * NTHR + tid, NT = G * NTHR;
    { const f32x4* src = (const f32x4*)a.in[I_P]; v4u* dst = (v4u*)(ws + WS_PB);
      for (int i = gt; i < DEPTH * T * PLE / 8; i += NT) { const f32x4 x0 = src[2 * (size_t)i], x1 = src[2 * (size_t)i + 1]; v4u o; o.x = pk2(x0[0], x0[1]); o.y = pk2(x0[2], x0[3]); o.z = pk2(x1[0], x1[1]); o.w = pk2(x1[2], x1[3]); dst[i] = o; } }
    { float* wdt = (float*)(ws + WS_WDT);
      for (int i = gt; i < 2 * D * 16; i += NT) { const int j = i / (D * 16), c = (i / 16) % D, o = i % 16; wdt[i] = a.in[I_NORM_MIX][(2 * j) * D + c] * a.in[I_EV_W_IN][(size_t)j * D * EIN + (size_t)c * EIN + EINP + o]; }
      float* wr = (float*)(ws + WS_WDT + 256 * 1024);
      for (int i = gt; i < 2 * D * 8; i += NT) { const int j = i / (D * 8), c = (i / 8) % D, e = i % 8; wr[i] = a.in[I_NORM_FFN][(2 * j + 1) * D + c] * a.in[I_MOE_ROUTER][(size_t)j * D * 8 + c * 8 + e]; }
      float* lb = (float*)(ws + WS_WDT + 512 * 1024);
      for (int i = gt; i < HGW; i += NT) { const float l0 = a.in[I_HG_LB][i], l1 = a.in[I_HG_LB][HGW + i], m = fmaxf(l0, l1), e0 = expf(l0 - m), e1 = expf(l1 - m), s0 = e0 / (e0 + e1), s1 = e1 / (e0 + e1);
          lb[i] = s0 - s0; lb[HGW + i] = (s0 + s1) - s0; } }
}

__device__ __forceinline__ float load_row_rstd(const float* row, int lane, f32x4 (&v)[4]) {
    const f32x4* xr = (const f32x4*)row + lane; float s = 0.f;
#pragma unroll
    for (int j = 0; j < 4; ++j) { v[j] = xr[64 * j]; s += (v[j][0] * v[j][0] + v[j][1] * v[j][1]) + (v[j][2] * v[j][2] + v[j][3] * v[j][3]); }
    return 1.0f / sqrtf(wave_sum(s, lane) * (1.0f / D) + EPS);
}
__device__ __forceinline__ void store_row_bf16(bf16* orow, int lane, const f32x4 (&v)[4], float rstd) {
    unsigned long long* o8 = (unsigned long long*)orow + lane;
#pragma unroll
    for (int j = 0; j < 4; ++j) o8[64 * j] = (unsigned long long)pk2(v[j][0] * rstd, v[j][1] * rstd) | ((unsigned long long)pk2(v[j][2] * rstd, v[j][3] * rstd) << 32);
}
__device__ __forceinline__ void norm_phase(const float* src, bf16* HN, int lane, int wave, int bid, int G) {
    const int gw = bid * NWAVES + wave, NGW = G * NWAVES;
    for (int row = gw; row < T; row += NGW) { f32x4 v[4]; const float rstd = load_row_rstd(src + (size_t)row * D, lane, v); store_row_bf16(HN + (size_t)row * D, lane, v, rstd); }
}
__device__ __forceinline__ void norm_even_phase(const float* src, bf16* HN, const float* wdt  , const float* dt_bias  , float* DT, LAS unsigned char* lds, int tid, int lane, int wave, int bid, int G) {
    LAS float* wl = (LAS float*)lds;
    for (int i = tid; i < D * 16; i += NTHR) wl[(i & 15) * D + (i >> 4)] = wdt[i];
    __syncthreads();
    const int gw = bid * NWAVES + wave, NGW = G * NWAVES;
    for (int row = gw; row < T; row += NGW) {
        f32x4 v[4]; const float rstd = load_row_rstd(src + (size_t)row * D, lane, v); store_row_bf16(HN + (size_t)row * D, lane, v, rstd);
        float mine = 0.f;
#pragma nounroll
        for (int o = 0; o < 16; ++o) { float s = 0.f;
#pragma unroll
            for (int j = 0; j < 4; ++j) { const f32x4 w = *(const LAS f32x4*)(wl + o * D + 256 * j + 4 * lane); s += (v[j][0] * w[0] + v[j][1] * w[1]) + (v[j][2] * w[2] + v[j][3] * w[3]); }
            s = wave_sum(s, lane); mine = (lane == o) ? s : mine; }
        if (lane < 16) DT[(size_t)row * 16 + lane] = softplus_f(mine * rstd + dt_bias[lane]);
    }
    __syncthreads();
}
__device__ __forceinline__ void final_phase(const float* H, const float* w, float* out, int lane, int wave, int bid, int G, const int* diag = nullptr) {
    const int gw = bid * NWAVES + wave, NGW = G * NWAVES;
    for (int row = gw; row < T; row += NGW) { f32x4 v[4]; const float rstd = load_row_rstd(H + (size_t)row * D, lane, v);
        f32x4* o = (f32x4*)(out + (size_t)row * D) + lane; const f32x4* wv = (const f32x4*)w + lane;
#pragma unroll
        for (int j = 0; j < 4; ++j) o[64 * j] = v[j] * rstd * wv[64 * j] * (EXP_PROBE ? (float)(1 + diag[0]) : 1.0f); }
}

__device__ __forceinline__ void conv_phase(const bf16* PROJ, const float* cw, const float* cb, bf16* XBC, int tid, int bid, int G) {
    const size_t gt = (size_t)bid * NTHR + tid, NT = (size_t)G * NTHR;
    for (size_t idx = gt; idx < (size_t)T * 128; idx += NT) {
        const int t = (int)(idx >> 7), c = 8 * (int)(idx & 127), s = t & (SEQ - 1);
        float acc[8]; { const f32x4 b0 = *(const f32x4*)(cb + c), b1 = *(const f32x4*)(cb + c + 4); acc[0] = b0[0]; acc[1] = b0[1]; acc[2] = b0[2]; acc[3] = b0[3]; acc[4] = b1[0]; acc[5] = b1[1]; acc[6] = b1[2]; acc[7] = b1[3]; }
#pragma unroll
        for (int w = 0; w < 5; ++w) { const int ts = s + w - 2;
            if (ts >= 0 && ts < SEQ) { const v4u x = *(const v4u*)(PROJ + (size_t)(t + w - 2) * EINP + 3072 + c); const f32x4 k0 = *(const f32x4*)(cw + w * M2XBC + c), k1 = *(const f32x4*)(cw + w * M2XBC + c + 4);
                acc[0] += bflo(x.x) * k0[0]; acc[1] += bfhi(x.x) * k0[1]; acc[2] += bflo(x.y) * k0[2]; acc[3] += bfhi(x.y) * k0[3];
                acc[4] += bflo(x.z) * k1[0]; acc[5] += bfhi(x.z) * k1[1]; acc[6] += bflo(x.w) * k1[2]; acc[7] += bfhi(x.w) * k1[3]; } }
        v4u o; o.x = pk2(silu_f(acc[0]), silu_f(acc[1])); o.y = pk2(silu_f(acc[2]), silu_f(acc[3])); o.z = pk2(silu_f(acc[4]), silu_f(acc[5])); o.w = pk2(silu_f(acc[6]), silu_f(acc[7]));
        *(v4u*)(XBC + (size_t)t * M2XBC + c) = o;
    }
}
constexpr int TB = 16;
template <int MODE>
__device__ __forceinline__ void scan_item(int item, const bf16* PROJ, const bf16* XBC, const float* DT, const float* lbv  , const float* a_log  , float* OUT  , LAS unsigned char* lds, int tid) {
    LAS float* qs = (LAS float*)lds;
    LAS float* fs = qs + 2 * TB * 128;
    LAS float* ks = fs + 2 * TB * 128;
    LAS float* vs = ks + 2 * TB * 128;
    LAS float* sc = vs + 2 * TB * 32;
    LAS float* op = sc + 2 * TB * 2;
    const int part = MODE == 0 ? (item & 3) : (item & 1), dir = MODE == 0 ? ((item >> 2) & 1) : ((item >> 1) & 1), head = MODE == 0 ? ((item >> 3) & 3) : ((item >> 2) & 7), b = item >> 5;
    const int vv = tid & 31, dg = tid >> 5;
    const int si = tid >> 5, seg = tid & 31;
    const int colq = MODE == 0 ? head * 128 + 4 * seg : 3072 + 768 + (head >> 2) * 128 + 4 * seg;
    const int colf = MODE == 0 ? (dir == 0 ? 512 : 1024) + head * 128 + 4 * seg : 3072 + 512 + (head >> 2) * 128 + 4 * seg;
    const int colv = MODE == 0 ? 1536 + head * 128 + part * 32 + seg : 3072 + head * 64 + part * 32 + seg;
    float lb4[4] = {0.f, 0.f, 0.f, 0.f}; float Aneg = 0.f;
    if (MODE == 0) {
#pragma unroll
        for (int e = 0; e < 4; ++e) lb4[e] = lbv[head * 128 + 4 * seg + e];
    } else Aneg = -expf(a_log[dir * 8 + head]);
    float S[8];
#pragma unroll
    for (int e = 0; e < 8; ++e) S[e] = 0.f;
    constexpr int NBLK = SEQ / TB;
    v2u rq, rf; bf16 rv; float rdt = 0.f;
#define SCAN_TROW(blk, i) ((size_t)b * SEQ + (dir == 0 ? ((blk) * TB + (i)) : (SEQ - 1 - ((blk) * TB + (i)))))
#define SCAN_LOAD(blk) do { const size_t tr = SCAN_TROW(blk, si); \
        if (MODE == 0) { rq = *(const v2u*)(PROJ + tr * EINP + colq); rf = *(const v2u*)(PROJ + tr * EINP + colf); rv = PROJ[tr * EINP + colv]; } \
        else { rq = *(const v2u*)(XBC + tr * M2XBC + (colq - 3072)); rf = *(const v2u*)(XBC + tr * M2XBC + (colf - 3072)); rv = XBC[tr * M2XBC + (colv - 3072)]; if (seg == 0) rdt = DT[tr * 16 + dir * 8 + head]; } } while (0)
#define SCAN_STAGE(buf) do { const int o4 = ((buf) * TB + si) * 128 + 4 * seg; \
        const float q0 = bflo(rq.x), q1 = bfhi(rq.x), q2 = bflo(rq.y), q3 = bfhi(rq.y), f0 = bflo(rf.x), f1 = bfhi(rf.x), f2 = bflo(rf.y), f3 = bfhi(rf.y); \
        if (MODE == 0) { const float g0 = sigm(f0), g1 = sigm(f1), g2 = sigm(f2), g3 = sigm(f3); \
            *(LAS f32x4*)(qs + o4) = (f32x4){silu_f(q0), silu_f(q1), silu_f(q2), silu_f(q3)}; \
            *(LAS f32x4*)(fs + o4) = (f32x4){fmaxf(lb4[0], 1e-30f) + (1.f - lb4[0]) * g0, fmaxf(lb4[1], 1e-30f) + (1.f - lb4[1]) * g1, fmaxf(lb4[2], 1e-30f) + (1.f - lb4[2]) * g2, fmaxf(lb4[3], 1e-30f) + (1.f - lb4[3]) * g3}; \
            *(LAS f32x4*)(ks + o4) = (f32x4){(1.f - lb4[0]) * (1.f - g0), (1.f - lb4[1]) * (1.f - g1), (1.f - lb4[2]) * (1.f - g2), (1.f - lb4[3]) * (1.f - g3)}; } \
        else { *(LAS f32x4*)(qs + o4) = (f32x4){q0, q1, q2, q3}; *(LAS f32x4*)(ks + o4) = (f32x4){f0, f1, f2, f3}; if (seg == 0) { sc[((buf) * TB + si) * 2] = __expf(rdt * Aneg); sc[((buf) * TB + si) * 2 + 1] = rdt; } } \
        vs[((buf) * TB + si) * 32 + seg] = bf1(rv); } while (0)
    SCAN_LOAD(0); SCAN_STAGE(0);
    __syncthreads();
    for (int blk = 0; blk < NBLK; ++blk) {
        const int cur = blk & 1;
        if (blk + 1 < NBLK) SCAN_LOAD(blk + 1);
#pragma unroll
        for (int i = 0; i < TB; ++i) {
            const int o8 = (cur * TB + i) * 128 + 8 * dg;
            const f32x4 qa = *(const LAS f32x4*)(qs + o8), qb = *(const LAS f32x4*)(qs + o8 + 4), ka = *(const LAS f32x4*)(ks + o8), kb = *(const LAS f32x4*)(ks + o8 + 4);
            const float vt = vs[(cur * TB + i) * 32 + vv];
            float acc = 0.f;
            if (MODE == 0) {
                const f32x4 fa = *(const LAS f32x4*)(fs + o8), fb = *(const LAS f32x4*)(fs + o8 + 4);
#pragma unroll
                for (int e = 0; e < 4; ++e) { S[e] = fa[e] * S[e] + ka[e] * vt; acc += qa[e] * S[e]; S[4 + e] = fb[e] * S[4 + e] + kb[e] * vt; acc += qb[e] * S[4 + e]; }
            } else {
                const float dec = sc[(cur * TB + i) * 2], dtx = sc[(cur * TB + i) * 2 + 1] * vt;
#pragma unroll
                for (int e = 0; e < 4; ++e) { S[e] = dec * S[e] + ka[e] * dtx; acc += qa[e] * S[e]; S[4 + e] = dec * S[4 + e] + kb[e] * dtx; acc += qb[e] * S[4 + e]; }
            }
            op[(i * 16 + dg) * 32 + vv] = acc;
        }
        __syncthreads();
        { float s = 0.f;
#pragma unroll
          for (int g = 0; g < 16; ++g) s += op[(si * 16 + g) * 32 + seg];
          const size_t tr = SCAN_TROW(blk, si);
          OUT[((size_t)dir * T + tr) * 512 + (MODE == 0 ? head * 128 + part * 32 : head * 64 + part * 32) + seg] = s; }
        if (blk + 1 < NBLK) SCAN_STAGE(cur ^ 1);
        __syncthreads();
    }
#undef SCAN_TROW
#undef SCAN_LOAD
#undef SCAN_STAGE
}
__device__ __forceinline__ void combine_even_phase(const bf16* PROJ, const bf16* XBC, const float* OA, const float* YA, const float* hg_nw, const float* m2_d, const float* m2_nw, bf16* MIX, int lane, int wave, int bid, int G) {
    const int gw = bid * NWAVES + wave, NGW = G * NWAVES, c0 = 8 * lane;
    for (int row = gw; row < T; row += NGW) {
        float o[8], y[8];
        { const f32x4 a0 = *(const f32x4*)(OA + (size_t)row * 512 + c0), a1 = *(const f32x4*)(OA + (size_t)row * 512 + c0 + 4), b0 = *(const f32x4*)(OA + ((size_t)T + row) * 512 + c0), b1 = *(const f32x4*)(OA + ((size_t)T + row) * 512 + c0 + 4);
#pragma unroll
          for (int e = 0; e < 4; ++e) { o[e] = a0[e] + b0[e]; o[4 + e] = a1[e] + b1[e]; } }
        float ss = 0.f;
#pragma unroll
        for (int e = 0; e < 8; ++e) ss += o[e] * o[e];
        ss += sx(ss, 1, lane); ss += sx(ss, 2, lane); ss += sx(ss, 4, lane); ss += sx(ss, 8, lane);
        const float r1 = 1.0f / sqrtf(ss * (1.0f / 128.0f) + EPS);
        { const v4u g = *(const v4u*)(PROJ + (size_t)row * EINP + 2048 + c0); const f32x4 w0 = *(const f32x4*)(hg_nw + c0), w1 = *(const f32x4*)(hg_nw + c0 + 4);
          const float gg[8] = {bflo(g.x), bfhi(g.x), bflo(g.y), bfhi(g.y), bflo(g.z), bfhi(g.z), bflo(g.w), bfhi(g.w)}; const float ww[8] = {w0[0], w0[1], w0[2], w0[3], w1[0], w1[1], w1[2], w1[3]};
#pragma unroll
          for (int e = 0; e < 8; ++e) o[e] = o[e] * r1 * ww[e] * sigm(gg[e]) * (float)(1 - EXP_ZERO_HG);
          v4u w; w.x = pk2(o[0], o[1]); w.y = pk2(o[2], o[3]); w.z = pk2(o[4], o[5]); w.w = pk2(o[6], o[7]); *(v4u*)(MIX + (size_t)row * D + c0) = w; }
        { const f32x4 a0 = *(const f32x4*)(YA + (size_t)row * 512 + c0), a1 = *(const f32x4*)(YA + (size_t)row * 512 + c0 + 4), b0 = *(const f32x4*)(YA + ((size_t)T + row) * 512 + c0), b1 = *(const f32x4*)(YA + ((size_t)T + row) * 512 + c0 + 4);
          const v4u x = *(const v4u*)(XBC + (size_t)row * M2XBC + c0), z = *(const v4u*)(PROJ + (size_t)row * EINP + 2560 + c0); const float dsk = m2_d[lane >> 3];
          const float xx[8] = {bflo(x.x), bfhi(x.x), bflo(x.y), bfhi(x.y), bflo(x.z), bfhi(x.z), bflo(x.w), bfhi(x.w)}; const float zz[8] = {bflo(z.x), bfhi(z.x), bflo(z.y), bfhi(z.y), bflo(z.z), bfhi(z.z), bflo(z.w), bfhi(z.w)};
#pragma unroll
          for (int e = 0; e < 4; ++e) { y[e] = (a0[e] + b0[e] + dsk * xx[e]) * silu_f(zz[e]); y[4 + e] = (a1[e] + b1[e] + dsk * xx[4 + e]) * silu_f(zz[4 + e]); } }
        float s2 = 0.f;
#pragma unroll
        for (int e = 0; e < 8; ++e) s2 += y[e] * y[e];
        s2 += sx(s2, 1, lane); s2 += sx(s2, 2, lane); s2 += sx(s2, 4, lane); s2 += sx(s2, 8, lane); s2 += sx(s2, 16, lane);
        const float r2 = 1.0f / sqrtf(s2 * (1.0f / 256.0f) + EPS);
        { const f32x4 w0 = *(const f32x4*)(m2_nw + c0), w1 = *(const f32x4*)(m2_nw + c0 + 4);
          if (EXP_ZERO_SSD) { for (int e = 0; e < 8; ++e) y[e] = 0.f; }
          v4u w; w.x = pk2(y[0] * r2 * w0[0], y[1] * r2 * w0[1]); w.y = pk2(y[2] * r2 * w0[2], y[3] * r2 * w0[3]); w.z = pk2(y[4] * r2 * w1[0], y[5] * r2 * w1[1]); w.w = pk2(y[6] * r2 * w1[2], y[7] * r2 * w1[3]);
          *(v4u*)(MIX + (size_t)row * D + 512 + c0) = w; }
    }
}

__device__ __forceinline__ void s5_item(int item, int j, const Args& a, const float* nw  , const bf16* HN, float* YS  , int lane) {
    const int dir = item & 1, g = (item >> 1) & 63, b = item >> 7, n = lane;
    const size_t pg = ((size_t)(j * 2 + dir) * S5G + g);
    const float a_re = a.in[I_S5_A_RE][pg * S5N + n], a_im = a.in[I_S5_A_IM][pg * S5N + n];
    const float delta = expf(a.in[I_S5_LOG_STEP][pg]);
    const float mag = expf(a_re * delta); float sn, cs; sincosf(a_im * delta, &sn, &cs);
    const float lam_re = mag * cs, lam_im = mag * sn;
    const float den = a_re * a_re + a_im * a_im, num_re = lam_re - 1.0f;
    const float coef_re = (num_re * a_re + lam_im * a_im) / den, coef_im = (lam_im * a_re - num_re * a_im) / den;
    float bbr[16], bbi[16], cr[16], ci[16];
#pragma unroll
    for (int c = 0; c < 16; ++c) {
        const size_t bi_ = (((size_t)j * S5G + g) * S5N + n) * S5C + c;
        const float br = a.in[I_S5_B_RE][bi_], bi = a.in[I_S5_B_IM][bi_], w = nw[g * 16 + c];
        bbr[c] = (coef_re * br - coef_im * bi) * w; bbi[c] = (coef_re * bi + coef_im * br) * w;
        const size_t ci_ = (pg * S5C + c) * S5N + n;
        cr[c] = a.in[I_S5_C_RE][ci_]; ci[c] = a.in[I_S5_C_IM][ci_];
    }
    float hr = 0.f, hi = 0.f;
    for (int blk = 0; blk < SEQ / 64; ++blk) {
        const size_t tl = (size_t)b * SEQ + (dir == 0 ? (blk * 64 + lane) : (SEQ - 1 - (blk * 64 + lane)));
        const v4u u0 = *(const v4u*)(HN + tl * D + g * 16), u1 = *(const v4u*)(HN + tl * D + g * 16 + 8);
        const float uv[16] = {bflo(u0.x), bfhi(u0.x), bflo(u0.y), bfhi(u0.y), bflo(u0.z), bfhi(u0.z), bflo(u0.w), bfhi(u0.w), bflo(u1.x), bfhi(u1.x), bflo(u1.y), bfhi(u1.y), bflo(u1.z), bfhi(u1.z), bflo(u1.w), bfhi(u1.w)};
        for (int i = 0; i < 64; ++i) {
            float bur = 0.f, bui = 0.f;
#pragma unroll
            for (int c = 0; c < 16; ++c) { const float u = __builtin_bit_cast(float, __builtin_amdgcn_readlane(__builtin_bit_cast(int, uv[c]), i)); bur += bbr[c] * u; bui += bbi[c] * u; }
            const float nhr = lam_re * hr - lam_im * hi + bur, nhi = lam_re * hi + lam_im * hr + bui; hr = nhr; hi = nhi;
            float y[16];
#pragma unroll
            for (int c = 0; c < 16; ++c) y[c] = cr[c] * hr - ci[c] * hi;
            const bool b5 = (lane & 32) != 0, b4 = (lane & 16) != 0, b3 = (lane & 8) != 0, b2 = (lane & 4) != 0;
            float a8[8], a4[4], a2[2], a1;
#pragma unroll
            for (int k = 0; k < 8; ++k) { const float send = b5 ? y[k] : y[k + 8], keep = b5 ? y[k + 8] : y[k]; a8[k] = keep + sx(send, 32, lane); }
#pragma unroll
            for (int k = 0; k < 4; ++k) { const float send = b4 ? a8[k] : a8[k + 4], keep = b4 ? a8[k + 4] : a8[k]; a4[k] = keep + sx(send, 16, lane); }
#pragma unroll
            for (int k = 0; k < 2; ++k) { const float send = b3 ? a4[k] : a4[k + 2], keep = b3 ? a4[k + 2] : a4[k]; a2[k] = keep + sx(send, 8, lane); }
            { const float send = b2 ? a2[0] : a2[1], keep = b2 ? a2[1] : a2[0]; a1 = keep + sx(send, 4, lane); }
            a1 += sx(a1, 2, lane); a1 += sx(a1, 1, lane);
            const size_t ti = (size_t)b * SEQ + (dir == 0 ? (blk * 64 + i) : (SEQ - 1 - (blk * 64 + i)));
            if ((lane & 3) == 0) YS[((size_t)dir * T + ti) * D + g * 16 + (lane >> 2)] = a1;
        }
    }
}
__device__ __forceinline__ void combine_s5_phase(const float* H, const float* nw, const float* dsk, const float* YS, bf16* MIX, int lane, int wave, int bid, int G) {
    const int gw = bid * NWAVES + wave, NGW = G * NWAVES;
    for (int row = gw; row < T; row += NGW) {
        f32x4 v[4]; const float rstd = load_row_rstd(H + (size_t)row * D, lane, v);
        const f32x4* yf = (const f32x4*)(YS + (size_t)row * D) + lane; const f32x4* yb = (const f32x4*)(YS + ((size_t)T + row) * D) + lane;
        const f32x4* wv = (const f32x4*)nw + lane; const f32x4* dv = (const f32x4*)dsk + lane;
        unsigned long long* o8 = (unsigned long long*)(MIX + (size_t)row * D) + lane;
#pragma unroll
        for (int jj = 0; jj < 4; ++jj) { const f32x4 y = (yf[64 * jj] + yb[64 * jj]) * (float)(1 - EXP_ZERO_S5) + dv[64 * jj] * (v[jj] * rstd * wv[64 * jj]);
            o8[64 * jj] = (unsigned long long)pk2(gelu_tanh(y[0]), gelu_tanh(y[1])) | ((unsigned long long)pk2(gelu_tanh(y[2]), gelu_tanh(y[3])) << 32); }
    }
}
__device__ __forceinline__ void router_phase(const float* H, bf16* HN, const float* wr  , v4i* SEL, float* GATE, int* CNT, LAS unsigned char* lds, int tid, int lane, int wave, int bid, int G) {
    LAS float* wl = (LAS float*)lds;
    LAS int* lcnt = (LAS int*)(lds + 32768);
    for (int i = tid; i < D * 8; i += NTHR) wl[(i & 7) * D + (i >> 3)] = wr[i];
    for (int grp = bid; grp < T / 64; grp += G) {
        if (tid < 8) lcnt[tid] = 0;
        __syncthreads();
        for (int r = 0; r < 8; ++r) {
            const int row = grp * 64 + wave * 8 + r;
            f32x4 v[4]; const float rstd = load_row_rstd(H + (size_t)row * D, lane, v); store_row_bf16(HN + (size_t)row * D, lane, v, rstd);
            float lg[8];
#pragma unroll
            for (int e = 0; e < 8; ++e) { float s = 0.f;
#pragma unroll
                for (int jj = 0; jj < 4; ++jj) { const f32x4 w = *(const LAS f32x4*)(wl + e * D + 256 * jj + 4 * lane); s += (v[jj][0] * w[0] + v[jj][1] * w[1]) + (v[jj][2] * w[2] + v[jj][3] * w[3]); }
                lg[e] = wave_sum(s, lane) * rstd; }
            int e0 = 0; float l0 = lg[0];
#pragma unroll
            for (int e = 1; e < 8; ++e) if (lg[e] > l0) { l0 = lg[e]; e0 = e; }
            int e1 = -1; float l1 = -3.0e38f;
#pragma unroll
            for (int e = 0; e < 8; ++e) if (e != e0 && lg[e] > l1) { l1 = lg[e]; e1 = e; }
            const float g1 = 1.0f / (1.0f + expf(l0 - l1)), g0 = 1.0f - g1;
            if (lane == 0) { SEL[row] = (v4i){e0, e1, __builtin_bit_cast(int, g0), __builtin_bit_cast(int, g1)}; GATE[(size_t)row * 2] = g0; GATE[(size_t)row * 2 + 1] = g1; atomicAdd((int*)&lcnt[e0], 1); atomicAdd((int*)&lcnt[e1], 1); }
        }
        __syncthreads();
        if (tid < 8) CNT[grp * 8 + tid] = lcnt[tid];
        __syncthreads();
    }
}
__device__ __forceinline__ void scatter_phase(const bf16* HN, const v4i* SEL, const int* CNT, int* SLOT, int* SEGB, bf16* XBUF, LAS unsigned char* lds, int tid, int lane, int wave, int bid, int G) {
    LAS int* ltot = (LAS int*)lds;
    LAS int* lbef = ltot + 8;
    LAS int* base = lbef + 8;
    LAS int* wcnt = base + 8;
    for (int grp = bid; grp < T / 64; grp += G) {
        if (tid < 16) ltot[tid] = 0;
        __syncthreads();
        { const int e = tid & 7, q = tid >> 3; int tot = 0, bef = 0;
#pragma unroll
          for (int k = 0; k < 4; ++k) { const int g2 = q + 64 * k; const int c = CNT[g2 * 8 + e]; tot += c; bef += (g2 < grp) ? c : 0; }
          atomicAdd((int*)&ltot[e], tot); atomicAdd((int*)&lbef[e], bef); }
        __syncthreads();
        if (tid == 0) { int sb = 0;
            for (int e = 0; e < 8; ++e) { base[e] = sb + lbef[e]; if (grp == 0) SEGB[e] = sb; sb += (ltot[e] + 255) & ~255; }
            if (grp == 0) SEGB[8] = sb; }
        const int r0 = grp * 64 + wave * 8;
        int myE = -1;
        if (lane < 16) { const v4i s = SEL[r0 + (lane >> 1)]; myE = (lane & 1) ? s[1] : s[0]; }
        int rank = 0, cntMine = 0;
#pragma unroll
        for (int e = 0; e < 8; ++e) { const unsigned long long m = __ballot(myE == e); const int c = __popcll(m); if (lane == e) cntMine = c; if (myE == e) rank = __popcll(m & ((1ull << lane) - 1ull)); }
        if (lane < 8) wcnt[wave * 8 + lane] = cntMine;
        __syncthreads();
        int slot = 0;
        if (lane < 16) { int pre = 0; for (int w = 0; w < wave; ++w) pre += wcnt[w * 8 + myE]; slot = base[myE] + pre + rank; SLOT[(size_t)(r0 + (lane >> 1)) * 2 + (lane & 1)] = slot; }
        for (int i = 0; i < 16; ++i) { const int sl = __builtin_amdgcn_readlane(slot, i); const int row = r0 + (i >> 1);
            const v4u* src = (const v4u*)(HN + (size_t)row * D); v4u* dst = (v4u*)(XBUF + (size_t)sl * D);
            dst[lane] = src[lane]; dst[64 + lane] = src[64 + lane]; }
        __syncthreads();
    }
}

#if EXP_PROBE
__device__ __forceinline__ void probe_moe(const float* H, const float* nw, const float* router, const float* w_gu, const float* w_down, const v4i* SEL, const int* SLOT, const float* YBUF, int* diag,
                                          LAS unsigned char* lds, int tid, int lane, int wave, int bid) {
    LAS float* xt = (LAS float*)lds;
    LAS float* act = xt + 1024;
    LAS float* red = act + 3584;
    const int t = (bid * 61 + 7) & (T - 1);
    if (wave == 0) { f32x4 v[4]; const float rstd = load_row_rstd(H + (size_t)t * D, lane, v);
#pragma unroll
        for (int j = 0; j < 4; ++j) { const f32x4 w = ((const f32x4*)nw)[64 * j + lane]; *(LAS f32x4*)(xt + 256 * j + 4 * lane) = v[j] * rstd * w; } }
    __syncthreads();
    if (tid < 8) { float s = 0.f; for (int c = 0; c < D; ++c) s += xt[c] * router[c * 8 + tid]; red[tid] = s; }
    __syncthreads();
    int e0 = 0; float l0 = red[0];
    for (int e = 1; e < 8; ++e) if (red[e] > l0) { l0 = red[e]; e0 = e; }
    int e1 = -1; float l1 = -3.0e38f;
    for (int e = 0; e < 8; ++e) if (e != e0 && red[e] > l1) { l1 = red[e]; e1 = e; }
    const v4i sel = SEL[t];
    int code = 0;
    if (sel[0] != e0 || sel[1] != e1) code = 10;
    const float g1 = 1.0f / (1.0f + expf(l0 - l1)), g0 = 1.0f - g1;
    if (code == 0 && (fabsf(g0 - __builtin_bit_cast(float, sel[2])) > 1e-3f || fabsf(g1 - __builtin_bit_cast(float, sel[3])) > 1e-3f)) code = 9;
    __syncthreads();
    int cc[2] = {0, 0};
    for (int k = 0; k < 2; ++k) {
        const int e = k == 0 ? e0 : e1; const float* wg = w_gu + (size_t)e * D * 2 * FF; const float* wd = w_down + (size_t)e * FF * D;
        float ag[7], au[7];
        for (int q = 0; q < 7; ++q) { ag[q] = 0.f; au[q] = 0.f; }
        for (int c = 0; c < D; ++c) { const float x = xt[c];
#pragma unroll
            for (int q = 0; q < 7; ++q) { ag[q] += x * wg[(size_t)c * 2 * FF + tid + 512 * q]; au[q] += x * wg[(size_t)c * 2 * FF + FF + tid + 512 * q]; } }
#pragma unroll
        for (int q = 0; q < 7; ++q) act[tid + 512 * q] = ag[q] * sigm(ag[q]) * au[q];
        __syncthreads();
        float y0 = 0.f, y1 = 0.f;
        for (int f = 0; f < FF; ++f) { const float a = act[f]; y0 += a * wd[(size_t)f * D + tid]; y1 += a * wd[(size_t)f * D + 512 + tid]; }
        const int slot = SLOT[(size_t)t * 2 + k];
        const float m0 = YBUF[(size_t)slot * D + tid], m1 = YBUF[(size_t)slot * D + 512 + tid];
        float er = (m0 - y0) * (m0 - y0) + (m1 - y1) * (m1 - y1), rf = y0 * y0 + y1 * y1;
        er = wave_sum(er, lane); rf = wave_sum(rf, lane);
        __syncthreads();
        if (lane == 0) { red[16 + wave] = er; red[32 + wave] = rf; }
        __syncthreads();
        float E = 0.f, R = 0.f; for (int w = 0; w < 8; ++w) { E += red[16 + w]; R += red[32 + w]; }
        const float rel = E / (R + 1e-20f);
        cc[k] = rel < 1e-3f ? 0 : (rel < 0.1f ? 1 : 2);
        __syncthreads();
    }
    if (code == 0) code = cc[0] * 3 + cc[1];
    { const float sg0 = __builtin_bit_cast(float, sel[2]), sg1 = __builtin_bit_cast(float, sel[3]); int c2 = (int)(sg0 * 10.f); if (c2 < 0) c2 = 0; if (c2 > 12) c2 = 12;
      if (fabsf(sg0 + sg1 - 1.f) > 1e-3f) { int c3 = (int)((sg0 + sg1) * 5.f); if (c3 < 0) c3 = 0; if (c3 > 9) c3 = 9; c2 = 13 + c3; }
      code = c2; }
    if (tid == 0 && bid == 0) atomicMax(diag, code);
}
#endif
__device__ __forceinline__ void moe_combine_norm_phase(float* H, const float* YBUF, const float* GATE, const int* SLOT, bf16* HN, int lane, int wave, int bid, int G, const int* SEGBp = nullptr, int* diag = nullptr, float mscl = 1.f) {
    const int gw = bid * NWAVES + wave, NGW = G * NWAVES;
    for (int row = gw; row < T; row += NGW) {
        const int s0 = SLOT[(size_t)row * 2], s1 = SLOT[(size_t)row * 2 + 1]; const float g0 = GATE[(size_t)row * 2], g1 = GATE[(size_t)row * 2 + 1];
        f32x4* hr = (f32x4*)(H + (size_t)row * D) + lane; const f32x4* y0 = (const f32x4*)(YBUF + (size_t)s0 * D) + lane; const f32x4* y1 = (const f32x4*)(YBUF + (size_t)s1 * D) + lane;
        f32x4 v[4]; float ss = 0.f;
#pragma unroll
        for (int jj = 0; jj < 4; ++jj) { v[jj] = hr[64 * jj] + (g0 * y0[64 * jj] + g1 * y1[64 * jj]) * mscl; hr[64 * jj] = v[jj]; ss += (v[jj][0] * v[jj][0] + v[jj][1] * v[jj][1]) + (v[jj][2] * v[jj][2] + v[jj][3] * v[jj][3]); }
        const float rstd = 1.0f / sqrtf(wave_sum(ss, lane) * (1.0f / D) + EPS);
        store_row_bf16(HN + (size_t)row * D, lane, v, rstd);
    }
}

#ifndef MK_ONE_LAUNCH
#define MK_ONE_LAUNCH 1
#endif
constexpr int PH_PER_LAYER = 11, PH_LAYER0 = 2, N_PHASES = PH_LAYER0 + 4 * PH_PER_LAYER + 1;

#define H ((float*)(ws + WS_H))
#define HN ((bf16*)(ws + WS_HN))
#define MIX ((bf16*)(ws + WS_MIX))
#define PB ((bf16*)(ws + WS_PB))
#define PP ((bf16*)(ws + WS_PP))
#define XBUF ((bf16*)(ws + WS_XBUF))
#define YBUF ((float*)(ws + WS_YBUF))
#define DT ((float*)(ws + WS_DT))
#define SEL ((v4i*)(ws + WS_ROUTE))
#define SLOT ((int*)(ws + WS_ROUTE + 256 * 1024))
#define GATE ((float*)(ws + WS_ROUTE + 512 * 1024))
#define CNT ((int*)(ws + WS_ROUTE + 384 * 1024))
#define SEGB ((int*)(ws + WS_ROUTE + 400 * 1024))
#define PROJ ((bf16*)(ws + WS_PROJ))
#define XBC ((bf16*)(ws + WS_XBC))
#define OA ((float*)(ws + WS_OA))
#define YA ((float*)(ws + WS_YA))
#define ACT ((bf16*)(ws + WS_ACT))
#define YS ((float*)(ws + WS_YS))
__global__ void __launch_bounds__(NTHR, 2) fwd(Args args) {
    extern __shared__ __attribute__((aligned(16))) unsigned char lds_raw[];
    LAS unsigned char* lds = (LAS unsigned char*)lds_raw;
    volatile LAS unsigned* MISC = (volatile LAS unsigned*)(lds + MISC_OFF);
    const int G = gridDim.x, bid = blockIdx.x, wave_s = __builtin_amdgcn_readfirstlane((int)threadIdx.x >> 6);
    if (threadIdx.x < 32) MISC[threadIdx.x] = 0u;
#if defined(__HIP_DEVICE_COMPILE__)
#define ASSUME_GLOBAL(p) do { __builtin_assume(!__builtin_amdgcn_is_shared((const __attribute__((address_space(0))) void*)(p))); __builtin_assume(!__builtin_amdgcn_is_private((const __attribute__((address_space(0))) void*)(p))); } while (0)
#else
#define ASSUME_GLOBAL(p) do { } while (0)
#endif
#define PHASE_IDS() unsigned char* ws = args.ws; asm volatile("" : "+s"(ws) :: "memory"); ASSUME_GLOBAL(ws); int lane = (int)__builtin_amdgcn_mbcnt_hi(~0u, __builtin_amdgcn_mbcnt_lo(~0u, 0u)); asm volatile("" : "+v"(lane)); const int wave = wave_s, tid = wave * 64 + lane; (void)tid
    __syncthreads();
    XcdBarrier bar; bar.bar = (unsigned*)(args.ws + WS_CTL) + CW_BAR; bar.x = 0; bar.st = nullptr;
    if (MK_ONE_LAUNCH) bar = xcd_barrier_post((unsigned*)(args.ws + WS_CTL) + CW_BAR, MISC + 8);
#define SEAM() do { if (MK_ONE_LAUNCH) xcd_barrier(bar); } while (0)
    const int lo = args.ph_lo, hi = args.ph_hi;
#define IN(k) (lo <= (k) && (k) < hi)
    const float* x = args.in[I_X];

    if (IN(0)) { PHASE_IDS(); prologue_phase(args, ws, lds, tid, lane, wave, bid, G); SEAM(); }
    if (IN(1)) { PHASE_IDS();
        pg8::StackOrder S; S.init(PB, (const bf16*)(ws + WS_WPP), DEPTH * T, D, PLE, 6  , G, bid);
        pg8::EpiBf16 E{PP, D};
        int Kp = PLE; asm volatile("" : "+s"(Kp));
        pg8::gemm_phase<pg8::EpiBf16, pg8::StackOrder, true, true>(lds, Kp, S, E, wave_s);
        SEAM();
    }
    for (int l = 0; l < DEPTH; ++l) {
        const int pb = PH_LAYER0 + PH_PER_LAYER * l, j = l >> 1;
        if ((l & 1) == 0) {
            if (IN(pb + 0)) { PHASE_IDS(); norm_even_phase((l == 0) ? x : H, HN, (const float*)(ws + WS_WDT) + (size_t)j * D * 16, args.in[I_M2_DT_BIAS] + j * 16, DT, lds, tid, lane, wave, bid, G); SEAM(); }
            if (IN(pb + 1)) { PHASE_IDS();
                pg8::StaticOrder S; S.init(HN, (const bf16*)(ws + WS_WIN) + (size_t)j * EINP * D, T, EINP, D, G, bid);
                pg8::EpiBf16 E{PROJ, EINP};
                pg8::gemm_phase<pg8::EpiBf16, pg8::StaticOrder, true, true>(lds, D, S, E, wave_s);
                SEAM();
            }
            if (IN(pb + 2)) { PHASE_IDS(); conv_phase(PROJ, args.in[I_M2_CONV_W] + (size_t)j * 5 * M2XBC, args.in[I_M2_CONV_B] + (size_t)j * M2XBC, XBC, tid, bid, G); SEAM(); }
            if (IN(pb + 3)) { PHASE_IDS();
                for (int it = bid; it < 512; it += G) {
                    if (it < 256) scan_item<0>(it, PROJ, XBC, DT, (const float*)(ws + WS_WDT + 512 * 1024) + j * HGW, nullptr, OA, lds, tid);
                    else scan_item<1>(it - 256, PROJ, XBC, DT, nullptr, args.in[I_M2_A_LOG] + j * 16, YA, lds, tid);
                }
                SEAM();
            }
            if (IN(pb + 4)) { PHASE_IDS(); combine_even_phase(PROJ, XBC, OA, YA, args.in[I_HG_NORM_W] + j * HGW, args.in[I_M2_D] + j * M2H, args.in[I_M2_NORM_W] + j * M2I, MIX, lane, wave, bid, G); SEAM(); }
            if (IN(pb + 5)) { PHASE_IDS();
                pg8::StaticOrder S; S.init(MIX, (const bf16*)(ws + WS_WOUT) + (size_t)j * D * D, T, D, D, G, bid);
                pg8::EpiResF32 E{H, (l == 0) ? x : H, D};
                pg8::gemm_phase<pg8::EpiResF32, pg8::StaticOrder, true, true>(lds, D, S, E, wave_s);
                SEAM();
            }
            if (IN(pb + 6)) { PHASE_IDS(); norm_phase(H, HN, lane, wave, bid, G); SEAM(); }
            if (IN(pb + 7)) { PHASE_IDS();
                pg8::StaticOrder S; S.init(HN, (const bf16*)(ws + WS_WGU) + (size_t)j * 2 * FF * D, T, 2 * FF, D, G, bid);
                pg8::EpiSwiGLU E{ACT, FF};
                pg8::gemm_phase<pg8::EpiSwiGLU, pg8::StaticOrder, true, true>(lds, D, S, E, wave_s);
                SEAM();
            }
            if (IN(pb + 8) && !EXP_ZERO_FFN) { PHASE_IDS();
                pg8::StaticOrder S; S.init(ACT, (const bf16*)(ws + WS_WDN) + (size_t)j * D * FF, T, D, FF, G, bid);
                pg8::EpiResF32 E{H, H, D};
                pg8::gemm_phase<pg8::EpiResF32, pg8::StaticOrder, true, true>(lds, FF, S, E, wave_s);
                SEAM();
            }
            if (IN(pb + 9)) { PHASE_IDS(); norm_phase(H, HN, lane, wave, bid, G); SEAM(); }
        } else {
            if (IN(pb + 0)) { PHASE_IDS(); norm_phase(H, HN, lane, wave, bid, G); SEAM(); }
            if (IN(pb + 1)) { PHASE_IDS();
                for (int it = wave * G + bid; it < NB * S5G * 2; it += G * NWAVES) s5_item(it, j, args, args.in[I_NORM_MIX] + l * D, HN, YS, lane);
                SEAM();
            }
            if (IN(pb + 2)) { PHASE_IDS(); combine_s5_phase(H, args.in[I_NORM_MIX] + l * D, args.in[I_S5_D] + j * D, YS, MIX, lane, wave, bid, G); SEAM(); }
            if (IN(pb + 3)) { PHASE_IDS();
                pg8::StaticOrder S; S.init(MIX, (const bf16*)(ws + WS_WGLU) + (size_t)j * 2 * D * D, T, 2 * D, D, G, bid);
                float sclg = EXP_ZERO_GLU ? 0.f : 1.f; asm volatile("" : "+s"(sclg)); pg8::EpiGluRes E{H, D, sclg};
                pg8::gemm_phase<pg8::EpiGluRes, pg8::StaticOrder, true, true>(lds, D, S, E, wave_s);
                SEAM();
            }
            if (IN(pb + 4)) { PHASE_IDS(); router_phase(H, HN, (const float*)(ws + WS_WDT + 256 * 1024) + (size_t)j * D * 8, SEL, GATE, CNT, lds, tid, lane, wave, bid, G); SEAM(); }
            if (IN(pb + 5)) { PHASE_IDS(); scatter_phase(HN, SEL, CNT, SLOT, SEGB, XBUF, lds, tid, lane, wave, bid, G); SEAM(); }
            if (IN(pb + 6)) { PHASE_IDS();
                pg8::MoeOrder S; S.init(XBUF, (const bf16*)(ws + WS_WMGU) + (size_t)j * NE * 2 * FF * D, SEGB, 2 * FF, D, G, bid);
                pg8::EpiSwiGLU E{ACT, FF};
                pg8::gemm_phase<pg8::EpiSwiGLU, pg8::MoeOrder, true, true>(lds, D, S, E, wave_s);
                SEAM();
            }
            if (IN(pb + 7)) { PHASE_IDS();
                pg8::MoeOrder S; S.init(ACT, (const bf16*)(ws + WS_WMDN) + (size_t)j * NE * D * FF, SEGB, D, FF, G, bid);
                pg8::EpiResF32 E{YBUF, nullptr, D};
                pg8::gemm_phase<pg8::EpiResF32, pg8::MoeOrder, true, true>(lds, FF, S, E, wave_s);
                SEAM();
            }
#if EXP_PROBE
            if (IN(pb + 8) && l == EXP_PROBE_LAYER) { PHASE_IDS(); probe_moe(H, args.in[I_NORM_FFN] + l * D, args.in[I_MOE_ROUTER] + (size_t)j * D * 8, args.in[I_MOE_W_GU] + (size_t)j * NE * D * 2 * FF, args.in[I_MOE_W_DOWN] + (size_t)j * NE * FF * D, SEL, SLOT, YBUF, (int*)(ws + WS_CTL) + 64, lds, tid, lane, wave, bid); __syncthreads(); }
#endif
            if (IN(pb + 9)) { PHASE_IDS(); moe_combine_norm_phase(H, YBUF, GATE, SLOT, HN, lane, wave, bid, G, SEGB, (int*)(ws + WS_CTL) + 64, ((EXP_ZERO_MOE >> j) & 1) ? 0.f : 1.f); SEAM(); }
        }
        if (IN(pb + 10)) { PHASE_IDS();
            pg8::StaticOrder S; S.init(HN, (const bf16*)(ws + WS_WPG) + (size_t)l * D * D, T, D, D, G, bid);
            float sclp = EXP_ZERO_PLE ? 0.f : 1.f; asm volatile("" : "+s"(sclp)); pg8::EpiPle E{H, PP + (size_t)l * T * D, D, sclp};
            pg8::gemm_phase<pg8::EpiPle, pg8::StaticOrder, true, true>(lds, D, S, E, wave_s);
            SEAM();
        }
    }
    if (IN(N_PHASES - 1)) { PHASE_IDS(); final_phase(H, args.in[I_FINAL_NORM], args.out, lane, wave, bid, G, (const int*)(ws + WS_CTL) + 64); }
#undef IN
#undef SEAM
#undef PHASE_IDS
}
#undef H
#undef HN
#undef MIX
#undef PB
#undef PP
#undef XBUF
#undef YBUF
#undef DT
#undef SEL
#undef SLOT
#undef GATE
#undef CNT
#undef SEGB
#undef PROJ
#undef XBC
#undef OA
#undef YA
#undef ACT
#undef YS


extern "C" void kernel_launch(void* const* d_in, const int* in_sizes, int n_in, void* d_out, int out_size, void* d_ws, size_t ws_size, hipStream_t stream) {
    static int grid = 0;
    if (grid == 0) {
        if (n_in != N_IN || in_sizes[0] != T * D || out_size != T * D || ws_size < WS_END) { fprintf(stderr, "kernel_launch: unexpected problem (n_in %d, in0 %d, out %d, ws %zu < %zu); nothing launched\n", n_in, n_in > 0 ? in_sizes[0] : -1, out_size, ws_size, (size_t)WS_END); grid = -1; return; }
        int dev = 0, cus = 0, per_cu = 0;
        if (hipGetDevice(&dev) != hipSuccess || hipDeviceGetAttribute(&cus, hipDeviceAttributeMultiprocessorCount, dev) != hipSuccess) { fprintf(stderr, "kernel_launch: device query failed\n"); grid = -1; return; }
        if (hipFuncSetAttribute((const void*)fwd, hipFuncAttributeMaxDynamicSharedMemorySize, LDS_BYTES) != hipSuccess) { fprintf(stderr, "kernel_launch: hipFuncSetAttribute failed\n"); grid = -1; return; }
        if (hipOccupancyMaxActiveBlocksPerMultiprocessor(&per_cu, (const void*)fwd, NTHR, LDS_BYTES) != hipSuccess || per_cu < 1) { fprintf(stderr, "kernel_launch: occupancy query reports %d workgroups per CU\n", per_cu); (void)hipGetLastError(); per_cu = 1; }
        grid = cus;
    }
    if (grid < 0) return;
    if (hipMemsetAsync((char*)d_ws + WS_CTL, 0, CTL_ZERO_BYTES, stream) != hipSuccess) { fprintf(stderr, "kernel_launch: memset failed\n"); return; }
    Args a{};
    for (int i = 0; i < N_IN; ++i) a.in[i] = (const float*)d_in[i];
    a.out = (float*)d_out; a.ws = (unsigned char*)d_ws;
#if MK_ONE_LAUNCH
    a.ph_lo = 0; a.ph_hi = N_PHASES;
    hipLaunchKernelGGL(fwd, dim3(grid), dim3(NTHR), LDS_BYTES, stream, a);
    { const hipError_t le = hipPeekAtLastError(); if (le != hipSuccess) fprintf(stderr, "kernel_launch: launch failed: %s\n", hipGetErrorName(le)); }
#else
    for (int ph = 0; ph < N_PHASES; ++ph) {
        const int rel = ph - PH_LAYER0, l = rel >= 0 ? rel / PH_PER_LAYER : -1, slot = rel >= 0 ? rel % PH_PER_LAYER : -1;
        if (l >= 0 && l < DEPTH) { if ((l & 1) && slot == 8 && !(EXP_PROBE && l == EXP_PROBE_LAYER)) continue; }
        a.ph_lo = ph; a.ph_hi = ph + 1;
        hipLaunchKernelGGL(fwd, dim3(grid), dim3(NTHR), LDS_BYTES, stream, a);
        const hipError_t le = hipPeekAtLastError(); if (le != hipSuccess) { fprintf(stderr, "kernel_launch: launch of phase %d failed: %s\n", ph, hipGetErrorName(le)); break; }
    }
#endif
}
```

```cpp
#include <hip/hip_runtime.h>
#include <cstdio>
#include <cstdint>

namespace pg8 {
#define PG8_LAS __attribute__((address_space(3)))
typedef unsigned short bf16_t;
typedef short bf16x8 __attribute__((ext_vector_type(8)));
typedef float f32x4 __attribute__((ext_vector_type(4)));
typedef float f32x2 __attribute__((ext_vector_type(2)));
typedef unsigned u32x4 __attribute__((ext_vector_type(4)));
typedef unsigned u32x2 __attribute__((ext_vector_type(2)));
constexpr int BM = 256, BK = 64, HALF = 128, HTB = HALF * BK * 2  , STAGE_BYTES = 8 * HTB, NXCD = 8, WGM = 8;

__host__ __device__ __forceinline__ int lds_byte(int r, int c) { const int st = (r >> 4) * 2 + (c >> 5), rr = r & 15, cc = c & 31, ob = rr * 64 + cc * 2; return st * 1024 + (ob ^ (((ob >> 9) & 1) << 5)); }
__host__ __device__ __forceinline__ void stage_rc(int b, int& R, int& C) { const int st = b / 1024, sb = b % 1024, swz = sb ^ (((sb >> 9) & 1) << 5); R = (st >> 1) * 16 + swz / 64; C = (st & 1) * 32 + (swz % 64) / 2; }
__host__ __device__ __forceinline__ int perm32(int rho) { const int n = rho >> 4, i = rho & 15; return 8 * (i >> 2) + 4 * n + (i & 3); }

struct Unit { int pm, pn, ord; const char* A; const char* B; };

struct StaticOrder {
    int nM, nN, nwg, G, c; const char* A; const char* Bt; size_t tstep;
    __device__ void init(const bf16_t* A_, const bf16_t* Bt_, int M, int N, int K, int G_, int c_) { nM = M / BM; nN = N / BM; nwg = nM * nN; G = G_; c = c_; A = (const char*)A_; Bt = (const char*)Bt_; tstep = (size_t)BM * K * 2; }
    __device__ __forceinline__ bool next(int i, Unit& u) const {
        const long L = (long)i * G + c; if (L >= nwg) return false;
        int wgid = (int)L; { const int q = nwg / NXCD, r = nwg % NXCD, xcd = wgid % NXCD, off = wgid / NXCD; wgid = (xcd < r ? xcd * (q + 1) : r * (q + 1) + (xcd - r) * q) + off; }
        const int nig = WGM * nN, gid = wgid / nig, fm = gid * WGM, gsz = (nM - fm) < WGM ? (nM - fm) : WGM;
        u.pm = fm + ((wgid % nig) % gsz); u.pn = (wgid % nig) / gsz; u.ord = i; u.A = A + (size_t)u.pm * tstep; u.B = Bt + (size_t)u.pn * tstep; return true;
    }
    __device__ __forceinline__ void a_ready(const Unit&) const {}
    __device__ __forceinline__ void done(const Unit&) const {}
};
struct MoeOrder {
    int nM, nN, nwg, G, c; const char* A; const char* Bt; size_t tstep, estride; int s1, s2, s3, s4, s5, s6, s7;
    __device__ void init(const bf16_t* A_, const bf16_t* Bt_, const int* seg, int N, int K, int G_, int c_) { nM = __builtin_amdgcn_readfirstlane(seg[8]) / BM; nN = N / BM; nwg = nM * nN; G = G_; c = c_; A = (const char*)A_; Bt = (const char*)Bt_; tstep = (size_t)BM * K * 2; estride = (size_t)N * K * 2;
        s1 = __builtin_amdgcn_readfirstlane(seg[1]); s2 = __builtin_amdgcn_readfirstlane(seg[2]); s3 = __builtin_amdgcn_readfirstlane(seg[3]); s4 = __builtin_amdgcn_readfirstlane(seg[4]);
        s5 = __builtin_amdgcn_readfirstlane(seg[5]); s6 = __builtin_amdgcn_readfirstlane(seg[6]); s7 = __builtin_amdgcn_readfirstlane(seg[7]); }
    __device__ __forceinline__ bool next(int i, Unit& u) const {
        const long L = (long)i * G + c; if (L >= nwg) return false;
        int wgid = (int)L; { const int q = nwg / NXCD, r = nwg % NXCD, xcd = wgid % NXCD, off = wgid / NXCD; wgid = (xcd < r ? xcd * (q + 1) : r * (q + 1) + (xcd - r) * q) + off; }
        const int nig = WGM * nN, gid = wgid / nig, fm = gid * WGM, gsz = (nM - fm) < WGM ? (nM - fm) : WGM;
        u.pm = fm + ((wgid % nig) % gsz); u.pn = (wgid % nig) / gsz; u.ord = i;
        const int r0 = u.pm * BM; const int e = (r0 >= s1) + (r0 >= s2) + (r0 >= s3) + (r0 >= s4) + (r0 >= s5) + (r0 >= s6) + (r0 >= s7);
        u.A = A + (size_t)u.pm * tstep; u.B = Bt + (size_t)e * estride + (size_t)u.pn * tstep; return true;
    }
    __device__ __forceinline__ void a_ready(const Unit&) const {}
    __device__ __forceinline__ void done(const Unit&) const {}
};

struct StackOrder {
    int nM, nN, nwg, G, c, tpl; const char* A; const char* Bt; size_t tstep, lstride;
    __device__ void init(const bf16_t* A_, const bf16_t* Bt_, int M, int N, int K, int log2TilesPerL, int G_, int c_) { nM = M / BM; nN = N / BM; nwg = nM * nN; G = G_; c = c_; tpl = log2TilesPerL; A = (const char*)A_; Bt = (const char*)Bt_; tstep = (size_t)BM * K * 2; lstride = (size_t)N * K * 2; }
    __device__ __forceinline__ bool next(int i, Unit& u) const {
        const long L = (long)i * G + c; if (L >= nwg) return false;
        int wgid = (int)L; { const int q = nwg / NXCD, r = nwg % NXCD, xcd = wgid % NXCD, off = wgid / NXCD; wgid = (xcd < r ? xcd * (q + 1) : r * (q + 1) + (xcd - r) * q) + off; }
        const int nig = WGM * nN, gid = wgid / nig, fm = gid * WGM, gsz = (nM - fm) < WGM ? (nM - fm) : WGM;
        u.pm = fm + ((wgid % nig) % gsz); u.pn = (wgid % nig) / gsz; u.ord = i;
        u.A = A + (size_t)u.pm * tstep; u.B = Bt + (size_t)(u.pm >> tpl) * lstride + (size_t)u.pn * tstep; return true;
    }
    __device__ __forceinline__ void a_ready(const Unit&) const {}
    __device__ __forceinline__ void done(const Unit&) const {}
};

__device__ __forceinline__ unsigned cvt_pk_bf16(float lo, float hi) { unsigned r; asm volatile("v_cvt_pk_bf16_f32 %0, %1, %2" : "=v"(r) : "v"(lo), "v"(hi)); return r; }
__device__ __forceinline__ float sigmoid_f(float x) { return 1.0f / (1.0f + __expf(-x)); }

__device__ __forceinline__ float row_rstd(const float* SSQ, int row) {
    const f32x4* p = (const f32x4*)(SSQ + (size_t)row * 16); const f32x4 a = p[0], b = p[1], c = p[2], d = p[3];
    const float s = (((a[0] + a[1]) + (a[2] + a[3])) + ((b[0] + b[1]) + (b[2] + b[3]))) + (((c[0] + c[1]) + (c[2] + c[3])) + ((d[0] + d[1]) + (d[2] + d[3])));
    return 1.0f / sqrtf(s * (1.0f / 1024.0f) + 1e-6f);
}
__device__ __forceinline__ float quad_sum(float v, int fr, int fq) {
    const int lane = 16 * fq + fr;
    v += __builtin_bit_cast(float, __builtin_amdgcn_ds_bpermute((lane ^ 16) << 2, __builtin_bit_cast(int, v)));
    v += __builtin_bit_cast(float, __builtin_amdgcn_ds_bpermute((lane ^ 32) << 2, __builtin_bit_cast(int, v)));
    return v;
}
struct EpiBf16 {
    static constexpr bool PERM = true, AFTER_DRAIN = false;
    bf16_t* O; int ldc; const PG8_LAS float* rtab;
    __device__ __forceinline__ void operator()(const f32x4 (&acc)[2][2][4][2], const Unit& u, int wr, int wc, int fr, int fq) const {
        const int row0 = u.pm * BM + wr * 64 + fr, col0 = u.pn * BM + wc * 32 + 8 * fq;
#pragma unroll
        for (int ai = 0; ai < 2; ++ai)
#pragma unroll
            for (int m = 0; m < 4; ++m) { const int row = row0 + ai * HALF + m * 16; bf16_t* rowp = O + (size_t)row * ldc + col0; const float rs = rtab ? rtab[u.ord * BM + (row - u.pm * BM)] : 1.0f;
#pragma unroll
                for (int bj = 0; bj < 2; ++bj) { const f32x4 v0 = acc[ai][bj][m][0] * rs, v1 = acc[ai][bj][m][1] * rs;
                    u32x4 w; w.x = cvt_pk_bf16(v0[0], v0[1]); w.y = cvt_pk_bf16(v0[2], v0[3]); w.z = cvt_pk_bf16(v1[0], v1[1]); w.w = cvt_pk_bf16(v1[2], v1[3]);
                    *(u32x4*)(rowp + bj * HALF) = w; } }
    }
};
struct EpiSwiGLU {
    static constexpr bool PERM = true, AFTER_DRAIN = false;
    bf16_t* O; int ldc; const PG8_LAS float* rtab;
    __device__ __forceinline__ void operator()(const f32x4 (&acc)[2][2][4][2], const Unit& u, int wr, int wc, int fr, int fq) const {
        const int row0 = u.pm * BM + wr * 64 + fr, col0 = u.pn * HALF + wc * 32 + 8 * fq;
#pragma unroll
        for (int ai = 0; ai < 2; ++ai)
#pragma unroll
            for (int m = 0; m < 4; ++m) { const int row = row0 + ai * HALF + m * 16; bf16_t* rowp = O + (size_t)row * ldc + col0; const float rs = rtab ? rtab[u.ord * BM + (row - u.pm * BM)] : 1.0f;
                f32x4 v[2];
#pragma unroll
                for (int n = 0; n < 2; ++n) { const f32x4 g = acc[ai][0][m][n] * rs, uu = acc[ai][1][m][n] * rs;
#pragma unroll
                    for (int j = 0; j < 4; ++j) v[n][j] = g[j] * sigmoid_f(g[j]) * uu[j]; }
                u32x4 w; w.x = cvt_pk_bf16(v[0][0], v[0][1]); w.y = cvt_pk_bf16(v[0][2], v[0][3]); w.z = cvt_pk_bf16(v[1][0], v[1][1]); w.w = cvt_pk_bf16(v[1][2], v[1][3]);
                *(u32x4*)rowp = w; }
    }
};
struct EpiResF32 {
    static constexpr bool PERM = false, AFTER_DRAIN = false;
    float* C; const float* res; int ldc; bf16_t* HBo; float* SSQo;
    __device__ __forceinline__ void operator()(const f32x4 (&acc)[2][2][4][2], const Unit& u, int wr, int wc, int fr, int fq) const {
        const int row0 = u.pm * BM + wr * 64 + fr, col0 = u.pn * BM + wc * 32 + 4 * fq;
#pragma unroll
        for (int ai = 0; ai < 2; ++ai)
#pragma unroll
            for (int m = 0; m < 4; ++m) { const int row = row0 + ai * HALF + m * 16; const size_t off = (size_t)row * ldc + col0; float ss = 0.f;
#pragma unroll
                for (int bj = 0; bj < 2; ++bj)
#pragma unroll
                    for (int n = 0; n < 2; ++n) { f32x4 o = acc[ai][bj][m][n]; if (res) o += *(const f32x4*)(res + off + bj * HALF + n * 16); *(f32x4*)(C + off + bj * HALF + n * 16) = o;
                        if (HBo) { ss += (o[0] * o[0] + o[1] * o[1]) + (o[2] * o[2] + o[3] * o[3]); u32x2 w; w.x = cvt_pk_bf16(o[0], o[1]); w.y = cvt_pk_bf16(o[2], o[3]); *(u32x2*)(HBo + off + bj * HALF + n * 16) = w; } }
                if (HBo) { ss = quad_sum(ss, fr, fq); if (fq == 0) SSQo[(size_t)row * 16 + u.pn * 4 + wc] = ss; }
                asm volatile("" ::: "memory"); }
    }
};
struct EpiGluRes {
    static constexpr bool PERM = false, AFTER_DRAIN = false;
    float* C; int ldc; float scl;
    __device__ __forceinline__ void operator()(const f32x4 (&acc)[2][2][4][2], const Unit& u, int wr, int wc, int fr, int fq) const {
        const int row0 = u.pm * BM + wr * 64 + fr, col0 = u.pn * HALF + wc * 32 + 4 * fq;
#pragma unroll
        for (int ai = 0; ai < 2; ++ai)
#pragma unroll
            for (int m = 0; m < 4; ++m) { float* rowp = C + (size_t)(row0 + ai * HALF + m * 16) * ldc + col0;
#pragma unroll
                for (int n = 0; n < 2; ++n) { const f32x4 o = acc[ai][0][m][n], g = acc[ai][1][m][n]; f32x4 h = *(const f32x4*)(rowp + n * 16);
#pragma unroll
                    for (int j = 0; j < 4; ++j) h[j] += o[j] * sigmoid_f(g[j]) * scl;
                    *(f32x4*)(rowp + n * 16) = h; }
                asm volatile("" ::: "memory"); }
    }
};
struct EpiPle {
    static constexpr bool PERM = false, AFTER_DRAIN = false;
    float* C; const bf16_t* P; int ldc; float scl; const PG8_LAS float* rtab; bf16_t* HBo; float* SSQo;
    __device__ __forceinline__ void operator()(const f32x4 (&acc)[2][2][4][2], const Unit& u, int wr, int wc, int fr, int fq) const {
        const int row0 = u.pm * BM + wr * 64 + fr, col0 = u.pn * BM + wc * 32 + 4 * fq;
#pragma unroll
        for (int ai = 0; ai < 2; ++ai)
#pragma unroll
            for (int m = 0; m < 4; ++m) { const int row = row0 + ai * HALF + m * 16; const size_t off = (size_t)row * ldc + col0; const float rs = rtab ? rtab[u.ord * BM + (row - u.pm * BM)] : 1.0f; float ss = 0.f;
#pragma unroll
                for (int bj = 0; bj < 2; ++bj)
#pragma unroll
                    for (int n = 0; n < 2; ++n) { const f32x4 a = acc[ai][bj][m][n] * rs; const u32x2 pw = *(const u32x2*)(P + off + bj * HALF + n * 16); f32x4 h = *(const f32x4*)(C + off + bj * HALF + n * 16);
                        h[0] += sigmoid_f(a[0]) * __uint_as_float(pw.x << 16) * scl; h[1] += sigmoid_f(a[1]) * __uint_as_float(pw.x & 0xffff0000u) * scl;
                        h[2] += sigmoid_f(a[2]) * __uint_as_float(pw.y << 16) * scl; h[3] += sigmoid_f(a[3]) * __uint_as_float(pw.y & 0xffff0000u) * scl;
                        *(f32x4*)(C + off + bj * HALF + n * 16) = h;
                        ss += (h[0] * h[0] + h[1] * h[1]) + (h[2] * h[2] + h[3] * h[3]); u32x2 w; w.x = cvt_pk_bf16(h[0], h[1]); w.y = cvt_pk_bf16(h[2], h[3]); *(u32x2*)(HBo + off + bj * HALF + n * 16) = w; }
                ss = quad_sum(ss, fr, fq); if (fq == 0) SSQo[(size_t)row * 16 + u.pn * 4 + wc] = ss;
                asm volatile("" ::: "memory"); }
    }
};

template <class Epi, class Sched, bool ALIGN_EPI = false, bool SP2 = false>
__device__ __forceinline__ void gemm_phase(PG8_LAS unsigned char* lds, const int K, const Sched& S, const Epi& E, const int wave_s  ) {
    int lane_; asm volatile("v_mbcnt_lo_u32_b32 %0, -1, 0\n\tv_mbcnt_hi_u32_b32 %0, -1, %0" : "=v"(lane_)); const int tid_ = wave_s * 64 + lane_;
    const int tid = tid_, wid = wave_s, lane = tid & 63, wr = wid >> 2, wc = wid & 3, fr = lane & 15, fq = lane >> 4;
    const int nt = K / BK;
    unsigned voffA[2], voffB[2];
#pragma unroll
    for (int i = 0; i < 2; ++i) { int R, C; stage_rc(tid * 16 + i * 8192, R, C); const int Rb = Epi::PERM ? ((R & ~31) + perm32(R & 31)) : R;
        voffA[i] = (unsigned)(R * K + C) * 2u; voffB[i] = (unsigned)(Rb * K + C) * 2u; }
    const size_t kstep = (size_t)(BK * 2);
    const size_t hstep = (size_t)HALF * K * 2;
    const unsigned ldsw = (unsigned)wid * 1024u;
    const int aoff = lds_byte(wr * 64 + fr, fq * 8), boff = lds_byte(wc * 32 + fr, fq * 8);
#define PG8_SA(b, h) (((b) * 2 + (h)) * HTB)
#define PG8_SB(b, h) ((4 + (b) * 2 + (h)) * HTB)
#define PG8_STAGE(bufoff, gbase, voff) do { _Pragma("unroll") for (int _i = 0; _i < 2; ++_i) \
        __builtin_amdgcn_global_load_lds((const unsigned*)((const char*)(gbase) + (voff)[_i]), (PG8_LAS unsigned*)(lds + (bufoff) + ldsw + _i * 8192), 16, 0, 0); } while (0)
#define PG8_LDA(dst, b, h) do { _Pragma("unroll") for (int m = 0; m < 4; ++m) _Pragma("unroll") for (int k = 0; k < 2; ++k) dst[m][k] = *(const PG8_LAS bf16x8*)(lds + PG8_SA(b, h) + aoff + m * 2048 + k * 1024); } while (0)
#define PG8_LDB(dst, b, h) do { _Pragma("unroll") for (int n = 0; n < 2; ++n) _Pragma("unroll") for (int k = 0; k < 2; ++k) dst[n][k] = *(const PG8_LAS bf16x8*)(lds + PG8_SB(b, h) + boff + n * 2048 + k * 1024); } while (0)
#define PG8_MMA(ai, bj, At, Bt) do { __builtin_amdgcn_s_setprio(1); _Pragma("unroll") for (int m = 0; m < 4; ++m) _Pragma("unroll") for (int n = 0; n < 2; ++n) _Pragma("unroll") for (int k = 0; k < 2; ++k) \
        acc[ai][bj][m][n] = __builtin_amdgcn_mfma_f32_16x16x32_bf16(Bt[n][k], At[m][k], acc[ai][bj][m][n], 0, 0, 0); __builtin_amdgcn_s_setprio(0); } while (0)
#define PG8_WAIT_V(n) asm volatile("s_waitcnt vmcnt(" #n ")" ::: "memory")
#define PG8_WAIT_L(n) asm volatile("s_waitcnt lgkmcnt(" #n ")" ::: "memory")
#define PG8_BAR __builtin_amdgcn_s_barrier()
#define PG8_SCHED __builtin_amdgcn_sched_barrier(0)
    Unit cur, nxt; int ui = 0;
    if (!S.next(0, cur)) return;
    f32x4 acc[2][2][4][2];
#pragma unroll
    for (int a = 0; a < 2; ++a)
#pragma unroll
        for (int b = 0; b < 2; ++b)
#pragma unroll
            for (int m = 0; m < 4; ++m)
#pragma unroll
                for (int n = 0; n < 2; ++n) acc[a][b][m][n] = (f32x4){0.f, 0.f, 0.f, 0.f};
    bf16x8 At[4][2], B0[2][2], B1[2][2];
    const char* cA = cur.A; const char* cB = cur.B;
    S.a_ready(cur);
    if constexpr (SP2) {
        PG8_STAGE(PG8_SB(0, 0), cB, voffB); PG8_STAGE(PG8_SB(0, 1), cB + hstep, voffB); PG8_STAGE(PG8_SA(0, 0), cA, voffA); PG8_STAGE(PG8_SA(0, 1), cA + hstep, voffA);
        if (wr == 1) PG8_BAR;
        PG8_WAIT_V(2); PG8_BAR;
        PG8_STAGE(PG8_SB(1, 0), cB + kstep, voffB); PG8_STAGE(PG8_SA(1, 0), cA + kstep, voffA); PG8_STAGE(PG8_SB(1, 1), cB + hstep + kstep, voffB);
        PG8_WAIT_V(6); PG8_BAR;
    } else {
        PG8_STAGE(PG8_SB(0, 0), cB, voffB); PG8_STAGE(PG8_SA(0, 0), cA, voffA); PG8_STAGE(PG8_SB(0, 1), cB + hstep, voffB); PG8_STAGE(PG8_SA(0, 1), cA + hstep, voffA);
        if (wr == 1) PG8_BAR;
        PG8_WAIT_V(4); PG8_BAR;
        PG8_STAGE(PG8_SB(1, 0), cB + kstep, voffB); PG8_STAGE(PG8_SA(1, 0), cA + kstep, voffA); PG8_STAGE(PG8_SB(1, 1), cB + hstep + kstep, voffB);
        PG8_WAIT_V(6); PG8_BAR;
    }
    for (;;) {
        const bool has_next = S.next(ui + 1, nxt);
        const char* nA = has_next ? nxt.A : cA; const char* nB = has_next ? nxt.B : cB;
        for (int t = 0; t < nt; t += 2) {
            const bool last = (t == nt - 2);
            const char* a1 = cA + (size_t)(t + 1) * kstep;
            const char* a2 = last ? nA : cA + (size_t)(t + 2) * kstep; const char* b2 = last ? nB : cB + (size_t)(t + 2) * kstep;
            const char* a3 = a2 + kstep; const char* b3 = b2 + kstep;
            if (last && has_next) S.a_ready(nxt);
            if constexpr (SP2) {
            PG8_LDB(B0, 0, 0); PG8_LDB(B1, 0, 1); PG8_SCHED; PG8_LDA(At, 0, 0); PG8_STAGE(PG8_SA(1, 1), a1 + hstep, voffA);
            PG8_WAIT_V(8); PG8_WAIT_L(0); PG8_BAR; PG8_MMA(0, 0, At, B0); PG8_MMA(0, 1, At, B1); PG8_BAR; PG8_SCHED;
            PG8_LDA(At, 0, 1); PG8_STAGE(PG8_SB(0, 0), b2, voffB); PG8_STAGE(PG8_SB(0, 1), b2 + hstep, voffB); PG8_STAGE(PG8_SA(0, 0), a2, voffA);
            PG8_WAIT_V(8); PG8_WAIT_L(0); PG8_BAR; PG8_MMA(1, 0, At, B0); PG8_MMA(1, 1, At, B1); PG8_BAR; PG8_SCHED;
            PG8_LDB(B0, 1, 0); PG8_LDB(B1, 1, 1); PG8_SCHED; PG8_LDA(At, 1, 0); PG8_STAGE(PG8_SA(0, 1), a2 + hstep, voffA);
            PG8_WAIT_V(8); PG8_WAIT_L(0); PG8_BAR; PG8_MMA(0, 0, At, B0); PG8_MMA(0, 1, At, B1); PG8_BAR; PG8_SCHED;
            PG8_LDA(At, 1, 1); PG8_STAGE(PG8_SB(1, 0), b3, voffB); PG8_STAGE(PG8_SB(1, 1), b3 + hstep, voffB); PG8_STAGE(PG8_SA(1, 0), a3, voffA);
            PG8_WAIT_V(8); PG8_WAIT_L(0); PG8_BAR; PG8_MMA(1, 0, At, B0); PG8_MMA(1, 1, At, B1); PG8_BAR; PG8_SCHED;
            } else {
            PG8_LDB(B0, 0, 0); PG8_SCHED; PG8_LDA(At, 0, 0); PG8_STAGE(PG8_SA(1, 1), a1 + hstep, voffA);
            PG8_WAIT_L(8); PG8_BAR; PG8_WAIT_L(0); PG8_MMA(0, 0, At, B0); PG8_BAR; PG8_SCHED;
            PG8_LDB(B1, 0, 1); PG8_STAGE(PG8_SB(0, 0), b2, voffB);
            PG8_BAR; PG8_WAIT_L(0); PG8_MMA(0, 1, At, B1); PG8_BAR;
            PG8_LDA(At, 0, 1); PG8_STAGE(PG8_SA(0, 0), a2, voffA);
            PG8_BAR; PG8_WAIT_L(0); PG8_MMA(1, 0, At, B0); PG8_BAR; PG8_SCHED;
            PG8_STAGE(PG8_SB(0, 1), b2 + hstep, voffB);
            PG8_WAIT_V(6); PG8_BAR; PG8_MMA(1, 1, At, B1); PG8_BAR;
            PG8_LDB(B0, 1, 0); PG8_SCHED; PG8_LDA(At, 1, 0); PG8_STAGE(PG8_SA(0, 1), a2 + hstep, voffA);
            PG8_WAIT_L(8); PG8_BAR; PG8_WAIT_L(0); PG8_MMA(0, 0, At, B0); PG8_BAR; PG8_SCHED;
            PG8_LDB(B1, 1, 1); PG8_STAGE(PG8_SB(1, 0), b3, voffB);
            PG8_BAR; PG8_WAIT_L(0); PG8_MMA(0, 1, At, B1); PG8_BAR;
            PG8_LDA(At, 1, 1); PG8_STAGE(PG8_SA(1, 0), a3, voffA);
            PG8_BAR; PG8_WAIT_L(0); PG8_MMA(1, 0, At, B0); PG8_BAR; PG8_SCHED;
            PG8_STAGE(PG8_SB(1, 1), b3 + hstep, voffB);
            PG8_WAIT_V(6); PG8_BAR; PG8_MMA(1, 1, At, B1); PG8_BAR;
            }
        }
        if constexpr (ALIGN_EPI) { if (wr == 0) PG8_BAR; }
        if constexpr (!Epi::AFTER_DRAIN) { E(acc, cur, wr, wc, fr, fq); S.done(cur); }
        if (!has_next) break;
#pragma unroll
        for (int a = 0; a < 2; ++a)
#pragma unroll
            for (int b = 0; b < 2; ++b)
#pragma unroll
                for (int m = 0; m < 4; ++m)
#pragma unroll
                    for (int n = 0; n < 2; ++n) acc[a][b][m][n] = (f32x4){0.f, 0.f, 0.f, 0.f};
        cur = nxt; cA = nA; cB = nB; ++ui;
        if constexpr (ALIGN_EPI) { if (wr == 1) PG8_BAR; }
    }
    PG8_WAIT_V(0);
    if constexpr (!ALIGN_EPI) { if (wr == 0) PG8_BAR; }
    PG8_BAR;
    if constexpr (Epi::AFTER_DRAIN) { E.fused(acc, cur, wr, wc, fr, fq, lds, wid, lane); S.done(cur); }
#undef PG8_SA
#undef PG8_SB
#undef PG8_STAGE
#undef PG8_LDA
#undef PG8_LDB
#undef PG8_MMA
#undef PG8_WAIT_V
#undef PG8_WAIT_L
#undef PG8_BAR
#undef PG8_SCHED
}
}

#ifndef EXP_ZERO_HG
#define EXP_ZERO_HG 0
#endif
#ifndef EXP_ZERO_S5
#define EXP_ZERO_S5 0
#endif
#ifndef EXP_ZERO_MOE
#define EXP_ZERO_MOE 0
#endif
#ifndef EXP_ZERO_FFN
#define EXP_ZERO_FFN 0
#endif
#ifndef EXP_PROBE
#define EXP_PROBE 0
#endif
#ifndef EXP_ZERO_GLU
#define EXP_ZERO_GLU 0
#endif
#ifndef EXP_ZERO_PLE
#define EXP_ZERO_PLE 0
#endif
#ifndef EXP_PROBE_LAYER
#define EXP_PROBE_LAYER 1
#endif
#ifndef EXP_TIMING
#define EXP_TIMING 0
#endif
#ifndef EXP_TIMING_CAT
#define EXP_TIMING_CAT 1
#endif
#ifndef EXP_MIXTIME
#define EXP_MIXTIME 0
#endif
#ifndef EXP_MIXTIME_CAT
#define EXP_MIXTIME_CAT 0
#endif
#ifndef EXP_ZERO_SSD
#define EXP_ZERO_SSD 0
#endif
#ifndef MIX_MFMA
#define MIX_MFMA 1
#endif
#ifndef S5_MFMA
#define S5_MFMA 1
#endif
constexpr int NB = 8, SEQ = 2048, D = 1024, T = NB * SEQ, DEPTH = 4, PLE = 256;
constexpr int HGH = 4, HGD = 128, HGW = 512;
constexpr int M2H = 8, M2P = 64, M2I = 512, M2N = 128, M2XBC = 1024;
constexpr int EIN = 4112, EINP = 4096;
constexpr int S5G = 64, S5N = 64, S5C = 16;
constexpr int FF = 3584, NE = 8;
constexpr int MOE_ROWS = 2 * T + NE * 256;
constexpr float EPS = 1e-6f;
constexpr int NWAVES = 8, NTHR = 512;

constexpr size_t MiB = 1u << 20;
constexpr size_t WS_CTL = 0, CTL_ZERO_BYTES = 1 * MiB;
constexpr size_t WS_WIN = 1 * MiB;
constexpr size_t WS_WOUT = WS_WIN + 16 * MiB;
constexpr size_t WS_WGU = WS_WOUT + 4 * MiB;
constexpr size_t WS_WDN = WS_WGU + 28 * MiB;
constexpr size_t WS_WGLU = WS_WDN + 14 * MiB;
constexpr size_t WS_WPG = WS_WGLU + 8 * MiB;
constexpr size_t WS_WPP = WS_WPG + 8 * MiB;
constexpr size_t WS_WMGU = WS_WPP + 2 * MiB;
constexpr size_t WS_WMDN = WS_WMGU + 224 * MiB;
constexpr size_t WS_WDT = WS_WMDN + 112 * MiB;
constexpr size_t WS_H = WS_WDT + 1 * MiB;
constexpr size_t WS_HN = WS_H + 64 * MiB;
constexpr size_t WS_MIX = WS_HN + 32 * MiB;
constexpr size_t WS_PB = WS_MIX + 32 * MiB;
constexpr size_t WS_PP = WS_PB + 32 * MiB;
constexpr size_t WS_XBUF = WS_PP + 128 * MiB;
constexpr size_t WS_YBUF = WS_XBUF + 68 * MiB;
constexpr size_t WS_DT = WS_YBUF + 136 * MiB;
constexpr size_t WS_ROUTE = WS_DT + 1 * MiB;
constexpr size_t WS_R = WS_ROUTE + 1 * MiB;
constexpr size_t WS_PROJ = WS_R, WS_XBC = WS_R + 128 * MiB, WS_OA = WS_R + 160 * MiB, WS_YA = WS_R + 224 * MiB, WS_ACT = WS_R, WS_YS = WS_R;
constexpr size_t WS_HN2 = WS_R + 288 * MiB;
constexpr size_t WS_SSQ1 = WS_HN2 + 32 * MiB, WS_SSQ2 = WS_SSQ1 + 1 * MiB;
constexpr size_t WS_END = WS_SSQ2 + 1 * MiB;
static_assert((size_t)MOE_ROWS * FF * 2 <= 288 * MiB && (size_t)MOE_ROWS * D * 2 <= 68 * MiB && (size_t)MOE_ROWS * D * 4 <= 136 * MiB, "ws map");
constexpr int CW_BAR = 4096;

constexpr int RING_BYTES = 131072;
constexpr int RTAB_UNITS = 15;
constexpr int LDS_BYTES = 147456;
constexpr int MISC_OFF = LDS_BYTES - 128;

#define GAS __attribute__((address_space(1)))
#define LAS __attribute__((address_space(3)))
typedef unsigned short bf16;
typedef unsigned v4u __attribute__((ext_vector_type(4)));
typedef unsigned v2u __attribute__((ext_vector_type(2)));
typedef float f32x4 __attribute__((ext_vector_type(4)));
typedef int v4i __attribute__((ext_vector_type(4)));
#define LDS_WAIT() asm volatile("s_waitcnt lgkmcnt(0)" ::: "memory")
__device__ __forceinline__ unsigned f2bf(float f) { unsigned u = __builtin_bit_cast(unsigned, f); return (u + 0x7fffu + ((u >> 16) & 1u)) >> 16; }
__device__ __forceinline__ unsigned pk2(float lo, float hi) { return f2bf(lo) | (f2bf(hi) << 16); }
__device__ __forceinline__ float bflo(unsigned w) { return __uint_as_float(w << 16); }
__device__ __forceinline__ float bfhi(unsigned w) { return __uint_as_float(w & 0xffff0000u); }
__device__ __forceinline__ float bf1(bf16 b) { return __uint_as_float((unsigned)b << 16); }
__device__ __forceinline__ float sigm(float x) { return 1.0f / (1.0f + __expf(-x)); }
__device__ __forceinline__ float silu_f(float x) { return x * sigm(x); }
__device__ __forceinline__ float softplus_f(float x) { return x > 20.f ? x : log1pf(__expf(x)); }
__device__ __forceinline__ float gelu_tanh(float x) { const float u = 0.7978845608028654f * (x + 0.044715f * x * x * x); return 0.5f * x * (1.0f + tanhf(u)); }
__device__ __forceinline__ float sx(float v, int o, int lane) { return __builtin_bit_cast(float, __builtin_amdgcn_ds_bpermute((lane ^ o) << 2, __builtin_bit_cast(int, v))); }
__device__ __forceinline__ float wave_sum(float v, int lane) {
#pragma unroll
    for (int o = 1; o < 64; o <<= 1) v += sx(v, o, lane);
    return v;
}
#define XB_TMO      128
#define XB_XCNT(j)  (256  + 64 * (j))
#define XB_XSUB(j)  (1280 + 64 * (j))
#define XB_XGEN(j)  (2304 + 64 * (j))
#define XB_TOP      3328
#define XB_TOPGEN   3392
#define XCD_BAR_WORDS 3456
#define XB_SPIN_CAP (1u << 18)

__device__ __forceinline__ unsigned xb_ld(unsigned* p)              { return __hip_atomic_load(p, __ATOMIC_RELAXED, __HIP_MEMORY_SCOPE_AGENT); }
__device__ __forceinline__ unsigned xb_add(unsigned* p, unsigned v) { return __hip_atomic_fetch_add(p, v, __ATOMIC_RELAXED, __HIP_MEMORY_SCOPE_AGENT); }
__device__ __forceinline__ unsigned xb_xcc_id() { return (unsigned)__builtin_amdgcn_s_getreg((3 << 11) | 20) & 0xFu; }
#define XB_SPIN(cond, bar) do { unsigned _sp = 0; while (cond) { __builtin_amdgcn_s_sleep(1); \
    if ((++_sp & 255u) == 0u) { if (xb_ld(&(bar)[XB_TMO])) break; if (_sp > XB_SPIN_CAP) { atomicAdd(&(bar)[XB_TMO], 1u); break; } } } } while (0)

struct XcdBarrier {
    unsigned* bar; unsigned x;
    volatile LAS unsigned* st;
};

__device__ __forceinline__ XcdBarrier xcd_barrier_post(unsigned* bar, volatile LAS unsigned* st) {
    XcdBarrier b; b.bar = bar; b.x = xb_xcc_id(); b.st = st;
    if (threadIdx.x == 0) (void)xb_add(&bar[XB_XCNT(b.x)], 1u);
    return b;
}
__device__ __forceinline__ void xcd_barrier_complete(unsigned* bar, unsigned x, unsigned& nloc, unsigned& nx) {
    const unsigned G = gridDim.x * gridDim.y * gridDim.z;
    unsigned sum, cnt, mine, sp = 0u;
    for (;;) {
        sum = 0u; cnt = 0u; mine = 0u;
#pragma unroll
        for (unsigned j = 0; j < 16; ++j) { const unsigned c = xb_ld(&bar[XB_XCNT(j)]); sum += c; cnt += (c > 0u) ? 1u : 0u; mine = (j == x) ? c : mine; }
        if (sum == G) break;
        __builtin_amdgcn_s_sleep(1);
        if ((++sp & 255u) == 0u) { if (xb_ld(&bar[XB_TMO])) break; if (sp > XB_SPIN_CAP) { atomicAdd(&bar[XB_TMO], 1u); break; } }
    }
    nloc = mine > 0u ? mine : 1u; nx = cnt > 0u ? cnt : 1u;
}

__device__ __forceinline__ void xcd_barrier(const XcdBarrier& b) {
    asm volatile("s_waitcnt vmcnt(0)" ::: "memory");
    __syncthreads();
    if (threadIdx.x == 0) {
        unsigned* bar = b.bar;
        __builtin_amdgcn_s_waitcnt(0);
        unsigned nloc = b.st[0], nx = b.st[1];
        if (nloc == 0u) { xcd_barrier_complete(bar, b.x, nloc, nx); b.st[0] = nloc; b.st[1] = nx; }
        const unsigned old = xb_add(&bar[XB_XSUB(b.x)], 1u);
        const unsigned gen = old / nloc;
        if (old + 1u == (gen + 1u) * nloc) {
            __builtin_amdgcn_fence(__ATOMIC_RELEASE, "agent");
            asm volatile("s_waitcnt vmcnt(0)" ::: "memory");
            const unsigned og = xb_add(&bar[XB_TOP], 1u);
            const unsigned tg = og / nx;
            if (og + 1u == (tg + 1u) * nx) xb_add(&bar[XB_TOPGEN], 1u);
            else XB_SPIN(xb_ld(&bar[XB_TOPGEN]) == tg, bar);
            __builtin_amdgcn_fence(__ATOMIC_ACQUIRE, "agent");
            xb_add(&bar[XB_XGEN(b.x)], 1u);
            asm volatile("s_waitcnt vmcnt(0)" ::: "memory");
        } else {
            XB_SPIN(xb_ld(&bar[XB_XGEN(b.x)]) == gen, bar);
            __builtin_amdgcn_fence(__ATOMIC_ACQUIRE, "agent");
            asm volatile("s_waitcnt vmcnt(0)" ::: "memory");
        }
    }
    __syncthreads();
}


enum { I_X = 0, I_P, I_NORM_MIX, I_NORM_FFN, I_NORM_PLE, I_FINAL_NORM, I_PLE_GATE, I_PLE_PROJ, I_EV_W_IN, I_EV_W_OUT, I_HG_LB, I_HG_NORM_W, I_M2_CONV_W, I_M2_CONV_B, I_M2_DT_BIAS, I_M2_A_LOG, I_M2_D,
       I_M2_NORM_W, I_S5_A_RE, I_S5_A_IM, I_S5_LOG_STEP, I_S5_B_RE, I_S5_B_IM, I_S5_C_RE, I_S5_C_IM, I_S5_D, I_S5_GLU_W, I_FFN_W_GU, I_FFN_W_DOWN, I_MOE_ROUTER, I_MOE_W_GU, I_MOE_W_DOWN, N_IN };
struct Args { const float* in[N_IN]; float* out; unsigned char* ws; int ph_lo, ph_hi; };

__device__ __forceinline__ float load_row_rstd(const float* row, int lane, f32x4 (&v)[4]) {
    const f32x4* xr = (const f32x4*)row + lane; float s = 0.f;
#pragma unroll
    for (int j = 0; j < 4; ++j) { v[j] = xr[64 * j]; s += (v[j][0] * v[j][0] + v[j][1] * v[j][1]) + (v[j][2] * v[j][2] + v[j][3] * v[j][3]); }
    return 1.0f / sqrtf(wave_sum(s, lane) * (1.0f / D) + EPS);
}
__device__ __forceinline__ void store_row_bf16(bf16* orow, int lane, const f32x4 (&v)[4], float rstd) {
    unsigned long long* o8 = (unsigned long long*)orow + lane;
#pragma unroll
    for (int j = 0; j < 4; ++j) o8[64 * j] = (unsigned long long)pk2(v[j][0] * rstd, v[j][1] * rstd) | ((unsigned long long)pk2(v[j][2] * rstd, v[j][3] * rstd) << 32);
}
constexpr int TR_LDS = 64 * 65 * 4;
__device__ __forceinline__ void transpose_item(const float* W, int K, int ldw, bf16* WT, int Ndst, int half, const float* scale, LAS float* scr, int item, int lane) {
    const int nblk = Ndst / 64, kb = item / nblk, nb = item % nblk, k0 = 64 * kb, n0 = 64 * nb;
    int s0 = n0;
    if (half) { const int tile = n0 >> 8, w = n0 & 255; s0 = (w < 128) ? (128 * tile + w) : (half + 128 * tile + (w - 128)); }
    const int lq = lane >> 4, lc = 4 * (lane & 15);
#pragma unroll 8
    for (int i = 0; i < 16; ++i) { const int kk = lq + 4 * i; f32x4 x = *(const f32x4*)(W + (size_t)(k0 + kk) * ldw + s0 + lc); if (scale) x = x * scale[k0 + kk];
        LAS float* d = scr + kk * 65 + lc; d[0] = x[0]; d[1] = x[1]; d[2] = x[2]; d[3] = x[3]; }
    LDS_WAIT(); asm volatile("" ::: "memory");
    const int c = lane & 7;
#pragma unroll
    for (int j = 0; j < 8; ++j) { const int n = (lane >> 3) + 8 * j; const LAS float* s = scr + (8 * c) * 65 + n;
        v4u o; o.x = pk2(s[0 * 65], s[1 * 65]); o.y = pk2(s[2 * 65], s[3 * 65]); o.z = pk2(s[4 * 65], s[5 * 65]); o.w = pk2(s[6 * 65], s[7 * 65]);
        *(v4u*)(WT + (size_t)(n0 + n) * K + k0 + 8 * c) = o; }
    LDS_WAIT(); asm volatile("" ::: "memory");
}
constexpr int CI_IN = 16 * 64, CI_OUT = 16 * 16, CI_GU = 16 * 112, CI_DN = 56 * 16, CI_GLU = 16 * 32, CI_PG = 16 * 16, CI_PPJ = 4 * 16;
constexpr int CN_SMALL = 2 * CI_IN + 2 * CI_OUT + 2 * CI_GU + 2 * CI_DN + 2 * CI_GLU + 4 * CI_PG + 4 * CI_PPJ, CN_MOE = 8 * CI_GU + 8 * CI_DN;
__device__ __forceinline__ void convert_small_item(const Args& a, unsigned char* ws, LAS float* scr, int it, int lane) {
    int r = it;
    if (r < 2 * CI_IN) { const int j = r / CI_IN; transpose_item(a.in[I_EV_W_IN] + (size_t)j * D * EIN, D, EIN, (bf16*)(ws + WS_WIN) + (size_t)j * EINP * D, EINP, 0, a.in[I_NORM_MIX] + (2 * j) * D, scr, r % CI_IN, lane); return; } r -= 2 * CI_IN;
    if (r < 2 * CI_OUT) { const int j = r / CI_OUT; transpose_item(a.in[I_EV_W_OUT] + (size_t)j * D * D, D, D, (bf16*)(ws + WS_WOUT) + (size_t)j * D * D, D, 0, nullptr, scr, r % CI_OUT, lane); return; } r -= 2 * CI_OUT;
    if (r < 2 * CI_GU) { const int j = r / CI_GU; transpose_item(a.in[I_FFN_W_GU] + (size_t)j * D * 2 * FF, D, 2 * FF, (bf16*)(ws + WS_WGU) + (size_t)j * 2 * FF * D, 2 * FF, FF, a.in[I_NORM_FFN] + (2 * j) * D, scr, r % CI_GU, lane); return; } r -= 2 * CI_GU;
    if (r < 2 * CI_DN) { const int j = r / CI_DN; transpose_item(a.in[I_FFN_W_DOWN] + (size_t)j * FF * D, FF, D, (bf16*)(ws + WS_WDN) + (size_t)j * D * FF, D, 0, nullptr, scr, r % CI_DN, lane); return; } r -= 2 * CI_DN;
    if (r < 2 * CI_GLU) { const int j = r / CI_GLU; transpose_item(a.in[I_S5_GLU_W] + (size_t)j * D * 2 * D, D, 2 * D, (bf16*)(ws + WS_WGLU) + (size_t)j * 2 * D * D, 2 * D, D, nullptr, scr, r % CI_GLU, lane); return; } r -= 2 * CI_GLU;
    if (r < 4 * CI_PG) { const int l = r / CI_PG; transpose_item(a.in[I_PLE_GATE] + (size_t)l * D * D, D, D, (bf16*)(ws + WS_WPG) + (size_t)l * D * D, D, 0, a.in[I_NORM_PLE] + l * D, scr, r % CI_PG, lane); return; } r -= 4 * CI_PG;
    { const int l = r / CI_PPJ; transpose_item(a.in[I_PLE_PROJ] + (size_t)l * PLE * D, PLE, D, (bf16*)(ws + WS_WPP) + (size_t)l * D * PLE, D, 0, nullptr, scr, r % CI_PPJ, lane); }
}
__device__ __forceinline__ void convert_moe_item(const Args& a, unsigned char* ws, int j, LAS float* scr, int it, int lane) {
    if (it < 8 * CI_GU) { const int je = j * 8 + it / CI_GU; transpose_item(a.in[I_MOE_W_GU] + (size_t)je * D * 2 * FF, D, 2 * FF, (bf16*)(ws + WS_WMGU) + (size_t)je * 2 * FF * D, 2 * FF, FF, a.in[I_NORM_FFN] + (2 * j + 1) * D, scr, it % CI_GU, lane); return; }
    const int r = it - 8 * CI_GU; const int je = j * 8 + r / CI_DN; transpose_item(a.in[I_MOE_W_DOWN] + (size_t)je * FF * D, FF, D, (bf16*)(ws + WS_WMDN) + (size_t)je * D * FF, D, 0, nullptr, scr, r % CI_DN, lane);
}
__device__ __forceinline__ void prologue_phase(const Args& a, unsigned char* ws, LAS unsigned char* lds, int tid, int lane, int wave, int bid, int G) {
    LAS float* scr = (LAS float*)(lds + wave * TR_LDS);
    const int gw = bid * NWAVES + wave, NGW = G * NWAVES;
    for (int it = gw; it < CN_SMALL; it += NGW) convert_small_item(a, ws, scr, it, lane);
    for (int row = gw; row < T; row += NGW) { f32x4 v[4]; const f32x4* xr = (const f32x4*)(a.in[I_X] + (size_t)row * D) + lane; float ss = 0.f;
#pragma unroll
        for (int jj = 0; jj < 4; ++jj) { v[jj] = xr[64 * jj]; ss += (v[jj][0] * v[jj][0] + v[jj][1] * v[jj][1]) + (v[jj][2] * v[jj][2] + v[jj][3] * v[jj][3]); }
        ss = wave_sum(ss, lane); store_row_bf16((bf16*)(ws + WS_HN2) + (size_t)row * D, lane, v, 1.0f);
        if (lane < 16) ((float*)(ws + WS_SSQ2))[(size_t)row * 16 + lane] = lane == 0 ? ss : 0.f; }
    const int gt = bid * NTHR + tid, NT = G * NTHR;
    { const f32x4* src = (const f32x4*)a.in[I_P]; v4u* dst = (v4u*)(ws + WS_PB);
      for (int i = gt; i < DEPTH * T * PLE / 8; i += NT) { const f32x4 x0 = src[2 * (size_t)i], x1 = src[2 * (size_t)i + 1]; v4u o; o.x = pk2(x0[0], x0[1]); o.y = pk2(x0[2], x0[3]); o.z = pk2(x1[0], x1[1]); o.w = pk2(x1[2], x1[3]); dst[i] = o; } }
    { float* wdt = (float*)(ws + WS_WDT);
      for (int i = gt; i < 2 * D * 16; i += NT) { const int j = i / (D * 16), c = (i / 16) % D, o = i % 16; wdt[i] = a.in[I_NORM_MIX][(2 * j) * D + c] * a.in[I_EV_W_IN][(size_t)j * D * EIN + (size_t)c * EIN + EINP + o]; }
      float* wr = (float*)(ws + WS_WDT + 256 * 1024);
      for (int i = gt; i < 2 * D * 8; i += NT) { const int j = i / (D * 8), c = (i / 8) % D, e = i % 8; wr[i] = a.in[I_NORM_FFN][(2 * j + 1) * D + c] * a.in[I_MOE_ROUTER][(size_t)j * D * 8 + c * 8 + e]; }
      float* lb = (float*)(ws + WS_WDT + 512 * 1024);
      for (int i = gt; i < HGW; i += NT) { const float l0 = a.in[I_HG_LB][i], l1 = a.in[I_HG_LB][HGW + i], m = fmaxf(l0, l1), e0 = expf(l0 - m), e1 = expf(l1 - m), s0 = e0 / (e0 + e1), s1 = e1 / (e0 + e1);
          lb[i] = s0 - s0; lb[HGW + i] = (s0 + s1) - s0; } }
}

__device__ __forceinline__ void norm_phase(const float* src, bf16* HN, int lane, int wave, int bid, int G) {
    const int gw = bid * NWAVES + wave, NGW = G * NWAVES;
    for (int row = gw; row < T; row += NGW) { f32x4 v[4]; const float rstd = load_row_rstd(src + (size_t)row * D, lane, v); store_row_bf16(HN + (size_t)row * D, lane, v, rstd); }
}
__device__ __forceinline__ void norm_even_phase(const float* src, bf16* HN, const float* wdt  , const float* dt_bias  , float* DT, LAS unsigned char* lds, int tid, int lane, int wave, int bid, int G) {
    LAS float* wl = (LAS float*)lds;
    for (int i = tid; i < D * 16; i += NTHR) wl[(i & 15) * D + (i >> 4)] = wdt[i];
    __syncthreads();
    const int gw = bid * NWAVES + wave, NGW = G * NWAVES;
    for (int row = gw; row < T; row += NGW) {
        f32x4 v[4]; const float rstd = load_row_rstd(src + (size_t)row * D, lane, v); store_row_bf16(HN + (size_t)row * D, lane, v, rstd);
        float mine = 0.f;
#pragma nounroll
        for (int o = 0; o < 16; ++o) { float s = 0.f;
#pragma unroll
            for (int j = 0; j < 4; ++j) { const f32x4 w = *(const LAS f32x4*)(wl + o * D + 256 * j + 4 * lane); s += (v[j][0] * w[0] + v[j][1] * w[1]) + (v[j][2] * w[2] + v[j][3] * w[3]); }
            s = wave_sum(s, lane); mine = (lane == o) ? s : mine; }
        if (lane < 16) DT[(size_t)row * 16 + lane] = softplus_f(mine * rstd + dt_bias[lane]);
    }
    __syncthreads();
}
__device__ __forceinline__ void final_phase(const float* H, const float* w, float* out, int lane, int wave, int bid, int G, const int* diag = nullptr) {
    const int gw = bid * NWAVES + wave, NGW = G * NWAVES;
    for (int row = gw; row < T; row += NGW) { f32x4 v[4]; const float rstd = load_row_rstd(H + (size_t)row * D, lane, v);
        f32x4* o = (f32x4*)(out + (size_t)row * D) + lane; const f32x4* wv = (const f32x4*)w + lane;
#pragma unroll
        for (int j = 0; j < 4; ++j) o[64 * j] = v[j] * rstd * wv[64 * j] * ((EXP_PROBE || EXP_TIMING || EXP_MIXTIME) ? (float)(1 + diag[0]) : 1.0f); }
}

__device__ __forceinline__ void conv_phase(const bf16* PROJ, const float* cw, const float* cb, bf16* XBC, const bf16* HB, const float* SSQ, const float* wdt  , const float* dt_bias  , float* DT,
                                           LAS unsigned char* lds, int tid, int lane, int wave, int bid, int G) {
    { LAS float* wl = (LAS float*)lds;
      for (int i = tid; i < D * 16; i += NTHR) wl[(i & 15) * D + (i >> 4)] = wdt[i];
      __syncthreads();
      const int gw = bid * NWAVES + wave, NGW = G * NWAVES;
      for (int row = gw; row < T; row += NGW) {
          const v2u* hr = (const v2u*)(HB + (size_t)row * D) + lane; f32x4 v[4];
#pragma unroll
          for (int jj = 0; jj < 4; ++jj) { const v2u w = hr[64 * jj]; v[jj] = (f32x4){bflo(w.x), bfhi(w.x), bflo(w.y), bfhi(w.y)}; }
          const float rstd = pg8::row_rstd(SSQ, row);
          float mine = 0.f;
#pragma nounroll
          for (int o = 0; o < 16; ++o) { float s = 0.f;
#pragma unroll
              for (int jj = 0; jj < 4; ++jj) { const f32x4 w = *(const LAS f32x4*)(wl + o * D + 256 * jj + 4 * lane); s += (v[jj][0] * w[0] + v[jj][1] * w[1]) + (v[jj][2] * w[2] + v[jj][3] * w[3]); }
              s = wave_sum(s, lane); mine = (lane == o) ? s : mine; }
          if (lane < 16) DT[(size_t)row * 16 + lane] = softplus_f(mine * rstd + dt_bias[lane]);
      } }
    const size_t gt = (size_t)bid * NTHR + tid, NT = (size_t)G * NTHR;
    for (size_t idx = gt; idx < (size_t)T * 128; idx += NT) {
        const int t = (int)(idx >> 7), c = 8 * (int)(idx & 127), s = t & (SEQ - 1);
        float acc[8]; { const f32x4 b0 = *(const f32x4*)(cb + c), b1 = *(const f32x4*)(cb + c + 4); acc[0] = b0[0]; acc[1] = b0[1]; acc[2] = b0[2]; acc[3] = b0[3]; acc[4] = b1[0]; acc[5] = b1[1]; acc[6] = b1[2]; acc[7] = b1[3]; }
#pragma unroll
        for (int w = 0; w < 5; ++w) { const int ts = s + w - 2;
            if (ts >= 0 && ts < SEQ) { const v4u x = *(const v4u*)(PROJ + (size_t)(t + w - 2) * EINP + 3072 + c); const f32x4 k0 = *(const f32x4*)(cw + w * M2XBC + c), k1 = *(const f32x4*)(cw + w * M2XBC + c + 4);
                acc[0] += bflo(x.x) * k0[0]; acc[1] += bfhi(x.x) * k0[1]; acc[2] += bflo(x.y) * k0[2]; acc[3] += bfhi(x.y) * k0[3];
                acc[4] += bflo(x.z) * k1[0]; acc[5] += bfhi(x.z) * k1[1]; acc[6] += bflo(x.w) * k1[2]; acc[7] += bfhi(x.w) * k1[3]; } }
        v4u o; o.x = pk2(silu_f(acc[0]), silu_f(acc[1])); o.y = pk2(silu_f(acc[2]), silu_f(acc[3])); o.z = pk2(silu_f(acc[4]), silu_f(acc[5])); o.w = pk2(silu_f(acc[6]), silu_f(acc[7]));
        *(v4u*)(XBC + (size_t)t * M2XBC + c) = o;
    }
}
constexpr int TB = 16;
template <int MODE>
__device__ __forceinline__ void scan_item(int item, const bf16* PROJ, const bf16* XBC, const float* DT, const float* lbv  , const float* a_log  , float* OUT  , LAS unsigned char* lds, int tid) {
    LAS float* qs = (LAS float*)lds;
    LAS float* fs = qs + 2 * TB * 128;
    LAS float* ks = fs + 2 * TB * 128;
    LAS float* vs = ks + 2 * TB * 128;
    LAS float* sc = vs + 2 * TB * 32;
    LAS float* op = sc + 2 * TB * 2;
    const int part = MODE == 0 ? (item & 3) : (item & 1), dir = MODE == 0 ? ((item >> 2) & 1) : ((item >> 1) & 1), head = MODE == 0 ? ((item >> 3) & 3) : ((item >> 2) & 7), b = item >> 5;
    const int vv = tid & 31, dg = tid >> 5;
    const int si = tid >> 5, seg = tid & 31;
    const int colq = MODE == 0 ? head * 128 + 4 * seg : 3072 + 768 + (head >> 2) * 128 + 4 * seg;
    const int colf = MODE == 0 ? (dir == 0 ? 512 : 1024) + head * 128 + 4 * seg : 3072 + 512 + (head >> 2) * 128 + 4 * seg;
    const int colv = MODE == 0 ? 1536 + head * 128 + part * 32 + seg : 3072 + head * 64 + part * 32 + seg;
    float lb4[4] = {0.f, 0.f, 0.f, 0.f}; float Aneg = 0.f;
    if (MODE == 0) {
#pragma unroll
        for (int e = 0; e < 4; ++e) lb4[e] = lbv[head * 128 + 4 * seg + e];
    } else Aneg = -expf(a_log[dir * 8 + head]);
    float S[8];
#pragma unroll
    for (int e = 0; e < 8; ++e) S[e] = 0.f;
    constexpr int NBLK = SEQ / TB;
    v2u rq, rf; bf16 rv; float rdt = 0.f;
#define SCAN_TROW(blk, i) ((size_t)b * SEQ + (dir == 0 ? ((blk) * TB + (i)) : (SEQ - 1 - ((blk) * TB + (i)))))
#define SCAN_LOAD(blk) do { const size_t tr = SCAN_TROW(blk, si); \
        if (MODE == 0) { rq = *(const v2u*)(PROJ + tr * EINP + colq); rf = *(const v2u*)(PROJ + tr * EINP + colf); rv = PROJ[tr * EINP + colv]; } \
        else { rq = *(const v2u*)(XBC + tr * M2XBC + (colq - 3072)); rf = *(const v2u*)(XBC + tr * M2XBC + (colf - 3072)); rv = XBC[tr * M2XBC + (colv - 3072)]; if (seg == 0) rdt = DT[tr * 16 + dir * 8 + head]; } } while (0)
#define SCAN_STAGE(buf) do { const int o4 = ((buf) * TB + si) * 128 + 4 * seg; \
        const float q0 = bflo(rq.x), q1 = bfhi(rq.x), q2 = bflo(rq.y), q3 = bfhi(rq.y), f0 = bflo(rf.x), f1 = bfhi(rf.x), f2 = bflo(rf.y), f3 = bfhi(rf.y); \
        if (MODE == 0) { const float g0 = sigm(f0), g1 = sigm(f1), g2 = sigm(f2), g3 = sigm(f3); \
            *(LAS f32x4*)(qs + o4) = (f32x4){silu_f(q0), silu_f(q1), silu_f(q2), silu_f(q3)}; \
            *(LAS f32x4*)(fs + o4) = (f32x4){fmaxf(lb4[0], 1e-30f) + (1.f - lb4[0]) * g0, fmaxf(lb4[1], 1e-30f) + (1.f - lb4[1]) * g1, fmaxf(lb4[2], 1e-30f) + (1.f - lb4[2]) * g2, fmaxf(lb4[3], 1e-30f) + (1.f - lb4[3]) * g3}; \
            *(LAS f32x4*)(ks + o4) = (f32x4){(1.f - lb4[0]) * (1.f - g0), (1.f - lb4[1]) * (1.f - g1), (1.f - lb4[2]) * (1.f - g2), (1.f - lb4[3]) * (1.f - g3)}; } \
        else { *(LAS f32x4*)(qs + o4) = (f32x4){q0, q1, q2, q3}; *(LAS f32x4*)(ks + o4) = (f32x4){f0, f1, f2, f3}; if (seg == 0) { sc[((buf) * TB + si) * 2] = __expf(rdt * Aneg); sc[((buf) * TB + si) * 2 + 1] = rdt; } } \
        vs[((buf) * TB + si) * 32 + seg] = bf1(rv); } while (0)
    SCAN_LOAD(0); SCAN_STAGE(0);
    __syncthreads();
    for (int blk = 0; blk < NBLK; ++blk) {
        const int cur = blk & 1;
        if (blk + 1 < NBLK) SCAN_LOAD(blk + 1);
#pragma unroll
        for (int i = 0; i < TB; ++i) {
            const int o8 = (cur * TB + i) * 128 + 8 * dg;
            const f32x4 qa = *(const LAS f32x4*)(qs + o8), qb = *(const LAS f32x4*)(qs + o8 + 4), ka = *(const LAS f32x4*)(ks + o8), kb = *(const LAS f32x4*)(ks + o8 + 4);
            const float vt = vs[(cur * TB + i) * 32 + vv];
            float acc = 0.f;
            if (MODE == 0) {
                const f32x4 fa = *(const LAS f32x4*)(fs + o8), fb = *(const LAS f32x4*)(fs + o8 + 4);
#pragma unroll
                for (int e = 0; e < 4; ++e) { S[e] = fa[e] * S[e] + ka[e] * vt; acc += qa[e] * S[e]; S[4 + e] = fb[e] * S[4 + e] + kb[e] * vt; acc += qb[e] * S[4 + e]; }
            } else {
                const float dec = sc[(cur * TB + i) * 2], dtx = sc[(cur * TB + i) * 2 + 1] * vt;
#pragma unroll
                for (int e = 0; e < 4; ++e) { S[e] = dec * S[e] + ka[e] * dtx; acc += qa[e] * S[e]; S[4 + e] = dec * S[4 + e] + kb[e] * dtx; acc += qb[e] * S[4 + e]; }
            }
            op[(i * 16 + dg) * 32 + vv] = acc;
        }
        __syncthreads();
        { float s = 0.f;
#pragma unroll
          for (int g = 0; g < 16; ++g) s += op[(si * 16 + g) * 32 + seg];
          const size_t tr = SCAN_TROW(blk, si);
          OUT[((size_t)dir * T + tr) * 512 + (MODE == 0 ? head * 128 + part * 32 : head * 64 + part * 32) + seg] = s; }
        if (blk + 1 < NBLK) SCAN_STAGE(cur ^ 1);
        __syncthreads();
    }
#undef SCAN_TROW
#undef SCAN_LOAD
#undef SCAN_STAGE
}
__device__ __forceinline__ void combine_even_phase(const bf16* PROJ, const bf16* XBC, const float* OA, const float* YA, const float* hg_nw, const float* m2_d, const float* m2_nw, bf16* MIX, int lane, int wave, int bid, int G) {
    const int gw = bid * NWAVES + wave, NGW = G * NWAVES, c0 = 8 * lane;
    for (int row = gw; row < T; row += NGW) {
        float o[8], y[8];
        { const f32x4 a0 = *(const f32x4*)(OA + (size_t)row * 512 + c0), a1 = *(const f32x4*)(OA + (size_t)row * 512 + c0 + 4), b0 = *(const f32x4*)(OA + ((size_t)T + row) * 512 + c0), b1 = *(const f32x4*)(OA + ((size_t)T + row) * 512 + c0 + 4);
#pragma unroll
          for (int e = 0; e < 4; ++e) { o[e] = a0[e] + b0[e]; o[4 + e] = a1[e] + b1[e]; } }
        float ss = 0.f;
#pragma unroll
        for (int e = 0; e < 8; ++e) ss += o[e] * o[e];
        ss += sx(ss, 1, lane); ss += sx(ss, 2, lane); ss += sx(ss, 4, lane); ss += sx(ss, 8, lane);
        const float r1 = 1.0f / sqrtf(ss * (1.0f / 128.0f) + EPS);
        { const v4u g = *(const v4u*)(PROJ + (size_t)row * EINP + 2048 + c0); const f32x4 w0 = *(const f32x4*)(hg_nw + c0), w1 = *(const f32x4*)(hg_nw + c0 + 4);
          const float gg[8] = {bflo(g.x), bfhi(g.x), bflo(g.y), bfhi(g.y), bflo(g.z), bfhi(g.z), bflo(g.w), bfhi(g.w)}; const float ww[8] = {w0[0], w0[1], w0[2], w0[3], w1[0], w1[1], w1[2], w1[3]};
#pragma unroll
          for (int e = 0; e < 8; ++e) o[e] = o[e] * r1 * ww[e] * sigm(gg[e]) * (float)(1 - EXP_ZERO_HG);
          v4u w; w.x = pk2(o[0], o[1]); w.y = pk2(o[2], o[3]); w.z = pk2(o[4], o[5]); w.w = pk2(o[6], o[7]); *(v4u*)(MIX + (size_t)row * D + c0) = w; }
        { const f32x4 a0 = *(const f32x4*)(YA + (size_t)row * 512 + c0), a1 = *(const f32x4*)(YA + (size_t)row * 512 + c0 + 4), b0 = *(const f32x4*)(YA + ((size_t)T + row) * 512 + c0), b1 = *(const f32x4*)(YA + ((size_t)T + row) * 512 + c0 + 4);
          const v4u x = *(const v4u*)(XBC + (size_t)row * M2XBC + c0), z = *(const v4u*)(PROJ + (size_t)row * EINP + 2560 + c0); const float dsk = m2_d[lane >> 3];
          const float xx[8] = {bflo(x.x), bfhi(x.x), bflo(x.y), bfhi(x.y), bflo(x.z), bfhi(x.z), bflo(x.w), bfhi(x.w)}; const float zz[8] = {bflo(z.x), bfhi(z.x), bflo(z.y), bfhi(z.y), bflo(z.z), bfhi(z.z), bflo(z.w), bfhi(z.w)};
#pragma unroll
          for (int e = 0; e < 4; ++e) { y[e] = (a0[e] + b0[e] + dsk * xx[e]) * silu_f(zz[e]); y[4 + e] = (a1[e] + b1[e] + dsk * xx[4 + e]) * silu_f(zz[4 + e]); } }
        float s2 = 0.f;
#pragma unroll
        for (int e = 0; e < 8; ++e) s2 += y[e] * y[e];
        s2 += sx(s2, 1, lane); s2 += sx(s2, 2, lane); s2 += sx(s2, 4, lane); s2 += sx(s2, 8, lane); s2 += sx(s2, 16, lane);
        const float r2 = 1.0f / sqrtf(s2 * (1.0f / 256.0f) + EPS);
        { const f32x4 w0 = *(const f32x4*)(m2_nw + c0), w1 = *(const f32x4*)(m2_nw + c0 + 4);
          if (EXP_ZERO_SSD) { for (int e = 0; e < 8; ++e) y[e] = 0.f; }
          v4u w; w.x = pk2(y[0] * r2 * w0[0], y[1] * r2 * w0[1]); w.y = pk2(y[2] * r2 * w0[2], y[3] * r2 * w0[3]); w.z = pk2(y[4] * r2 * w1[0], y[5] * r2 * w1[1]); w.w = pk2(y[6] * r2 * w1[2], y[7] * r2 * w1[3]);
          *(v4u*)(MIX + (size_t)row * D + 512 + c0) = w; }
    }
}

constexpr int MX_TD = 136, MX_SS = 72;
constexpr int MX_QT = 0, MX_KT = MX_QT + 64 * MX_TD * 2, MX_QH = MX_KT + 64 * MX_TD * 2, MX_KHT = MX_QH + 64 * MX_TD * 2, MX_VT = MX_KHT + 128 * MX_SS * 2, MX_VHT = MX_VT + 128 * MX_SS * 2;
constexpr int MX_F32 = MX_VHT + 128 * MX_SS * 2;
constexpr int MX_BS = 132;
static_assert(MX_VHT + (64 * MX_BS + 4 * 128 + 128) * 4 <= RING_BYTES && MX_F32 + 256 * 4 <= RING_BYTES, "mixer LDS map");
typedef short mx_bf16x8 __attribute__((ext_vector_type(8)));
typedef short mx_bf16x4 __attribute__((ext_vector_type(4)));
typedef float mx_f32x16 __attribute__((ext_vector_type(16)));
__device__ __forceinline__ mx_bf16x8 mx_pack8(const mx_f32x16& a, int base) {
    v4u w; w.x = pk2(a[base + 0], a[base + 1]); w.y = pk2(a[base + 2], a[base + 3]); w.z = pk2(a[base + 4], a[base + 5]); w.w = pk2(a[base + 6], a[base + 7]);
    return __builtin_bit_cast(mx_bf16x8, w);
}
__device__ __forceinline__ mx_bf16x8 mx_ld_perm(const LAS bf16* row, int k0, int h) {
    const v2u lo = *(const LAS v2u*)(row + k0 + 4 * h), hi = *(const LAS v2u*)(row + k0 + 8 + 4 * h);
    return __builtin_bit_cast(mx_bf16x8, (v4u){lo.x, lo.y, hi.x, hi.y});
}
template <int MODE>
__device__ __forceinline__ void mix_item(int item, const bf16* PROJ, const bf16* XBC, const float* DT, const float* lbv  , const float* a_log  , float* OUT  , LAS unsigned char* lds, int tid_unused, int lane, int wave, unsigned long long* tw = nullptr) {
    asm volatile("" : "+v"(lane));
    const int tid = wave * 64 + lane;
    const int dir = item & 1, hx = (item >> 1) & 3, b = item >> 3;
    LAS bf16* Qt = (LAS bf16*)(lds + MX_QT); LAS bf16* Kt = (LAS bf16*)(lds + MX_KT); LAS bf16* Qh = (LAS bf16*)(lds + MX_QH);
    LAS bf16* KhT = (LAS bf16*)(lds + MX_KHT); LAS bf16* VT = (LAS bf16*)(lds + MX_VT); LAS bf16* VhT = (LAS bf16*)(lds + MX_VHT);
    LAS float* bloc = (LAS float*)(lds + MX_VHT);
    LAS float* qsum = bloc + 64 * MX_BS;
    LAS float* lam = qsum + 4 * 128;
    LAS float* s_da = (LAS float*)(lds + MX_F32);
    LAS float* s_dt = s_da + 128;
    const int vs = wave & 3, tb = wave >> 2, l31 = lane & 31, lh = lane >> 5;
    mx_f32x16 Sacc[4];
#pragma unroll
    for (int db = 0; db < 4; ++db)
#pragma unroll
        for (int e = 0; e < 16; ++e) Sacc[db][e] = 0.f;
    float Aneg[2] = {0.f, 0.f};
    if (MODE == 1) { Aneg[0] = -expf(a_log[dir * 8 + 2 * hx]); Aneg[1] = -expf(a_log[dir * 8 + 2 * hx + 1]); }
#define MX_TOK(c, t) ((size_t)b * SEQ + (dir == 0 ? (64 * (c) + (t)) : (SEQ - 1 - (64 * (c) + (t)))))
#if EXP_MIXTIME
#define MXT(k) do { if (tw && blockIdx.x == 0 && tid == 0) { const unsigned long long now_ = wall_clock64(); tw[k] += now_ - tlast_; tlast_ = now_; } } while (0)
    unsigned long long tlast_ = wall_clock64();
#else
#define MXT(k) do { } while (0)
#endif
    for (int c = 0; c < SEQ / 64; ++c) {
#pragma unroll
        for (int u = 0; u < 2; ++u) {
            const int pi = tid + 512 * u, t = pi >> 4, d0 = 8 * (pi & 15); const size_t tok = MX_TOK(c, t);
            if (MODE == 0) {
                const v4u qv = *(const v4u*)(PROJ + tok * EINP + hx * 128 + d0), fv = *(const v4u*)(PROJ + tok * EINP + (dir == 0 ? 512 : 1024) + hx * 128 + d0), vv = *(const v4u*)(PROJ + tok * EINP + 1536 + hx * 128 + d0);
                const unsigned qw[4] = {qv.x, qv.y, qv.z, qv.w}, fw[4] = {fv.x, fv.y, fv.z, fv.w}, vw[4] = {vv.x, vv.y, vv.z, vv.w};
                float lf[8], qq[8], kk[8];
#pragma unroll
                for (int e = 0; e < 8; ++e) { const float qp = (e & 1) ? bfhi(qw[e >> 1]) : bflo(qw[e >> 1]), fp = (e & 1) ? bfhi(fw[e >> 1]) : bflo(fw[e >> 1]); const float lbe = lbv[hx * 128 + d0 + e];
                    const float sg = sigm(fp), f = fmaxf(lbe, 1e-30f) + (1.f - lbe) * sg; qq[e] = silu_f(qp); kk[e] = (1.f - lbe) * (1.f - sg); lf[e] = __logf(f);
                    VT[(d0 + e) * MX_SS + t] = (bf16)((e & 1) ? (vw[e >> 1] >> 16) : (vw[e >> 1] & 0xffffu)); }
                *(LAS f32x4*)(bloc + t * MX_BS + d0) = (f32x4){lf[0], lf[1], lf[2], lf[3]}; *(LAS f32x4*)(bloc + t * MX_BS + d0 + 4) = (f32x4){lf[4], lf[5], lf[6], lf[7]};
                *(LAS v4u*)(Qt + t * MX_TD + d0) = (v4u){pk2(qq[0], qq[1]), pk2(qq[2], qq[3]), pk2(qq[4], qq[5]), pk2(qq[6], qq[7])};
                *(LAS v4u*)(Kt + t * MX_TD + d0) = (v4u){pk2(kk[0], kk[1]), pk2(kk[2], kk[3]), pk2(kk[4], kk[5]), pk2(kk[6], kk[7])};
            } else {
                const int grp = hx >> 1;
                const v4u cv = *(const v4u*)(XBC + tok * M2XBC + 768 + grp * 128 + d0), bv = *(const v4u*)(XBC + tok * M2XBC + 512 + grp * 128 + d0), xv = *(const v4u*)(XBC + tok * M2XBC + hx * 128 + d0);
                *(LAS v4u*)(Qt + t * MX_TD + d0) = cv; *(LAS v4u*)(Kt + t * MX_TD + d0) = bv;
                const unsigned bw[4] = {bv.x, bv.y, bv.z, bv.w}, xw[4] = {xv.x, xv.y, xv.z, xv.w};
#pragma unroll
                for (int e = 0; e < 8; ++e) { const unsigned bb = (e & 1) ? (bw[e >> 1] >> 16) : (bw[e >> 1] & 0xffffu), xx = (e & 1) ? (xw[e >> 1] >> 16) : (xw[e >> 1] & 0xffffu);
                    KhT[(d0 + e) * MX_SS + t] = (bf16)bb; VT[(d0 + e) * MX_SS + t] = (bf16)xx; }
            }
        }
        if (MODE == 1 && tid < 128) { const int hh = tid >> 6, t = tid & 63; const float dt = DT[MX_TOK(c, t) * 16 + dir * 8 + 2 * hx + hh]; s_da[hh * 64 + t] = dt * Aneg[hh]; s_dt[hh * 64 + t] = dt; }
        __syncthreads(); MXT(0);
        if (MODE == 0) { const int d = tid & 127, tq = tid >> 7; float run = 0.f;
#pragma unroll
            for (int i = 0; i < 16; ++i) { run += bloc[(16 * tq + i) * MX_BS + d]; bloc[(16 * tq + i) * MX_BS + d] = run; }
            qsum[tq * 128 + d] = run;
        } else if (wave < 2) { float v = s_da[wave * 64 + lane];
#pragma unroll
            for (int o = 1; o < 64; o <<= 1) { const float up = __builtin_bit_cast(float, __builtin_amdgcn_ds_bpermute((lane - o) << 2, __builtin_bit_cast(int, v))); if (lane >= o) v += up; }
            s_da[wave * 64 + lane] = v; }
        __syncthreads(); MXT(1);
#pragma unroll
        for (int u = 0; u < 2; ++u) {
            const int pi = tid + 512 * u, t = pi >> 4, d0 = 8 * (pi & 15);
            if (MODE == 0) {
                float bt[8], br[8], be[8];
#pragma unroll
                for (int hf = 0; hf < 2; ++hf) { const int dd = d0 + 4 * hf;
                    const f32x4 q0 = *(const LAS f32x4*)(qsum + dd), q1 = *(const LAS f32x4*)(qsum + 128 + dd), q2 = *(const LAS f32x4*)(qsum + 256 + dd);
                    const f32x4 x = *(const LAS f32x4*)(bloc + t * MX_BS + dd), r = *(const LAS f32x4*)(bloc + 31 * MX_BS + dd), en = *(const LAS f32x4*)(bloc + 63 * MX_BS + dd);
#pragma unroll
                    for (int e = 0; e < 4; ++e) { bt[4 * hf + e] = x[e] + (t >= 16 ? q0[e] : 0.f) + (t >= 32 ? q1[e] : 0.f) + (t >= 48 ? q2[e] : 0.f); br[4 * hf + e] = r[e] + q0[e]; be[4 * hf + e] = en[e] + q0[e] + q1[e] + q2[e]; } }
                float o1[8], o2[8], o3[8];
                const v4u qv = *(const LAS v4u*)(Qt + t * MX_TD + d0), kv = *(const LAS v4u*)(Kt + t * MX_TD + d0); const unsigned qw[4] = {qv.x, qv.y, qv.z, qv.w}, kw[4] = {kv.x, kv.y, kv.z, kv.w};
#pragma unroll
                for (int e = 0; e < 8; ++e) { const float q = (e & 1) ? bfhi(qw[e >> 1]) : bflo(qw[e >> 1]), k = (e & 1) ? bfhi(kw[e >> 1]) : bflo(kw[e >> 1]); o1[e] = q * __expf(bt[e] - br[e]); o2[e] = k * __expf(br[e] - bt[e]); o3[e] = q * __expf(bt[e]);
                    KhT[(d0 + e) * MX_SS + t] = (bf16)f2bf(k * __expf(be[e] - bt[e])); }
                *(LAS v4u*)(Qt + t * MX_TD + d0) = (v4u){pk2(o1[0], o1[1]), pk2(o1[2], o1[3]), pk2(o1[4], o1[5]), pk2(o1[6], o1[7])};
                *(LAS v4u*)(Kt + t * MX_TD + d0) = (v4u){pk2(o2[0], o2[1]), pk2(o2[2], o2[3]), pk2(o2[4], o2[5]), pk2(o2[6], o2[7])};
                *(LAS v4u*)(Qh + t * MX_TD + d0) = (v4u){pk2(o3[0], o3[1]), pk2(o3[2], o3[3]), pk2(o3[4], o3[5]), pk2(o3[6], o3[7])};
                if (t == 0) { *(LAS f32x4*)(lam + d0) = (f32x4){__expf(be[0]), __expf(be[1]), __expf(be[2]), __expf(be[3])}; *(LAS f32x4*)(lam + d0 + 4) = (f32x4){__expf(be[4]), __expf(be[5]), __expf(be[6]), __expf(be[7])}; }
            } else {
                const int hh = d0 >> 6; const float w = s_dt[hh * 64 + t] * __expf(s_da[hh * 64 + 63] - s_da[hh * 64 + t]);
                const v4u xv = *(const v4u*)(XBC + MX_TOK(c, t) * M2XBC + hx * 128 + d0); const unsigned xw[4] = {xv.x, xv.y, xv.z, xv.w};
#pragma unroll
                for (int e = 0; e < 8; ++e) VhT[(d0 + e) * MX_SS + t] = (bf16)f2bf(((e & 1) ? bfhi(xw[e >> 1]) : bflo(xw[e >> 1])) * w);
            }
        }
        __syncthreads(); MXT(2);
        {
            mx_f32x16 acc;
#pragma unroll
            for (int e = 0; e < 16; ++e) acc[e] = 0.f;
            const LAS bf16* qrow = (MODE == 0 ? Qh : Qt) + (32 * tb + l31) * MX_TD;
#pragma unroll
            for (int db = 0; db < 4; ++db)
#pragma unroll
                for (int s2 = 0; s2 < 2; ++s2) acc = __builtin_amdgcn_mfma_f32_32x32x16_bf16(mx_pack8(Sacc[db], 8 * s2), mx_ld_perm(qrow, 32 * db + 16 * s2, lh), acc, 0, 0, 0);
            const int hh = vs >> 1;
            float acum_t = 0.f;
            if (MODE == 1) { acum_t = s_da[hh * 64 + 32 * tb + l31]; const float sc = __expf(acum_t);
#pragma unroll
                for (int e = 0; e < 16; ++e) acc[e] *= sc; }
            for (int sb = 0; sb <= tb; ++sb) {
                mx_f32x16 accP;
#pragma unroll
                for (int e = 0; e < 16; ++e) accP[e] = 0.f;
                const LAS bf16* krow = Kt + (32 * sb + l31) * MX_TD; const LAS bf16* q2row = Qt + (32 * tb + l31) * MX_TD;
#pragma unroll
                for (int ks = 0; ks < 8; ++ks) accP = __builtin_amdgcn_mfma_f32_32x32x16_bf16(*(const LAS mx_bf16x8*)(krow + 16 * ks + 8 * lh), *(const LAS mx_bf16x8*)(q2row + 16 * ks + 8 * lh), accP, 0, 0, 0);
#pragma unroll
                for (int i = 0; i < 4; ++i) {
                    f32x4 as4 = (f32x4){0.f, 0.f, 0.f, 0.f}, ds4 = (f32x4){1.f, 1.f, 1.f, 1.f};
                    if (MODE == 1) { as4 = *(const LAS f32x4*)(s_da + hh * 64 + 32 * sb + 8 * i + 4 * lh); ds4 = *(const LAS f32x4*)(s_dt + hh * 64 + 32 * sb + 8 * i + 4 * lh); }
#pragma unroll
                    for (int e = 0; e < 4; ++e) { const int sl = 8 * i + 4 * lh + e; float p = accP[4 * i + e];
                        if (MODE == 1) p *= __expf(fminf(acum_t - as4[e], 0.f)) * ds4[e];
                        accP[4 * i + e] = (sb < tb || sl <= l31) ? p : 0.f; }
                    if (MODE == 1) asm volatile("" ::: "memory");
                }
                const LAS bf16* vrow = VT + (32 * vs + l31) * MX_SS;
#pragma unroll
                for (int s2 = 0; s2 < 2; ++s2) acc = __builtin_amdgcn_mfma_f32_32x32x16_bf16(mx_ld_perm(vrow, 32 * sb + 16 * s2, lh), mx_pack8(accP, 8 * s2), acc, 0, 0, 0);
            }
            { const size_t tok = MX_TOK(c, 32 * tb + l31); float* orow = OUT + ((size_t)dir * T + tok) * 512 + hx * 128 + 32 * vs + 4 * lh;
#pragma unroll
              for (int i = 0; i < 4; ++i) *(f32x4*)(orow + 8 * i) = (f32x4){acc[4 * i], acc[4 * i + 1], acc[4 * i + 2], acc[4 * i + 3]}; }
            const LAS bf16* vhrow = (MODE == 0 ? VT : VhT) + (32 * vs + l31) * MX_SS;
            const float lamh = (MODE == 1) ? __expf(s_da[hh * 64 + 63]) : 0.f;
#pragma unroll
            for (int db = 0; db < 4; ++db) {
                if (MODE == 0) {
#pragma unroll
                    for (int i = 0; i < 4; ++i) { const f32x4 lm = *(const LAS f32x4*)(lam + 32 * db + 8 * i + 4 * lh);
#pragma unroll
                        for (int e = 0; e < 4; ++e) Sacc[db][4 * i + e] *= lm[e]; }
                } else {
#pragma unroll
                    for (int e = 0; e < 16; ++e) Sacc[db][e] *= lamh;
                }
                const LAS bf16* khrow = KhT + (32 * db + l31) * MX_SS;
#pragma unroll
                for (int ks = 0; ks < 4; ++ks) Sacc[db] = __builtin_amdgcn_mfma_f32_32x32x16_bf16(*(const LAS mx_bf16x8*)(khrow + 16 * ks + 8 * lh), *(const LAS mx_bf16x8*)(vhrow + 16 * ks + 8 * lh), Sacc[db], 0, 0, 0);
            }
        }
        __syncthreads(); MXT(3);
    }
#undef MX_TOK
#undef MXT
}

__device__ __forceinline__ void s5_item(int item, int j, const Args& a, const float* nw  , const bf16* HN, float* YS  , int lane) {
    const int dir = item & 1, g = (item >> 1) & 63, b = item >> 7, n = lane;
    const size_t pg = ((size_t)(j * 2 + dir) * S5G + g);
    const float a_re = a.in[I_S5_A_RE][pg * S5N + n], a_im = a.in[I_S5_A_IM][pg * S5N + n];
    const float delta = expf(a.in[I_S5_LOG_STEP][pg]);
    const float mag = expf(a_re * delta); float sn, cs; sincosf(a_im * delta, &sn, &cs);
    const float lam_re = mag * cs, lam_im = mag * sn;
    const float den = a_re * a_re + a_im * a_im, num_re = lam_re - 1.0f;
    const float coef_re = (num_re * a_re + lam_im * a_im) / den, coef_im = (lam_im * a_re - num_re * a_im) / den;
    float bbr[16], bbi[16], cr[16], ci[16];
#pragma unroll
    for (int c = 0; c < 16; ++c) {
        const size_t bi_ = (((size_t)j * S5G + g) * S5N + n) * S5C + c;
        const float br = a.in[I_S5_B_RE][bi_], bi = a.in[I_S5_B_IM][bi_], w = nw[g * 16 + c];
        bbr[c] = (coef_re * br - coef_im * bi) * w; bbi[c] = (coef_re * bi + coef_im * br) * w;
        const size_t ci_ = (pg * S5C + c) * S5N + n;
        cr[c] = a.in[I_S5_C_RE][ci_]; ci[c] = a.in[I_S5_C_IM][ci_];
    }
    float hr = 0.f, hi = 0.f;
    for (int blk = 0; blk < SEQ / 64; ++blk) {
        const size_t tl = (size_t)b * SEQ + (dir == 0 ? (blk * 64 + lane) : (SEQ - 1 - (blk * 64 + lane)));
        const v4u u0 = *(const v4u*)(HN + tl * D + g * 16), u1 = *(const v4u*)(HN + tl * D + g * 16 + 8);
        const float uv[16] = {bflo(u0.x), bfhi(u0.x), bflo(u0.y), bfhi(u0.y), bflo(u0.z), bfhi(u0.z), bflo(u0.w), bfhi(u0.w), bflo(u1.x), bfhi(u1.x), bflo(u1.y), bfhi(u1.y), bflo(u1.z), bfhi(u1.z), bflo(u1.w), bfhi(u1.w)};
        for (int i = 0; i < 64; ++i) {
            float bur = 0.f, bui = 0.f;
#pragma unroll
            for (int c = 0; c < 16; ++c) { const float u = __builtin_bit_cast(float, __builtin_amdgcn_readlane(__builtin_bit_cast(int, uv[c]), i)); bur += bbr[c] * u; bui += bbi[c] * u; }
            const float nhr = lam_re * hr - lam_im * hi + bur, nhi = lam_re * hi + lam_im * hr + bui; hr = nhr; hi = nhi;
            float y[16];
#pragma unroll
            for (int c = 0; c < 16; ++c) y[c] = cr[c] * hr - ci[c] * hi;
            const bool b5 = (lane & 32) != 0, b4 = (lane & 16) != 0, b3 = (lane & 8) != 0, b2 = (lane & 4) != 0;
            float a8[8], a4[4], a2[2], a1;
#pragma unroll
            for (int k = 0; k < 8; ++k) { const float send = b5 ? y[k] : y[k + 8], keep = b5 ? y[k + 8] : y[k]; a8[k] = keep + sx(send, 32, lane); }
#pragma unroll
            for (int k = 0; k < 4; ++k) { const float send = b4 ? a8[k] : a8[k + 4], keep = b4 ? a8[k + 4] : a8[k]; a4[k] = keep + sx(send, 16, lane); }
#pragma unroll
            for (int k = 0; k < 2; ++k) { const float send = b3 ? a4[k] : a4[k + 2], keep = b3 ? a4[k + 2] : a4[k]; a2[k] = keep + sx(send, 8, lane); }
            { const float send = b2 ? a2[0] : a2[1], keep = b2 ? a2[1] : a2[0]; a1 = keep + sx(send, 4, lane); }
            a1 += sx(a1, 2, lane); a1 += sx(a1, 1, lane);
            const size_t ti = (size_t)b * SEQ + (dir == 0 ? (blk * 64 + i) : (SEQ - 1 - (blk * 64 + i)));
            if ((lane & 3) == 0) YS[((size_t)dir * T + ti) * D + g * 16 + (lane >> 2)] = a1;
        }
    }
}

constexpr int S5_BUS = 36, S5_HS = 136, S5_WAVE_LDS = 128 * S5_BUS * 4 + 32 * S5_HS * 2 + 128;
typedef short s5_bf16x8 __attribute__((ext_vector_type(8)));
typedef float s5_f32x16 __attribute__((ext_vector_type(16)));
__device__ __forceinline__ void s5_item_mfma(int item, int j, const Args& a, const float* nw  , const bf16* HN  , const float* SSQ, float* YS  , LAS unsigned char* wl, int lane) {
    const int dir = item & 1, g = (item >> 1) & 63, b = item >> 7;
    const size_t pg = ((size_t)(j * 2 + dir) * S5G + g);
    const float delta = expf(a.in[I_S5_LOG_STEP][pg]);
    LAS float* buT = (LAS float*)wl;
    LAS bf16* Hl = (LAS bf16*)(wl + 128 * S5_BUS * 4);
    LAS float* rsl = (LAS float*)(wl + 128 * S5_BUS * 4 + 32 * S5_HS * 2);
    float lam_re, lam_im;
    { const float a_re = a.in[I_S5_A_RE][pg * S5N + lane], a_im = a.in[I_S5_A_IM][pg * S5N + lane]; const float mag = expf(a_re * delta); float sn, cs; sincosf(a_im * delta, &sn, &cs); lam_re = mag * cs; lam_im = mag * sn; }
    s5_bf16x8 Bb[4];
    { const int col = lane & 31, h = lane >> 5;
#pragma unroll
      for (int q = 0; q < 4; ++q) { const int np = 32 * q + col, n = np & 63; const bool isIm = np >= 64;
          const float a_re = a.in[I_S5_A_RE][pg * S5N + n], a_im = a.in[I_S5_A_IM][pg * S5N + n]; const float mag = expf(a_re * delta); float sn, cs; sincosf(a_im * delta, &sn, &cs);
          const float lr = mag * cs, li = mag * sn, den = a_re * a_re + a_im * a_im, num_re = lr - 1.0f;
          const float coef_re = (num_re * a_re + li * a_im) / den, coef_im = (li * a_re - num_re * a_im) / den;
          unsigned w4[4];
#pragma unroll
          for (int jp = 0; jp < 4; ++jp) { float vv[2];
#pragma unroll
              for (int e = 0; e < 2; ++e) { const int c = 8 * h + 2 * jp + e; const size_t bi_ = (((size_t)j * S5G + g) * S5N + n) * S5C + c; const float br = a.in[I_S5_B_RE][bi_], bi = a.in[I_S5_B_IM][bi_];
                  vv[e] = (isIm ? (coef_re * bi + coef_im * br) : (coef_re * br - coef_im * bi)) * nw[g * 16 + c]; }
              w4[jp] = pk2(vv[0], vv[1]); }
          Bb[q] = __builtin_bit_cast(s5_bf16x8, (v4u){w4[0], w4[1], w4[2], w4[3]}); } }
    s5_bf16x8 Cb[4];
    { const int c = lane & 15, q4 = lane >> 4;
#pragma unroll
      for (int ks = 0; ks < 4; ++ks) { unsigned w4[4];
#pragma unroll
          for (int jp = 0; jp < 4; ++jp) { float vv[2];
#pragma unroll
              for (int e = 0; e < 2; ++e) { const int np = 32 * ks + 8 * q4 + 2 * jp + e, n = np & 63; const size_t ci_ = (pg * S5C + c) * S5N + n; vv[e] = np < 64 ? a.in[I_S5_C_RE][ci_] : -a.in[I_S5_C_IM][ci_]; }
              w4[jp] = pk2(vv[0], vv[1]); }
          Cb[ks] = __builtin_bit_cast(s5_bf16x8, (v4u){w4[0], w4[1], w4[2], w4[3]}); } }
    float hr = 0.f, hi = 0.f;
    const int ar = lane & 31, ah = lane >> 5;
#define S5_TOK(tile, r) ((size_t)b * SEQ + (dir == 0 ? (32 * (tile) + (r)) : (SEQ - 1 - (32 * (tile) + (r)))))
    v4u unext = *(const v4u*)(HN + S5_TOK(0, ar) * D + g * 16 + 8 * ah);
    float rsnext = pg8::row_rstd(SSQ, (int)S5_TOK(0, ar));
    for (int tile = 0; tile < SEQ / 32; ++tile) {
        const s5_bf16x8 Aop = __builtin_bit_cast(s5_bf16x8, unext);
        if (lane < 32) rsl[lane] = rsnext;
        f32x4 sq0 = (f32x4){0.f, 0.f, 0.f, 0.f}, sq1 = sq0, sq2 = sq0, sq3 = sq0;
        if (tile + 1 < SEQ / 32) { unext = *(const v4u*)(HN + S5_TOK(tile + 1, ar) * D + g * 16 + 8 * ah);
            const f32x4* sp = (const f32x4*)(SSQ + S5_TOK(tile + 1, ar) * 16); sq0 = sp[0]; sq1 = sp[1]; sq2 = sp[2]; sq3 = sp[3]; }
        LDS_WAIT();
        f32x4 rs4[4];
#pragma unroll
        for (int i = 0; i < 4; ++i) rs4[i] = *(const LAS f32x4*)(rsl + 8 * i + 4 * ah);
#pragma unroll
        for (int q = 0; q < 4; ++q) { s5_f32x16 acc;
#pragma unroll
            for (int e = 0; e < 16; ++e) acc[e] = 0.f;
            acc = __builtin_amdgcn_mfma_f32_32x32x16_bf16(Aop, Bb[q], acc, 0, 0, 0);
#pragma unroll
            for (int i = 0; i < 4; ++i) *(LAS f32x4*)(buT + (32 * q + ar) * S5_BUS + 8 * i + 4 * ah) = (f32x4){acc[4 * i], acc[4 * i + 1], acc[4 * i + 2], acc[4 * i + 3]} * rs4[i]; }
        LDS_WAIT();
#pragma unroll
        for (int k = 0; k < 8; ++k) { const f32x4 re4 = *(const LAS f32x4*)(buT + lane * S5_BUS + 4 * k), im4 = *(const LAS f32x4*)(buT + (64 + lane) * S5_BUS + 4 * k);
#pragma unroll
            for (int e = 0; e < 4; ++e) { const float nhr = lam_re * hr - lam_im * hi + re4[e], nhi = lam_re * hi + lam_im * hr + im4[e]; hr = nhr; hi = nhi;
                Hl[(4 * k + e) * S5_HS + lane] = (bf16)f2bf(hr); Hl[(4 * k + e) * S5_HS + 64 + lane] = (bf16)f2bf(hi); } }
        LDS_WAIT();
#pragma unroll
        for (int m = 0; m < 2; ++m) { f32x4 acc = (f32x4){0.f, 0.f, 0.f, 0.f};
#pragma unroll
            for (int ks = 0; ks < 4; ++ks) { const s5_bf16x8 A2 = *(const LAS s5_bf16x8*)(Hl + (16 * m + (lane & 15)) * S5_HS + 32 * ks + 8 * (lane >> 4)); acc = __builtin_amdgcn_mfma_f32_16x16x32_bf16(A2, Cb[ks], acc, 0, 0, 0); }
#pragma unroll
            for (int e = 0; e < 4; ++e) YS[((size_t)dir * T + S5_TOK(tile, 16 * m + 4 * (lane >> 4) + e)) * D + g * 16 + (lane & 15)] = acc[e]; }
        LDS_WAIT();
        { const float sq = (((sq0[0] + sq0[1]) + (sq0[2] + sq0[3])) + ((sq1[0] + sq1[1]) + (sq1[2] + sq1[3]))) + (((sq2[0] + sq2[1]) + (sq2[2] + sq2[3])) + ((sq3[0] + sq3[1]) + (sq3[2] + sq3[3])));
          rsnext = 1.0f / sqrtf(sq * (1.0f / 1024.0f) + EPS); }
    }
#undef S5_TOK
}
__device__ __forceinline__ void combine_s5_phase(const float* H, const float* nw, const float* dsk, const float* YS, bf16* MIX, int lane, int wave, int bid, int G) {
    const int gw = bid * NWAVES + wave, NGW = G * NWAVES;
    for (int row = gw; row < T; row += NGW) {
        f32x4 v[4]; const float rstd = load_row_rstd(H + (size_t)row * D, lane, v);
        const f32x4* yf = (const f32x4*)(YS + (size_t)row * D) + lane; const f32x4* yb = (const f32x4*)(YS + ((size_t)T + row) * D) + lane;
        const f32x4* wv = (const f32x4*)nw + lane; const f32x4* dv = (const f32x4*)dsk + lane;
        unsigned long long* o8 = (unsigned long long*)(MIX + (size_t)row * D) + lane;
#pragma unroll
        for (int jj = 0; jj < 4; ++jj) { const f32x4 y = (yf[64 * jj] + yb[64 * jj]) * (float)(1 - EXP_ZERO_S5) + dv[64 * jj] * (v[jj] * rstd * wv[64 * jj]);
            o8[64 * jj] = (unsigned long long)pk2(gelu_tanh(y[0]), gelu_tanh(y[1])) | ((unsigned long long)pk2(gelu_tanh(y[2]), gelu_tanh(y[3])) << 32); }
    }
}
__device__ __forceinline__ void router_phase(const float* H, bf16* HN, const float* wr  , v4i* SEL, float* GATE, int* CNT, LAS unsigned char* lds, int tid, int lane, int wave, int bid, int G) {
    LAS float* wl = (LAS float*)lds;
    LAS int* lcnt = (LAS int*)(lds + 32768);
    for (int i = tid; i < D * 8; i += NTHR) wl[(i & 7) * D + (i >> 3)] = wr[i];
    for (int grp = bid; grp < T / 64; grp += G) {
        if (tid < 8) lcnt[tid] = 0;
        __syncthreads();
        for (int r = 0; r < 8; ++r) {
            const int row = grp * 64 + wave * 8 + r;
            f32x4 v[4]; const float rstd = load_row_rstd(H + (size_t)row * D, lane, v); store_row_bf16(HN + (size_t)row * D, lane, v, rstd);
            float lg[8];
#pragma unroll
            for (int e = 0; e < 8; ++e) { float s = 0.f;
#pragma unroll
                for (int jj = 0; jj < 4; ++jj) { const f32x4 w = *(const LAS f32x4*)(wl + e * D + 256 * jj + 4 * lane); s += (v[jj][0] * w[0] + v[jj][1] * w[1]) + (v[jj][2] * w[2] + v[jj][3] * w[3]); }
                lg[e] = wave_sum(s, lane) * rstd; }
            int e0 = 0; float l0 = lg[0];
#pragma unroll
            for (int e = 1; e < 8; ++e) if (lg[e] > l0) { l0 = lg[e]; e0 = e; }
            int e1 = -1; float l1 = -3.0e38f;
#pragma unroll
            for (int e = 0; e < 8; ++e) if (e != e0 && lg[e] > l1) { l1 = lg[e]; e1 = e; }
            const float g1 = 1.0f / (1.0f + expf(l0 - l1)), g0 = 1.0f - g1;
            if (lane == 0) { SEL[row] = (v4i){e0, e1, __builtin_bit_cast(int, g0), __builtin_bit_cast(int, g1)}; GATE[(size_t)row * 2] = g0; GATE[(size_t)row * 2 + 1] = g1; atomicAdd((int*)&lcnt[e0], 1); atomicAdd((int*)&lcnt[e1], 1); }
        }
        __syncthreads();
        if (tid < 8) CNT[grp * 8 + tid] = lcnt[tid];
        __syncthreads();
    }
}
__device__ __forceinline__ void scatter_phase(const bf16* HN, const v4i* SEL, const int* CNT, int* SLOT, int* SEGB, bf16* XBUF, LAS unsigned char* lds, int tid, int lane, int wave, int bid, int G) {
    LAS int* ltot = (LAS int*)lds;
    LAS int* lbef = ltot + 8;
    LAS int* base = lbef + 8;
    LAS int* wcnt = base + 8;
    for (int grp = bid; grp < T / 64; grp += G) {
        if (tid < 16) ltot[tid] = 0;
        __syncthreads();
        { const int e = tid & 7, q = tid >> 3; int tot = 0, bef = 0;
#pragma unroll
          for (int k = 0; k < 4; ++k) { const int g2 = q + 64 * k; const int c = CNT[g2 * 8 + e]; tot += c; bef += (g2 < grp) ? c : 0; }
          atomicAdd((int*)&ltot[e], tot); atomicAdd((int*)&lbef[e], bef); }
        __syncthreads();
        if (tid == 0) { int sb = 0;
            for (int e = 0; e < 8; ++e) { base[e] = sb + lbef[e]; if (grp == 0) SEGB[e] = sb; sb += (ltot[e] + 255) & ~255; }
            if (grp == 0) SEGB[8] = sb; }
        const int r0 = grp * 64 + wave * 8;
        int myE = -1;
        if (lane < 16) { const v4i s = SEL[r0 + (lane >> 1)]; myE = (lane & 1) ? s[1] : s[0]; }
        int rank = 0, cntMine = 0;
#pragma unroll
        for (int e = 0; e < 8; ++e) { const unsigned long long m = __ballot(myE == e); const int c = __popcll(m); if (lane == e) cntMine = c; if (myE == e) rank = __popcll(m & ((1ull << lane) - 1ull)); }
        if (lane < 8) wcnt[wave * 8 + lane] = cntMine;
        __syncthreads();
        int slot = 0;
        if (lane < 16) { int pre = 0; for (int w = 0; w < wave; ++w) pre += wcnt[w * 8 + myE]; slot = base[myE] + pre + rank; SLOT[(size_t)(r0 + (lane >> 1)) * 2 + (lane & 1)] = slot; }
        for (int i = 0; i < 16; ++i) { const int sl = __builtin_amdgcn_readlane(slot, i); const int row = r0 + (i >> 1);
            const v4u* src = (const v4u*)(HN + (size_t)row * D); v4u* dst = (v4u*)(XBUF + (size_t)sl * D);
            dst[lane] = src[lane]; dst[64 + lane] = src[64 + lane]; }
        __syncthreads();
    }
}

#if EXP_PROBE
__device__ __forceinline__ void probe_moe(const float* H, const float* nw, const float* router, const float* w_gu, const float* w_down, const v4i* SEL, const int* SLOT, const float* YBUF, int* diag,
                                          LAS unsigned char* lds, int tid, int lane, int wave, int bid) {
    LAS float* xt = (LAS float*)lds;
    LAS float* act = xt + 1024;
    LAS float* red = act + 3584;
    const int t = (bid * 61 + 7) & (T - 1);
    if (wave == 0) { f32x4 v[4]; const float rstd = load_row_rstd(H + (size_t)t * D, lane, v);
#pragma unroll
        for (int j = 0; j < 4; ++j) { const f32x4 w = ((const f32x4*)nw)[64 * j + lane]; *(LAS f32x4*)(xt + 256 * j + 4 * lane) = v[j] * rstd * w; } }
    __syncthreads();
    if (tid < 8) { float s = 0.f; for (int c = 0; c < D; ++c) s += xt[c] * router[c * 8 + tid]; red[tid] = s; }
    __syncthreads();
    int e0 = 0; float l0 = red[0];
    for (int e = 1; e < 8; ++e) if (red[e] > l0) { l0 = red[e]; e0 = e; }
    int e1 = -1; float l1 = -3.0e38f;
    for (int e = 0; e < 8; ++e) if (e != e0 && red[e] > l1) { l1 = red[e]; e1 = e; }
    const v4i sel = SEL[t];
    int code = 0;
    if (sel[0] != e0 || sel[1] != e1) code = 10;
    const float g1 = 1.0f / (1.0f + expf(l0 - l1)), g0 = 1.0f - g1;
    if (code == 0 && (fabsf(g0 - __builtin_bit_cast(float, sel[2])) > 1e-3f || fabsf(g1 - __builtin_bit_cast(float, sel[3])) > 1e-3f)) code = 9;
    __syncthreads();
    int cc[2] = {0, 0};
    for (int k = 0; k < 2; ++k) {
        const int e = k == 0 ? e0 : e1; const float* wg = w_gu + (size_t)e * D * 2 * FF; const float* wd = w_down + (size_t)e * FF * D;
        float ag[7], au[7];
        for (int q = 0; q < 7; ++q) { ag[q] = 0.f; au[q] = 0.f; }
        for (int c = 0; c < D; ++c) { const float x = xt[c];
#pragma unroll
            for (int q = 0; q < 7; ++q) { ag[q] += x * wg[(size_t)c * 2 * FF + tid + 512 * q]; au[q] += x * wg[(size_t)c * 2 * FF + FF + tid + 512 * q]; } }
#pragma unroll
        for (int q = 0; q < 7; ++q) act[tid + 512 * q] = ag[q] * sigm(ag[q]) * au[q];
        __syncthreads();
        float y0 = 0.f, y1 = 0.f;
        for (int f = 0; f < FF; ++f) { const float a = act[f]; y0 += a * wd[(size_t)f * D + tid]; y1 += a * wd[(size_t)f * D + 512 + tid]; }
        const int slot = SLOT[(size_t)t * 2 + k];
        const float m0 = YBUF[(size_t)slot * D + tid], m1 = YBUF[(size_t)slot * D + 512 + tid];
        float er = (m0 - y0) * (m0 - y0) + (m1 - y1) * (m1 - y1), rf = y0 * y0 + y1 * y1;
        er = wave_sum(er, lane); rf = wave_sum(rf, lane);
        __syncthreads();
        if (lane == 0) { red[16 + wave] = er; red[32 + wave] = rf; }
        __syncthreads();
        float E = 0.f, R = 0.f; for (int w = 0; w < 8; ++w) { E += red[16 + w]; R += red[32 + w]; }
        const float rel = E / (R + 1e-20f);
        cc[k] = rel < 1e-3f ? 0 : (rel < 0.1f ? 1 : 2);
        __syncthreads();
    }
    if (code == 0) code = cc[0] * 3 + cc[1];
    { const float sg0 = __builtin_bit_cast(float, sel[2]), sg1 = __builtin_bit_cast(float, sel[3]); int c2 = (int)(sg0 * 10.f); if (c2 < 0) c2 = 0; if (c2 > 12) c2 = 12;
      if (fabsf(sg0 + sg1 - 1.f) > 1e-3f) { int c3 = (int)((sg0 + sg1) * 5.f); if (c3 < 0) c3 = 0; if (c3 > 9) c3 = 9; c2 = 13 + c3; }
      code = c2; }
    if (tid == 0 && bid == 0) atomicMax(diag, code);
}
#endif
__device__ __forceinline__ void moe_combine_norm_phase(float* H, const float* YBUF, const float* GATE, const int* SLOT, bf16* HN, int lane, int wave, int bid, int G, const int* SEGBp = nullptr, int* diag = nullptr, float mscl = 1.f) {
    const int gw = bid * NWAVES + wave, NGW = G * NWAVES;
    for (int row = gw; row < T; row += NGW) {
        const int s0 = SLOT[(size_t)row * 2], s1 = SLOT[(size_t)row * 2 + 1]; const float g0 = GATE[(size_t)row * 2], g1 = GATE[(size_t)row * 2 + 1];
        f32x4* hr = (f32x4*)(H + (size_t)row * D) + lane; const f32x4* y0 = (const f32x4*)(YBUF + (size_t)s0 * D) + lane; const f32x4* y1 = (const f32x4*)(YBUF + (size_t)s1 * D) + lane;
        f32x4 v[4]; float ss = 0.f;
#pragma unroll
        for (int jj = 0; jj < 4; ++jj) { v[jj] = hr[64 * jj] + (g0 * y0[64 * jj] + g1 * y1[64 * jj]) * mscl; hr[64 * jj] = v[jj]; ss += (v[jj][0] * v[jj][0] + v[jj][1] * v[jj][1]) + (v[jj][2] * v[jj][2] + v[jj][3] * v[jj][3]); }
        const float rstd = 1.0f / sqrtf(wave_sum(ss, lane) * (1.0f / D) + EPS);
        store_row_bf16(HN + (size_t)row * D, lane, v, rstd);
    }
}

#ifndef MK_ONE_LAUNCH
#define MK_ONE_LAUNCH 1
#endif
constexpr int PH_PER_LAYER = 11, PH_LAYER0 = 2, N_PHASES = PH_LAYER0 + 4 * PH_PER_LAYER + 1;

#define H ((float*)(ws + WS_H))
#define HN ((bf16*)(ws + WS_HN))
#define HN2 ((bf16*)(ws + WS_HN2))
#define SSQ1 ((float*)(ws + WS_SSQ1))
#define SSQ2 ((float*)(ws + WS_SSQ2))
#define MIX ((bf16*)(ws + WS_MIX))
#define PB ((bf16*)(ws + WS_PB))
#define PP ((bf16*)(ws + WS_PP))
#define XBUF ((bf16*)(ws + WS_XBUF))
#define YBUF ((float*)(ws + WS_YBUF))
#define DT ((float*)(ws + WS_DT))
#define SEL ((v4i*)(ws + WS_ROUTE))
#define SLOT ((int*)(ws + WS_ROUTE + 256 * 1024))
#define GATE ((float*)(ws + WS_ROUTE + 512 * 1024))
#define CNT ((int*)(ws + WS_ROUTE + 384 * 1024))
#define SEGB ((int*)(ws + WS_ROUTE + 400 * 1024))
#define PROJ ((bf16*)(ws + WS_PROJ))
#define XBC ((bf16*)(ws + WS_XBC))
#define OA ((float*)(ws + WS_OA))
#define YA ((float*)(ws + WS_YA))
#define ACT ((bf16*)(ws + WS_ACT))
#define YS ((float*)(ws + WS_YS))
__global__ void __launch_bounds__(NTHR, 2) fwd(Args args) {
    extern __shared__ __attribute__((aligned(16))) unsigned char lds_raw[];
    LAS unsigned char* lds = (LAS unsigned char*)lds_raw;
    volatile LAS unsigned* MISC = (volatile LAS unsigned*)(lds + MISC_OFF);
    const int G0 = gridDim.x, bid0 = blockIdx.x, wave_s = __builtin_amdgcn_readfirstlane((int)threadIdx.x >> 6);
    if (threadIdx.x < 32) MISC[threadIdx.x] = 0u;
#if defined(__HIP_DEVICE_COMPILE__)
#define ASSUME_GLOBAL(p) do { __builtin_assume(!__builtin_amdgcn_is_shared((const __attribute__((address_space(0))) void*)(p))); __builtin_assume(!__builtin_amdgcn_is_private((const __attribute__((address_space(0))) void*)(p))); } while (0)
#else
#define ASSUME_GLOBAL(p) do { } while (0)
#endif
#define PHASE_IDS() LAS float* rtab = (LAS float*)(lds + RING_BYTES); (void)rtab; int G = G0, bid = bid0; asm volatile("" : "+s"(G), "+s"(bid)); unsigned char* ws = args.ws; asm volatile("" : "+s"(ws) :: "memory"); ASSUME_GLOBAL(ws); int lane; asm volatile("v_mbcnt_lo_u32_b32 %0, -1, 0\n\tv_mbcnt_hi_u32_b32 %0, -1, %0" : "=v"(lane)); const int wave = wave_s, tid = wave * 64 + lane; (void)tid
    __syncthreads();
    XcdBarrier bar; bar.bar = (unsigned*)(args.ws + WS_CTL) + CW_BAR; bar.x = 0; bar.st = nullptr;
    if (MK_ONE_LAUNCH) { bar = xcd_barrier_post((unsigned*)(args.ws + WS_CTL) + CW_BAR, MISC + 8); bar.x = (unsigned)__builtin_amdgcn_readfirstlane((int)bar.x); }
#if EXP_TIMING
#define SEAM_CAT(cat) do { if (MK_ONE_LAUNCH) { XcdBarrier bb_ = bar; asm volatile("" : "+s"(bb_.x), "+s"(bb_.bar)); xcd_barrier(bb_); } if (blockIdx.x == 0 && threadIdx.x == 0) { unsigned long long* tw = (unsigned long long*)(args.ws + WS_CTL + 1024); const unsigned long long now = wall_clock64(); if (tw[0]) tw[1 + (cat)] += now - tw[0]; tw[0] = now; } } while (0)
#else
#define SEAM_CAT(cat) do { if (MK_ONE_LAUNCH) { XcdBarrier bb_ = bar; asm volatile("" : "+s"(bb_.x), "+s"(bb_.bar)); xcd_barrier(bb_); } } while (0)
#endif
#define SEAM() SEAM_CAT(4)
#if EXP_TIMING
    if (blockIdx.x == 0 && threadIdx.x == 0) { unsigned long long* tw = (unsigned long long*)(args.ws + WS_CTL + 1024); tw[0] = wall_clock64(); }
#endif
    const int lo = args.ph_lo, hi = args.ph_hi; (void)lo; (void)hi;
#if MK_ONE_LAUNCH
#define IN(k) true
#else
#define IN(k) (lo <= (k) && (k) < hi)
#endif
    const float* x = args.in[I_X];
#define FILL_RTAB(S, SSQ) do { pg8::Unit u_; for (int i_ = 0; i_ < RTAB_UNITS && (S).next(i_, u_); ++i_) { if (tid < 256) rtab[i_ * 256 + tid] = pg8::row_rstd((SSQ), u_.pm * 256 + tid); } __syncthreads(); } while (0)

    if (IN(0)) { PHASE_IDS(); prologue_phase(args, ws, lds, tid, lane, wave, bid, G); SEAM_CAT(0); }
    if (IN(1)) { PHASE_IDS();
        pg8::StackOrder S; S.init(PB, (const bf16*)(ws + WS_WPP), DEPTH * T, D, PLE, 6  , G, bid);
        pg8::EpiBf16 E{PP, D, nullptr};
        int Kp = PLE; asm volatile("" : "+s"(Kp));
        pg8::gemm_phase<pg8::EpiBf16, pg8::StackOrder, true, true>(lds, Kp, S, E, wave_s);
        SEAM_CAT(1);
    }
    for (int l = 0; l < DEPTH; ++l) {
        const int pb = PH_LAYER0 + PH_PER_LAYER * l, j = l >> 1;
        if ((l & 1) == 0) {
            if (IN(pb + 1)) { PHASE_IDS();
                pg8::StaticOrder S; S.init(HN2, (const bf16*)(ws + WS_WIN) + (size_t)j * EINP * D, T, EINP, D, G, bid);
                FILL_RTAB(S, SSQ2); pg8::EpiBf16 E{PROJ, EINP, rtab};
                pg8::gemm_phase<pg8::EpiBf16, pg8::StaticOrder, true, true>(lds, D, S, E, wave_s);
                SEAM_CAT(1);
            }
            if (IN(pb + 2)) { PHASE_IDS(); conv_phase(PROJ, args.in[I_M2_CONV_W] + (size_t)j * 5 * M2XBC, args.in[I_M2_CONV_B] + (size_t)j * M2XBC, XBC, HN2, SSQ2, (const float*)(ws + WS_WDT) + (size_t)j * D * 16, args.in[I_M2_DT_BIAS] + j * 16, DT, lds, tid, lane, wave, bid, G); SEAM(); }
            if (IN(pb + 3)) { PHASE_IDS();
#if MIX_MFMA
                { const int spare = G > 128 ? G - 128 : G, cb = G > 128 ? bid - 128 : bid;
                  if (cb >= 0) { LAS float* scr = (LAS float*)(lds + wave * TR_LDS); if (G <= 128) __syncthreads();
                      for (int it = cb * NWAVES + wave; it < CN_MOE; it += spare * NWAVES) convert_moe_item(args, ws, j, scr, it, lane); if (G <= 128) __syncthreads(); } }
                for (int it = bid; it < 128; it += G) {
                    if ((it & 1) == 0) mix_item<0>(it >> 1, PROJ, XBC, DT, (const float*)(ws + WS_WDT + 512 * 1024) + j * HGW, nullptr, OA, lds, tid, lane, wave, (unsigned long long*)(ws + WS_CTL + 2048));
                    else mix_item<1>(it >> 1, PROJ, XBC, DT, nullptr, args.in[I_M2_A_LOG] + j * 16, YA, lds, tid, lane, wave, (unsigned long long*)(ws + WS_CTL + 2048));
                }
#else
                for (int it = bid; it < 512; it += G) {
                    if (it < 256) scan_item<0>(it, PROJ, XBC, DT, (const float*)(ws + WS_WDT + 512 * 1024) + j * HGW, nullptr, OA, lds, tid);
                    else scan_item<1>(it - 256, PROJ, XBC, DT, nullptr, args.in[I_M2_A_LOG] + j * 16, YA, lds, tid);
                }
#endif
                SEAM_CAT(2);
            }
            if (IN(pb + 4)) { PHASE_IDS(); combine_even_phase(PROJ, XBC, OA, YA, args.in[I_HG_NORM_W] + j * HGW, args.in[I_M2_D] + j * M2H, args.in[I_M2_NORM_W] + j * M2I, MIX, lane, wave, bid, G); SEAM(); }
            if (IN(pb + 5)) { PHASE_IDS();
                pg8::StaticOrder S; S.init(MIX, (const bf16*)(ws + WS_WOUT) + (size_t)j * D * D, T, D, D, G, bid);
                pg8::EpiResF32 E{H, (l == 0) ? x : H, D, HN, SSQ1};
                pg8::gemm_phase<pg8::EpiResF32, pg8::StaticOrder, true, true>(lds, D, S, E, wave_s);
                SEAM_CAT(1);
            }
            if (IN(pb + 7)) { PHASE_IDS();
                pg8::StaticOrder S; S.init(HN, (const bf16*)(ws + WS_WGU) + (size_t)j * 2 * FF * D, T, 2 * FF, D, G, bid);
                FILL_RTAB(S, SSQ1); pg8::EpiSwiGLU E{ACT, FF, rtab};
                pg8::gemm_phase<pg8::EpiSwiGLU, pg8::StaticOrder, true, true>(lds, D, S, E, wave_s);
                SEAM_CAT(1);
            }
            if (IN(pb + 8) && !EXP_ZERO_FFN) { PHASE_IDS();
                pg8::StaticOrder S; S.init(ACT, (const bf16*)(ws + WS_WDN) + (size_t)j * D * FF, T, D, FF, G, bid);
                pg8::EpiResF32 E{H, H, D, HN, SSQ1};
                pg8::gemm_phase<pg8::EpiResF32, pg8::StaticOrder, true, true>(lds, FF, S, E, wave_s);
                SEAM_CAT(1);
            }
        } else {
            if (IN(pb + 1)) { PHASE_IDS();
#if S5_MFMA
                if (wave < 4) for (int it = wave * G + bid; it < NB * S5G * 2; it += G * 4) s5_item_mfma(it, j, args, args.in[I_NORM_MIX] + l * D, HN2, SSQ2, YS, lds + wave * S5_WAVE_LDS, lane);
#else
                for (int it = wave * G + bid; it < NB * S5G * 2; it += G * NWAVES) s5_item(it, j, args, args.in[I_NORM_MIX] + l * D, HN, YS, lane);
#endif
                SEAM_CAT(3);
            }
            if (IN(pb + 2)) { PHASE_IDS(); combine_s5_phase(H, args.in[I_NORM_MIX] + l * D, args.in[I_S5_D] + j * D, YS, MIX, lane, wave, bid, G); SEAM(); }
            if (IN(pb + 3)) { PHASE_IDS();
                pg8::StaticOrder S; S.init(MIX, (const bf16*)(ws + WS_WGLU) + (size_t)j * 2 * D * D, T, 2 * D, D, G, bid);
                float sclg = EXP_ZERO_GLU ? 0.f : 1.f; asm volatile("" : "+s"(sclg)); pg8::EpiGluRes E{H, D, sclg};
                pg8::gemm_phase<pg8::EpiGluRes, pg8::StaticOrder, true, true>(lds, D, S, E, wave_s);
                SEAM_CAT(1);
            }
            if (IN(pb + 4)) { PHASE_IDS(); router_phase(H, HN, (const float*)(ws + WS_WDT + 256 * 1024) + (size_t)j * D * 8, SEL, GATE, CNT, lds, tid, lane, wave, bid, G); SEAM(); }
            if (IN(pb + 5)) { PHASE_IDS(); scatter_phase(HN, SEL, CNT, SLOT, SEGB, XBUF, lds, tid, lane, wave, bid, G); SEAM(); }
            if (IN(pb + 6)) { PHASE_IDS();
                pg8::MoeOrder S; S.init(XBUF, (const bf16*)(ws + WS_WMGU) + (size_t)j * NE * 2 * FF * D, SEGB, 2 * FF, D, G, bid);
                pg8::EpiSwiGLU E{ACT, FF, nullptr};
                pg8::gemm_phase<pg8::EpiSwiGLU, pg8::MoeOrder, true, true>(lds, D, S, E, wave_s);
                SEAM_CAT(1);
            }
            if (IN(pb + 7)) { PHASE_IDS();
                pg8::MoeOrder S; S.init(ACT, (const bf16*)(ws + WS_WMDN) + (size_t)j * NE * D * FF, SEGB, D, FF, G, bid);
                pg8::EpiResF32 E{YBUF, nullptr, D, nullptr, nullptr};
                pg8::gemm_phase<pg8::EpiResF32, pg8::MoeOrder, true, true>(lds, FF, S, E, wave_s);
                SEAM_CAT(1);
            }
#if EXP_PROBE
            if (IN(pb + 8) && l == EXP_PROBE_LAYER) { PHASE_IDS(); probe_moe(H, args.in[I_NORM_FFN] + l * D, args.in[I_MOE_ROUTER] + (size_t)j * D * 8, args.in[I_MOE_W_GU] + (size_t)j * NE * D * 2 * FF, args.in[I_MOE_W_DOWN] + (size_t)j * NE * FF * D, SEL, SLOT, YBUF, (int*)(ws + WS_CTL) + 64, lds, tid, lane, wave, bid); __syncthreads(); }
#endif
            if (IN(pb + 9)) { PHASE_IDS(); moe_combine_norm_phase(H, YBUF, GATE, SLOT, HN, lane, wave, bid, G, SEGB, (int*)(ws + WS_CTL) + 64, ((EXP_ZERO_MOE >> j) & 1) ? 0.f : 1.f); SEAM(); }
        }
        if (IN(pb + 10)) { PHASE_IDS();
            pg8::StaticOrder S; S.init(HN, (const bf16*)(ws + WS_WPG) + (size_t)l * D * D, T, D, D, G, bid);
            float sclp = EXP_ZERO_PLE ? 0.f : 1.f; asm volatile("" : "+s"(sclp)); if (!(l & 1)) FILL_RTAB(S, SSQ1); pg8::EpiPle E{H, PP + (size_t)l * T * D, D, sclp, (l & 1) ? (const LAS float*)nullptr : (const LAS float*)rtab, HN2, SSQ2};
            pg8::gemm_phase<pg8::EpiPle, pg8::StaticOrder, true, true>(lds, D, S, E, wave_s);
            SEAM_CAT(1);
        }
    }
    if (IN(N_PHASES - 1)) { PHASE_IDS();
#if EXP_MIXTIME
        { const unsigned long long* tw = (const unsigned long long*)(ws + WS_CTL + 2048); const float tot = (float)(tw[0] + tw[1] + tw[2] + tw[3]); if (bid == 0 && tid == 0) ((int*)(ws + WS_CTL))[64] = (int)(10.f * (float)tw[EXP_MIXTIME_CAT] / tot + 0.5f); }
        SEAM_CAT(5);
#endif
#if EXP_TIMING
        { const unsigned long long* tw = (const unsigned long long*)(ws + WS_CTL + 1024); const float tot = (float)(tw[1] + tw[2] + tw[3] + tw[4] + tw[5]); if (bid == 0 && tid == 0) ((int*)(ws + WS_CTL))[64] = (int)(50.f * (float)tw[1 + EXP_TIMING_CAT] / tot + 0.5f); }
        SEAM_CAT(5);
#endif
        final_phase(H, args.in[I_FINAL_NORM], args.out, lane, wave, bid, G, (const int*)(ws + WS_CTL) + 64); }
#undef IN
#undef SEAM
#undef SEAM_CAT
#undef PHASE_IDS
#undef FILL_RTAB
}
#undef H
#undef HN
#undef HN2
#undef SSQ1
#undef SSQ2
#undef MIX
#undef PB
#undef PP
#undef XBUF
#undef YBUF
#undef DT
#undef SEL
#undef SLOT
#undef GATE
#undef CNT
#undef SEGB
#undef PROJ
#undef XBC
#undef OA
#undef YA
#undef ACT
#undef YS


extern "C" void kernel_launch(void* const* d_in, const int* in_sizes, int n_in, void* d_out, int out_size, void* d_ws, size_t ws_size, hipStream_t stream) {
    static int grid = 0;
    if (grid == 0) {
        if (n_in != N_IN || in_sizes[0] != T * D || out_size != T * D || ws_size < WS_END) { fprintf(stderr, "kernel_launch: unexpected problem (n_in %d, in0 %d, out %d, ws %zu < %zu); nothing launched\n", n_in, n_in > 0 ? in_sizes[0] : -1, out_size, ws_size, (size_t)WS_END); grid = -1; return; }
        int dev = 0, cus = 0, per_cu = 0;
        if (hipGetDevice(&dev) != hipSuccess || hipDeviceGetAttribute(&cus, hipDeviceAttributeMultiprocessorCount, dev) != hipSuccess) { fprintf(stderr, "kernel_launch: device query failed\n"); grid = -1; return; }
        if (hipFuncSetAttribute((const void*)fwd, hipFuncAttributeMaxDynamicSharedMemorySize, LDS_BYTES) != hipSuccess) { fprintf(stderr, "kernel_launch: hipFuncSetAttribute failed\n"); grid = -1; return; }
        if (hipOccupancyMaxActiveBlocksPerMultiprocessor(&per_cu, (const void*)fwd, NTHR, LDS_BYTES) != hipSuccess || per_cu < 1) { fprintf(stderr, "kernel_launch: occupancy query reports %d workgroups per CU\n", per_cu); (void)hipGetLastError(); per_cu = 1; }
        grid = cus;
    }
    if (grid < 0) return;
    if (hipMemsetAsync((char*)d_ws + WS_CTL, 0, CTL_ZERO_BYTES, stream) != hipSuccess) { fprintf(stderr, "kernel_launch: memset failed\n"); return; }
    Args a{};
    for (int i = 0; i < N_IN; ++i) a.in[i] = (const float*)d_in[i];
    a.out = (float*)d_out; a.ws = (unsigned char*)d_ws;
#if MK_ONE_LAUNCH
    a.ph_lo = 0; a.ph_hi = N_PHASES;
    hipLaunchKernelGGL(fwd, dim3(grid), dim3(NTHR), LDS_BYTES, stream, a);
    { const hipError_t le = hipPeekAtLastError(); if (le != hipSuccess) fprintf(stderr, "kernel_launch: launch failed: %s\n", hipGetErrorName(le)); }
#else
    for (int ph = 0; ph < N_PHASES; ++ph) {
        const int rel = ph - PH_LAYER0, l = rel >= 0 ? rel / PH_PER_LAYER : -1, slot = rel >= 0 ? rel % PH_PER_LAYER : -1;
        if (l >= 0 && l < DEPTH) { if ((l & 1) && slot == 8 && !(EXP_PROBE && l == EXP_PROBE_LAYER)) continue; }
        a.ph_lo = ph; a.ph_hi = ph + 1;
        hipLaunchKernelGGL(fwd, dim3(grid), dim3(NTHR), LDS_BYTES, stream, a);
        const hipError_t le = hipPeekAtLastError(); if (le != hipSuccess) { fprintf(stderr, "kernel_launch: launch of phase %d failed: %s\n", ph, hipGetErrorName(le)); break; }
    }
#endif
}
```

```cpp
#include <hip/hip_runtime.h>
#include <cstdio>
#include <cstdint>

namespace pg8 {
#define PG8_LAS __attribute__((address_space(3)))
typedef unsigned short bf16_t;
typedef short bf16x8 __attribute__((ext_vector_type(8)));
typedef float f32x4 __attribute__((ext_vector_type(4)));
typedef float f32x2 __attribute__((ext_vector_type(2)));
typedef unsigned u32x4 __attribute__((ext_vector_type(4)));
typedef unsigned u32x2 __attribute__((ext_vector_type(2)));
constexpr int BM = 256, BK = 64, HALF = 128, HTB = HALF * BK * 2  , STAGE_BYTES = 8 * HTB, NXCD = 8, WGM = 8;

__host__ __device__ __forceinline__ int lds_byte(int r, int c) { const int st = (r >> 4) * 2 + (c >> 5), rr = r & 15, cc = c & 31, ob = rr * 64 + cc * 2; return st * 1024 + (ob ^ (((ob >> 9) & 1) << 5)); }
__host__ __device__ __forceinline__ void stage_rc(int b, int& R, int& C) { const int st = b / 1024, sb = b % 1024, swz = sb ^ (((sb >> 9) & 1) << 5); R = (st >> 1) * 16 + swz / 64; C = (st & 1) * 32 + (swz % 64) / 2; }
__host__ __device__ __forceinline__ int perm32(int rho) { const int n = rho >> 4, i = rho & 15; return 8 * (i >> 2) + 4 * n + (i & 3); }

struct Unit { int pm, pn; const char* A; const char* B; };

struct StaticOrder {
    int nM, nN, nwg, G, c; const char* A; const char* Bt; size_t tstep;
    __device__ void init(const bf16_t* A_, const bf16_t* Bt_, int M, int N, int K, int G_, int c_) { nM = M / BM; nN = N / BM; nwg = nM * nN; G = G_; c = c_; A = (const char*)A_; Bt = (const char*)Bt_; tstep = (size_t)BM * K * 2; }
    __device__ __forceinline__ bool next(int i, Unit& u) const {
        const long L = (long)i * G + c; if (L >= nwg) return false;
        int wgid = (int)L; { const int q = nwg / NXCD, r = nwg % NXCD, xcd = wgid % NXCD, off = wgid / NXCD; wgid = (xcd < r ? xcd * (q + 1) : r * (q + 1) + (xcd - r) * q) + off; }
        const int nig = WGM * nN, gid = wgid / nig, fm = gid * WGM, gsz = (nM - fm) < WGM ? (nM - fm) : WGM;
        u.pm = fm + ((wgid % nig) % gsz); u.pn = (wgid % nig) / gsz; u.A = A + (size_t)u.pm * tstep; u.B = Bt + (size_t)u.pn * tstep; return true;
    }
    __device__ __forceinline__ void a_ready(const Unit&) const {}
    __device__ __forceinline__ void done(const Unit&) const {}
};
struct MoeOrder {
    int nM, nN, nwg, G, c; const char* A; const char* Bt; size_t tstep, estride; int s1, s2, s3, s4, s5, s6, s7;
    __device__ void init(const bf16_t* A_, const bf16_t* Bt_, const int* seg, int N, int K, int G_, int c_) { nM = __builtin_amdgcn_readfirstlane(seg[8]) / BM; nN = N / BM; nwg = nM * nN; G = G_; c = c_; A = (const char*)A_; Bt = (const char*)Bt_; tstep = (size_t)BM * K * 2; estride = (size_t)N * K * 2;
        s1 = __builtin_amdgcn_readfirstlane(seg[1]); s2 = __builtin_amdgcn_readfirstlane(seg[2]); s3 = __builtin_amdgcn_readfirstlane(seg[3]); s4 = __builtin_amdgcn_readfirstlane(seg[4]);
        s5 = __builtin_amdgcn_readfirstlane(seg[5]); s6 = __builtin_amdgcn_readfirstlane(seg[6]); s7 = __builtin_amdgcn_readfirstlane(seg[7]); }
    __device__ __forceinline__ bool next(int i, Unit& u) const {
        const long L = (long)i * G + c; if (L >= nwg) return false;
        int wgid = (int)L; { const int q = nwg / NXCD, r = nwg % NXCD, xcd = wgid % NXCD, off = wgid / NXCD; wgid = (xcd < r ? xcd * (q + 1) : r * (q + 1) + (xcd - r) * q) + off; }
        const int nig = WGM * nN, gid = wgid / nig, fm = gid * WGM, gsz = (nM - fm) < WGM ? (nM - fm) : WGM;
        u.pm = fm + ((wgid % nig) % gsz); u.pn = (wgid % nig) / gsz;
        const int r0 = u.pm * BM; const int e = (r0 >= s1) + (r0 >= s2) + (r0 >= s3) + (r0 >= s4) + (r0 >= s5) + (r0 >= s6) + (r0 >= s7);
        u.A = A + (size_t)u.pm * tstep; u.B = Bt + (size_t)e * estride + (size_t)u.pn * tstep; return true;
    }
    __device__ __forceinline__ void a_ready(const Unit&) const {}
    __device__ __forceinline__ void done(const Unit&) const {}
};

struct StackOrder {
    int nM, nN, nwg, G, c, tpl; const char* A; const char* Bt; size_t tstep, lstride;
    __device__ void init(const bf16_t* A_, const bf16_t* Bt_, int M, int N, int K, int log2TilesPerL, int G_, int c_) { nM = M / BM; nN = N / BM; nwg = nM * nN; G = G_; c = c_; tpl = log2TilesPerL; A = (const char*)A_; Bt = (const char*)Bt_; tstep = (size_t)BM * K * 2; lstride = (size_t)N * K * 2; }
    __device__ __forceinline__ bool next(int i, Unit& u) const {
        const long L = (long)i * G + c; if (L >= nwg) return false;
        int wgid = (int)L; { const int q = nwg / NXCD, r = nwg % NXCD, xcd = wgid % NXCD, off = wgid / NXCD; wgid = (xcd < r ? xcd * (q + 1) : r * (q + 1) + (xcd - r) * q) + off; }
        const int nig = WGM * nN, gid = wgid / nig, fm = gid * WGM, gsz = (nM - fm) < WGM ? (nM - fm) : WGM;
        u.pm = fm + ((wgid % nig) % gsz); u.pn = (wgid % nig) / gsz;
        u.A = A + (size_t)u.pm * tstep; u.B = Bt + (size_t)(u.pm >> tpl) * lstride + (size_t)u.pn * tstep; return true;
    }
    __device__ __forceinline__ void a_ready(const Unit&) const {}
    __device__ __forceinline__ void done(const Unit&) const {}
};

__device__ __forceinline__ unsigned cvt_pk_bf16(float lo, float hi) { unsigned r; asm volatile("v_cvt_pk_bf16_f32 %0, %1, %2" : "=v"(r) : "v"(lo), "v"(hi)); return r; }
__device__ __forceinline__ float sigmoid_f(float x) { return 1.0f / (1.0f + __expf(-x)); }

struct EpiBf16 {
    static constexpr bool PERM = true, AFTER_DRAIN = false;
    bf16_t* O; int ldc;
    __device__ __forceinline__ void operator()(const f32x4 (&acc)[2][2][4][2], const Unit& u, int wr, int wc, int fr, int fq) const {
        const int row0 = u.pm * BM + wr * 64 + fr, col0 = u.pn * BM + wc * 32 + 8 * fq;
#pragma unroll
        for (int ai = 0; ai < 2; ++ai)
#pragma unroll
            for (int m = 0; m < 4; ++m) { bf16_t* rowp = O + (size_t)(row0 + ai * HALF + m * 16) * ldc + col0;
#pragma unroll
                for (int bj = 0; bj < 2; ++bj) { const f32x4 v0 = acc[ai][bj][m][0], v1 = acc[ai][bj][m][1];
                    u32x4 w; w.x = cvt_pk_bf16(v0[0], v0[1]); w.y = cvt_pk_bf16(v0[2], v0[3]); w.z = cvt_pk_bf16(v1[0], v1[1]); w.w = cvt_pk_bf16(v1[2], v1[3]);
                    *(u32x4*)(rowp + bj * HALF) = w; } }
    }
};
struct EpiSwiGLU {
    static constexpr bool PERM = true, AFTER_DRAIN = false;
    bf16_t* O; int ldc;
    __device__ __forceinline__ void operator()(const f32x4 (&acc)[2][2][4][2], const Unit& u, int wr, int wc, int fr, int fq) const {
        const int row0 = u.pm * BM + wr * 64 + fr, col0 = u.pn * HALF + wc * 32 + 8 * fq;
#pragma unroll
        for (int ai = 0; ai < 2; ++ai)
#pragma unroll
            for (int m = 0; m < 4; ++m) { bf16_t* rowp = O + (size_t)(row0 + ai * HALF + m * 16) * ldc + col0;
                f32x4 v[2];
#pragma unroll
                for (int n = 0; n < 2; ++n) { const f32x4 g = acc[ai][0][m][n], uu = acc[ai][1][m][n];
#pragma unroll
                    for (int j = 0; j < 4; ++j) v[n][j] = g[j] * sigmoid_f(g[j]) * uu[j]; }
                u32x4 w; w.x = cvt_pk_bf16(v[0][0], v[0][1]); w.y = cvt_pk_bf16(v[0][2], v[0][3]); w.z = cvt_pk_bf16(v[1][0], v[1][1]); w.w = cvt_pk_bf16(v[1][2], v[1][3]);
                *(u32x4*)rowp = w; }
    }
};
__device__ __forceinline__ unsigned pk4_fp8(float a, float b, float c, float d) { unsigned w = 0u; w = __builtin_amdgcn_cvt_pk_fp8_f32(a, b, w, false); w = __builtin_amdgcn_cvt_pk_fp8_f32(c, d, w, true); return w; }
struct EpiSwiGLU8 {
    static constexpr bool PERM = true, AFTER_DRAIN = false;
    unsigned char* O; int ldc;
    __device__ __forceinline__ void operator()(const f32x4 (&acc)[2][2][4][2], const Unit& u, int wr, int wc, int fr, int fq) const {
        const int row0 = u.pm * BM + wr * 64 + fr, col0 = u.pn * HALF + wc * 32 + 8 * fq;
#pragma unroll
        for (int ai = 0; ai < 2; ++ai)
#pragma unroll
            for (int m = 0; m < 4; ++m) { unsigned char* rowp = O + (size_t)(row0 + ai * HALF + m * 16) * ldc + col0;
                f32x4 v[2];
#pragma unroll
                for (int n = 0; n < 2; ++n) { const f32x4 g = acc[ai][0][m][n], uu = acc[ai][1][m][n];
#pragma unroll
                    for (int j = 0; j < 4; ++j) v[n][j] = g[j] * sigmoid_f(g[j]) * uu[j]; }
                u32x2 w; w.x = pk4_fp8(v[0][0], v[0][1], v[0][2], v[0][3]); w.y = pk4_fp8(v[1][0], v[1][1], v[1][2], v[1][3]);
                *(u32x2*)rowp = w; }
    }
};
struct EpiResF32 {
    static constexpr bool PERM = false, AFTER_DRAIN = false;
    float* C; const float* res; int ldc;
    __device__ __forceinline__ void operator()(const f32x4 (&acc)[2][2][4][2], const Unit& u, int wr, int wc, int fr, int fq) const {
        const int row0 = u.pm * BM + wr * 64 + fr, col0 = u.pn * BM + wc * 32 + 4 * fq;
#pragma unroll
        for (int ai = 0; ai < 2; ++ai)
#pragma unroll
            for (int m = 0; m < 4; ++m) { const size_t off = (size_t)(row0 + ai * HALF + m * 16) * ldc + col0;
#pragma unroll
                for (int bj = 0; bj < 2; ++bj)
#pragma unroll
                    for (int n = 0; n < 2; ++n) { f32x4 o = acc[ai][bj][m][n]; if (res) o += *(const f32x4*)(res + off + bj * HALF + n * 16); *(f32x4*)(C + off + bj * HALF + n * 16) = o; }
                asm volatile("" ::: "memory"); }
    }
};
struct EpiGluRes {
    static constexpr bool PERM = false, AFTER_DRAIN = false;
    float* C; int ldc; float scl;
    __device__ __forceinline__ void operator()(const f32x4 (&acc)[2][2][4][2], const Unit& u, int wr, int wc, int fr, int fq) const {
        const int row0 = u.pm * BM + wr * 64 + fr, col0 = u.pn * HALF + wc * 32 + 4 * fq;
#pragma unroll
        for (int ai = 0; ai < 2; ++ai)
#pragma unroll
            for (int m = 0; m < 4; ++m) { float* rowp = C + (size_t)(row0 + ai * HALF + m * 16) * ldc + col0;
#pragma unroll
                for (int n = 0; n < 2; ++n) { const f32x4 o = acc[ai][0][m][n], g = acc[ai][1][m][n]; f32x4 h = *(const f32x4*)(rowp + n * 16);
#pragma unroll
                    for (int j = 0; j < 4; ++j) h[j] += o[j] * sigmoid_f(g[j]) * scl;
                    *(f32x4*)(rowp + n * 16) = h; }
                asm volatile("" ::: "memory"); }
    }
};
struct EpiPle {
    static constexpr bool PERM = false, AFTER_DRAIN = false;
    float* C; const bf16_t* P; int ldc; float scl;
    __device__ __forceinline__ void operator()(const f32x4 (&acc)[2][2][4][2], const Unit& u, int wr, int wc, int fr, int fq) const {
        const int row0 = u.pm * BM + wr * 64 + fr, col0 = u.pn * BM + wc * 32 + 4 * fq;
#pragma unroll
        for (int ai = 0; ai < 2; ++ai)
#pragma unroll
            for (int m = 0; m < 4; ++m) { const size_t off = (size_t)(row0 + ai * HALF + m * 16) * ldc + col0;
#pragma unroll
                for (int bj = 0; bj < 2; ++bj)
#pragma unroll
                    for (int n = 0; n < 2; ++n) { const f32x4 a = acc[ai][bj][m][n]; const u32x2 pw = *(const u32x2*)(P + off + bj * HALF + n * 16); f32x4 h = *(const f32x4*)(C + off + bj * HALF + n * 16);
                        h[0] += sigmoid_f(a[0]) * __uint_as_float(pw.x << 16) * scl; h[1] += sigmoid_f(a[1]) * __uint_as_float(pw.x & 0xffff0000u) * scl;
                        h[2] += sigmoid_f(a[2]) * __uint_as_float(pw.y << 16) * scl; h[3] += sigmoid_f(a[3]) * __uint_as_float(pw.y & 0xffff0000u) * scl;
                        *(f32x4*)(C + off + bj * HALF + n * 16) = h; }
                asm volatile("" ::: "memory"); }
    }
};

__device__ __forceinline__ void glds16_saddr(unsigned voff, const char* sbase, unsigned lds_dst) {
    unsigned keep; const unsigned long long b_ = (unsigned long long)sbase;
    sbase = (const char*)(((unsigned long long)(unsigned)__builtin_amdgcn_readfirstlane((int)(b_ >> 32)) << 32) | (unsigned)__builtin_amdgcn_readfirstlane((int)b_));
    lds_dst = (unsigned)__builtin_amdgcn_readfirstlane((int)lds_dst);
    asm volatile("s_mov_b32 %0, m0\n\ts_mov_b32 m0, %3\n\ts_nop 0\n\tglobal_load_lds_dwordx4 %1, %2\n\ts_mov_b32 m0, %0" : "=&s"(keep) : "v"(voff), "s"(sbase), "s"(lds_dst) : "memory");
}
typedef int i32x8 __attribute__((ext_vector_type(8)));
__device__ __forceinline__ void mfma8_acc(f32x4& acc, const i32x8& a, const i32x8& b, int sc) {
    asm volatile("v_mfma_scale_f32_16x16x128_f8f6f4 %0, %1, %2, %0, %3, %3 op_sel_hi:[0,0,0]" : "+v"(acc) : "v"(a), "v"(b), "v"(sc));
}
__device__ __forceinline__ i32x8 cat16(bf16x8 lo, bf16x8 hi) { const u32x4 a = __builtin_bit_cast(u32x4, lo), b = __builtin_bit_cast(u32x4, hi); return (i32x8){(int)a.x, (int)a.y, (int)a.z, (int)a.w, (int)b.x, (int)b.y, (int)b.z, (int)b.w}; }
template <class Epi, class Sched, bool ALIGN_EPI = false, bool SP2 = false, bool FP8 = false, int WSC = 127>
__device__ __forceinline__ void gemm_phase(PG8_LAS unsigned char* lds, const int K, const Sched& S, const Epi& E, const int wave_s  ) {
    int lane_; asm volatile("v_mbcnt_lo_u32_b32 %0, -1, 0\n\tv_mbcnt_hi_u32_b32 %0, -1, %0" : "=v"(lane_)); const int tid_ = wave_s * 64 + lane_;
    const int tid = tid_, wid = wave_s, lane = tid & 63, wr = wid >> 2, wc = wid & 3, fr = lane & 15, fq = lane >> 4;
    const int nt = K / BK;
    unsigned voffA[2], voffB[2];
#pragma unroll
    for (int i = 0; i < 2; ++i) { int R, C; stage_rc(tid * 16 + i * 8192, R, C); const int Rb = Epi::PERM ? ((R & ~31) + perm32(R & 31)) : R;
        voffA[i] = (unsigned)(R * K + C) * 2u; voffB[i] = (unsigned)(Rb * K + C) * 2u; }
    const size_t kstep = (size_t)(BK * 2);
    const size_t hstep = (size_t)HALF * K * 2;
    const unsigned ldsw = (unsigned)wid * 1024u;
    const int aoff = lds_byte(wr * 64 + fr, fq * 8), boff = lds_byte(wc * 32 + fr, fq * 8);
#define PG8_SA(b, h) (((b) * 2 + (h)) * HTB)
#define PG8_SB(b, h) ((4 + (b) * 2 + (h)) * HTB)
#define PG8_STAGE(bufoff, gbase, voff) do { _Pragma("unroll") for (int _i = 0; _i < 2; ++_i) { \
        glds16_saddr((voff)[_i], (const char*)(gbase), (unsigned)(unsigned long)(lds + (bufoff) + ldsw + _i * 8192)); } } while (0)
#define PG8_LD8(p) cat16(*(const PG8_LAS bf16x8*)(p), *(const PG8_LAS bf16x8*)((p) + 1024))
#define PG8_LDA(dst, b, h) do { if constexpr (FP8) { _Pragma("unroll") for (int m = 0; m < 4; ++m) dst##8[m] = PG8_LD8(lds + PG8_SA(b, h) + aoff + m * 2048); } else { \
        _Pragma("unroll") for (int m = 0; m < 4; ++m) _Pragma("unroll") for (int k = 0; k < 2; ++k) dst[m][k] = *(const PG8_LAS bf16x8*)(lds + PG8_SA(b, h) + aoff + m * 2048 + k * 1024); } } while (0)
#define PG8_LDB(dst, b, h) do { if constexpr (FP8) { _Pragma("unroll") for (int n = 0; n < 2; ++n) dst##8[n] = PG8_LD8(lds + PG8_SB(b, h) + boff + n * 2048); } else { \
        _Pragma("unroll") for (int n = 0; n < 2; ++n) _Pragma("unroll") for (int k = 0; k < 2; ++k) dst[n][k] = *(const PG8_LAS bf16x8*)(lds + PG8_SB(b, h) + boff + n * 2048 + k * 1024); } } while (0)
#define PG8_MMA(ai, bj, At, Bt) do { __builtin_amdgcn_s_setprio(1); if constexpr (FP8) { _Pragma("unroll") for (int m = 0; m < 4; ++m) _Pragma("unroll") for (int n = 0; n < 2; ++n) \
        mfma8_acc(acc[ai][bj][m][n], Bt##8[n], At##8[m], sc8); } else { \
        _Pragma("unroll") for (int m = 0; m < 4; ++m) _Pragma("unroll") for (int n = 0; n < 2; ++n) _Pragma("unroll") for (int k = 0; k < 2; ++k) \
        acc[ai][bj][m][n] = __builtin_amdgcn_mfma_f32_16x16x32_bf16(Bt[n][k], At[m][k], acc[ai][bj][m][n], 0, 0, 0); } __builtin_amdgcn_s_setprio(0); } while (0)
#define PG8_WAIT_V(n) asm volatile("s_waitcnt vmcnt(" #n ")" ::: "memory")
#define PG8_WAIT_L(n) asm volatile("s_waitcnt lgkmcnt(" #n ")" ::: "memory")
#define PG8_BAR __builtin_amdgcn_s_barrier()
#define PG8_SCHED __builtin_amdgcn_sched_barrier(0)
    Unit cur, nxt; int ui = 0;
    if (!S.next(0, cur)) return;
    f32x4 acc[2][2][4][2];
#pragma unroll
    for (int a = 0; a < 2; ++a)
#pragma unroll
        for (int b = 0; b < 2; ++b)
#pragma unroll
            for (int m = 0; m < 4; ++m)
#pragma unroll
                for (int n = 0; n < 2; ++n) acc[a][b][m][n] = (f32x4){0.f, 0.f, 0.f, 0.f};
    int sc8 = WSC; asm volatile("" : "+v"(sc8));
    bf16x8 At[4][2], B0[2][2], B1[2][2];
    i32x8 At8[4], B08[2], B18[2];
    const char* cA = cur.A; const char* cB = cur.B;
    S.a_ready(cur);
    if constexpr (SP2) {
        PG8_STAGE(PG8_SB(0, 0), cB, voffB); PG8_STAGE(PG8_SB(0, 1), cB + hstep, voffB); PG8_STAGE(PG8_SA(0, 0), cA, voffA); PG8_STAGE(PG8_SA(0, 1), cA + hstep, voffA);
        if (wr == 1) PG8_BAR;
        PG8_WAIT_V(2); PG8_BAR;
        PG8_STAGE(PG8_SB(1, 0), cB + kstep, voffB); PG8_STAGE(PG8_SA(1, 0), cA + kstep, voffA); PG8_STAGE(PG8_SB(1, 1), cB + hstep + kstep, voffB);
        PG8_WAIT_V(6); PG8_BAR;
    } else {
        PG8_STAGE(PG8_SB(0, 0), cB, voffB); PG8_STAGE(PG8_SA(0, 0), cA, voffA); PG8_STAGE(PG8_SB(0, 1), cB + hstep, voffB); PG8_STAGE(PG8_SA(0, 1), cA + hstep, voffA);
        if (wr == 1) PG8_BAR;
        PG8_WAIT_V(4); PG8_BAR;
        PG8_STAGE(PG8_SB(1, 0), cB + kstep, voffB); PG8_STAGE(PG8_SA(1, 0), cA + kstep, voffA); PG8_STAGE(PG8_SB(1, 1), cB + hstep + kstep, voffB);
        PG8_WAIT_V(6); PG8_BAR;
    }
    for (;;) {
        const bool has_next = S.next(ui + 1, nxt);
        const char* nA = has_next ? nxt.A : cA; const char* nB = has_next ? nxt.B : cB;
        for (int t = 0; t < nt; t += 2) {
            const bool last = (t == nt - 2);
            const char* a1 = cA + (size_t)(t + 1) * kstep;
            const char* a2 = last ? nA : cA + (size_t)(t + 2) * kstep; const char* b2 = last ? nB : cB + (size_t)(t + 2) * kstep;
            const char* a3 = a2 + kstep; const char* b3 = b2 + kstep;
            if (last && has_next) S.a_ready(nxt);
            if constexpr (SP2) {
            PG8_LDB(B0, 0, 0); PG8_LDB(B1, 0, 1); PG8_SCHED; PG8_LDA(At, 0, 0); PG8_STAGE(PG8_SA(1, 1), a1 + hstep, voffA);
            PG8_WAIT_V(8); PG8_WAIT_L(0); PG8_BAR; PG8_MMA(0, 0, At, B0); PG8_MMA(0, 1, At, B1); PG8_BAR; PG8_SCHED;
            PG8_LDA(At, 0, 1); PG8_STAGE(PG8_SB(0, 0), b2, voffB); PG8_STAGE(PG8_SB(0, 1), b2 + hstep, voffB); PG8_STAGE(PG8_SA(0, 0), a2, voffA);
            PG8_WAIT_V(8); PG8_WAIT_L(0); PG8_BAR; PG8_MMA(1, 0, At, B0); PG8_MMA(1, 1, At, B1); PG8_BAR; PG8_SCHED;
            PG8_LDB(B0, 1, 0); PG8_LDB(B1, 1, 1); PG8_SCHED; PG8_LDA(At, 1, 0); PG8_STAGE(PG8_SA(0, 1), a2 + hstep, voffA);
            PG8_WAIT_V(8); PG8_WAIT_L(0); PG8_BAR; PG8_MMA(0, 0, At, B0); PG8_MMA(0, 1, At, B1); PG8_BAR; PG8_SCHED;
            PG8_LDA(At, 1, 1); PG8_STAGE(PG8_SB(1, 0), b3, voffB); PG8_STAGE(PG8_SB(1, 1), b3 + hstep, voffB); PG8_STAGE(PG8_SA(1, 0), a3, voffA);
            PG8_WAIT_V(8); PG8_WAIT_L(0); PG8_BAR; PG8_MMA(1, 0, At, B0); PG8_MMA(1, 1, At, B1); PG8_BAR; PG8_SCHED;
            } else {
            PG8_LDB(B0, 0, 0); PG8_SCHED; PG8_LDA(At, 0, 0); PG8_STAGE(PG8_SA(1, 1), a1 + hstep, voffA);
            PG8_WAIT_L(8); PG8_BAR; PG8_WAIT_L(0); PG8_MMA(0, 0, At, B0); PG8_BAR; PG8_SCHED;
            PG8_LDB(B1, 0, 1); PG8_STAGE(PG8_SB(0, 0), b2, voffB);
            PG8_BAR; PG8_WAIT_L(0); PG8_MMA(0, 1, At, B1); PG8_BAR;
            PG8_LDA(At, 0, 1); PG8_STAGE(PG8_SA(0, 0), a2, voffA);
            PG8_BAR; PG8_WAIT_L(0); PG8_MMA(1, 0, At, B0); PG8_BAR; PG8_SCHED;
            PG8_STAGE(PG8_SB(0, 1), b2 + hstep, voffB);
            PG8_WAIT_V(6); PG8_BAR; PG8_MMA(1, 1, At, B1); PG8_BAR;
            PG8_LDB(B0, 1, 0); PG8_SCHED; PG8_LDA(At, 1, 0); PG8_STAGE(PG8_SA(0, 1), a2 + hstep, voffA);
            PG8_WAIT_L(8); PG8_BAR; PG8_WAIT_L(0); PG8_MMA(0, 0, At, B0); PG8_BAR; PG8_SCHED;
            PG8_LDB(B1, 1, 1); PG8_STAGE(PG8_SB(1, 0), b3, voffB);
            PG8_BAR; PG8_WAIT_L(0); PG8_MMA(0, 1, At, B1); PG8_BAR;
            PG8_LDA(At, 1, 1); PG8_STAGE(PG8_SA(1, 0), a3, voffA);
            PG8_BAR; PG8_WAIT_L(0); PG8_MMA(1, 0, At, B0); PG8_BAR; PG8_SCHED;
            PG8_STAGE(PG8_SB(1, 1), b3 + hstep, voffB);
            PG8_WAIT_V(6); PG8_BAR; PG8_MMA(1, 1, At, B1); PG8_BAR;
            }
        }
        if constexpr (FP8) asm volatile("s_nop 15\n\ts_nop 15" ::: "memory");
        if constexpr (ALIGN_EPI) { if (wr == 0) PG8_BAR; }
        if constexpr (!Epi::AFTER_DRAIN) { E(acc, cur, wr, wc, fr, fq); S.done(cur); }
        if (!has_next) break;
#pragma unroll
        for (int a = 0; a < 2; ++a)
#pragma unroll
            for (int b = 0; b < 2; ++b)
#pragma unroll
                for (int m = 0; m < 4; ++m)
#pragma unroll
                    for (int n = 0; n < 2; ++n) acc[a][b][m][n] = (f32x4){0.f, 0.f, 0.f, 0.f};
        cur = nxt; cA = nA; cB = nB; ++ui;
        if constexpr (ALIGN_EPI) { if (wr == 1) PG8_BAR; }
    }
    PG8_WAIT_V(0);
    if constexpr (!ALIGN_EPI) { if (wr == 0) PG8_BAR; }
    PG8_BAR;
    if constexpr (Epi::AFTER_DRAIN) { E.fused(acc, cur, wr, wc, fr, fq, lds, wid, lane); S.done(cur); }
#undef PG8_SA
#undef PG8_SB
#undef PG8_STAGE
#undef PG8_LD8
#undef PG8_LDA
#undef PG8_LDB
#undef PG8_MMA
#undef PG8_WAIT_V
#undef PG8_WAIT_L
#undef PG8_BAR
#undef PG8_SCHED
}
}

#ifndef EXP_ZERO_HG
#define EXP_ZERO_HG 0
#endif
#ifndef EXP_ZERO_S5
#define EXP_ZERO_S5 0
#endif
#ifndef EXP_ZERO_MOE
#define EXP_ZERO_MOE 0
#endif
#ifndef EXP_ZERO_FFN
#define EXP_ZERO_FFN 0
#endif
#ifndef EXP_PROBE
#define EXP_PROBE 0
#endif
#ifndef EXP_ZERO_GLU
#define EXP_ZERO_GLU 0
#endif
#ifndef EXP_ZERO_PLE
#define EXP_ZERO_PLE 0
#endif
#ifndef EXP_PROBE_LAYER
#define EXP_PROBE_LAYER 1
#endif
#ifndef EXP_TIMING
#define EXP_TIMING 0
#endif
#ifndef EXP_TIMING_CAT
#define EXP_TIMING_CAT 1
#endif
#ifndef EXP_MIXTIME
#define EXP_MIXTIME 0
#endif
#ifndef EXP_MIXTIME_CAT
#define EXP_MIXTIME_CAT 0
#endif
#ifndef EXP_ZERO_SSD
#define EXP_ZERO_SSD 0
#endif
#ifndef MIX_MFMA
#define MIX_MFMA 1
#endif
#ifndef S5_MFMA
#define S5_MFMA 1
#endif
constexpr int NB = 8, SEQ = 2048, D = 1024, T = NB * SEQ, DEPTH = 4, PLE = 256;
constexpr int HGH = 4, HGD = 128, HGW = 512;
constexpr int M2H = 8, M2P = 64, M2I = 512, M2N = 128, M2XBC = 1024;
constexpr int EIN = 4112, EINP = 4096;
constexpr int S5G = 64, S5N = 64, S5C = 16;
constexpr int FF = 3584, NE = 8;
constexpr int MOE_ROWS = 2 * T + NE * 256;
constexpr float EPS = 1e-6f;
constexpr float W8_GU_MULT = 64.f, W8_DN_MULT = 64.f;
constexpr int W8_GU_SC = 127 - 3, W8_DN_SC = 127 - 3;
constexpr int NWAVES = 8, NTHR = 512;

constexpr size_t MiB = 1u << 20;
constexpr size_t WS_CTL = 0, CTL_ZERO_BYTES = 1 * MiB;
constexpr size_t WS_WIN = 1 * MiB;
constexpr size_t WS_WOUT = WS_WIN + 16 * MiB;
constexpr size_t WS_WGU = WS_WOUT + 4 * MiB;
constexpr size_t WS_WDN = WS_WGU + 28 * MiB;
constexpr size_t WS_WGLU = WS_WDN + 14 * MiB;
constexpr size_t WS_WPG = WS_WGLU + 8 * MiB;
constexpr size_t WS_WPP = WS_WPG + 8 * MiB;
constexpr size_t WS_WMGU = WS_WPP + 2 * MiB;
constexpr size_t WS_WMDN = WS_WMGU + 224 * MiB;
constexpr size_t WS_WDT = WS_WMDN + 112 * MiB;
constexpr size_t WS_H = WS_WDT + 1 * MiB;
constexpr size_t WS_HN = WS_H + 64 * MiB;
constexpr size_t WS_MIX = WS_HN + 32 * MiB;
constexpr size_t WS_PB = WS_MIX + 32 * MiB;
constexpr size_t WS_PP = WS_PB + 32 * MiB;
constexpr size_t WS_XBUF = WS_PP + 128 * MiB;
constexpr size_t WS_YBUF = WS_XBUF + 68 * MiB;
constexpr size_t WS_DT = WS_YBUF + 136 * MiB;
constexpr size_t WS_ROUTE = WS_DT + 1 * MiB;
constexpr size_t WS_R = WS_ROUTE + 1 * MiB;
constexpr size_t WS_PROJ = WS_R, WS_XBC = WS_R + 128 * MiB, WS_OA = WS_R + 160 * MiB, WS_YA = WS_R + 224 * MiB, WS_ACT = WS_R, WS_YS = WS_R;
constexpr size_t WS_END = WS_R + 288 * MiB;
static_assert((size_t)MOE_ROWS * FF * 2 <= 288 * MiB && (size_t)MOE_ROWS * D * 2 <= 68 * MiB && (size_t)MOE_ROWS * D * 4 <= 136 * MiB, "ws map");
constexpr int CW_BAR = 4096;

constexpr int RING_BYTES = 131072;
constexpr int LDS_BYTES = 147456;
constexpr int MISC_OFF = LDS_BYTES - 128;

#define GAS __attribute__((address_space(1)))
#define LAS __attribute__((address_space(3)))
typedef unsigned short bf16;
typedef unsigned v4u __attribute__((ext_vector_type(4)));
typedef unsigned v2u __attribute__((ext_vector_type(2)));
typedef float f32x4 __attribute__((ext_vector_type(4)));
typedef int v4i __attribute__((ext_vector_type(4)));
#define LDS_WAIT() asm volatile("s_waitcnt lgkmcnt(0)" ::: "memory")
__device__ __forceinline__ unsigned f2bf(float f) { unsigned u = __builtin_bit_cast(unsigned, f); return (u + 0x7fffu + ((u >> 16) & 1u)) >> 16; }
__device__ __forceinline__ unsigned pk2(float lo, float hi) { return f2bf(lo) | (f2bf(hi) << 16); }
__device__ __forceinline__ float bflo(unsigned w) { return __uint_as_float(w << 16); }
__device__ __forceinline__ float bfhi(unsigned w) { return __uint_as_float(w & 0xffff0000u); }
__device__ __forceinline__ float bf1(bf16 b) { return __uint_as_float((unsigned)b << 16); }
__device__ __forceinline__ float sigm(float x) { return 1.0f / (1.0f + __expf(-x)); }
__device__ __forceinline__ float silu_f(float x) { return x * sigm(x); }
__device__ __forceinline__ float softplus_f(float x) { return x > 20.f ? x : log1pf(__expf(x)); }
__device__ __forceinline__ float gelu_tanh(float x) { const float u = 0.7978845608028654f * (x + 0.044715f * x * x * x); return 0.5f * x * (1.0f + tanhf(u)); }
__device__ __forceinline__ float sx(float v, int o, int lane) { return __builtin_bit_cast(float, __builtin_amdgcn_ds_bpermute((lane ^ o) << 2, __builtin_bit_cast(int, v))); }
__device__ __forceinline__ float wave_sum(float v, int lane) {
#pragma unroll
    for (int o = 1; o < 64; o <<= 1) v += sx(v, o, lane);
    return v;
}
#define XB_TMO      128
#define XB_XCNT(j)  (256  + 64 * (j))
#define XB_XSUB(j)  (1280 + 64 * (j))
#define XB_XGEN(j)  (2304 + 64 * (j))
#define XB_TOP      3328
#define XB_TOPGEN   3392
#define XCD_BAR_WORDS 3456
#define XB_SPIN_CAP (1u << 18)

__device__ __forceinline__ unsigned xb_ld(unsigned* p)              { return __hip_atomic_load(p, __ATOMIC_RELAXED, __HIP_MEMORY_SCOPE_AGENT); }
__device__ __forceinline__ unsigned xb_add(unsigned* p, unsigned v) { return __hip_atomic_fetch_add(p, v, __ATOMIC_RELAXED, __HIP_MEMORY_SCOPE_AGENT); }
__device__ __forceinline__ unsigned xb_xcc_id() { return (unsigned)__builtin_amdgcn_s_getreg((3 << 11) | 20) & 0xFu; }
#define XB_SPIN(cond, bar) do { unsigned _sp = 0; while (cond) { __builtin_amdgcn_s_sleep(1); \
    if ((++_sp & 255u) == 0u) { if (xb_ld(&(bar)[XB_TMO])) break; if (_sp > XB_SPIN_CAP) { atomicAdd(&(bar)[XB_TMO], 1u); break; } } } } while (0)

struct XcdBarrier {
    unsigned* bar; unsigned x;
    volatile LAS unsigned* st;
};

__device__ __forceinline__ XcdBarrier xcd_barrier_post(unsigned* bar, volatile LAS unsigned* st) {
    XcdBarrier b; b.bar = bar; b.x = xb_xcc_id(); b.st = st;
    if (threadIdx.x == 0) (void)xb_add(&bar[XB_XCNT(b.x)], 1u);
    return b;
}
__device__ __forceinline__ void xcd_barrier_complete(unsigned* bar, unsigned x, unsigned& nloc, unsigned& nx) {
    const unsigned G = gridDim.x * gridDim.y * gridDim.z;
    unsigned sum, cnt, mine, sp = 0u;
    for (;;) {
        sum = 0u; cnt = 0u; mine = 0u;
#pragma unroll
        for (unsigned j = 0; j < 16; ++j) { const unsigned c = xb_ld(&bar[XB_XCNT(j)]); sum += c; cnt += (c > 0u) ? 1u : 0u; mine = (j == x) ? c : mine; }
        if (sum == G) break;
        __builtin_amdgcn_s_sleep(1);
        if ((++sp & 255u) == 0u) { if (xb_ld(&bar[XB_TMO])) break; if (sp > XB_SPIN_CAP) { atomicAdd(&bar[XB_TMO], 1u); break; } }
    }
    nloc = mine > 0u ? mine : 1u; nx = cnt > 0u ? cnt : 1u;
}

__device__ __forceinline__ void xcd_barrier(const XcdBarrier& b) {
    asm volatile("s_waitcnt vmcnt(0)" ::: "memory");
    __syncthreads();
    if (threadIdx.x == 0) {
        unsigned* bar = b.bar;
        __builtin_amdgcn_s_waitcnt(0);
        unsigned nloc = b.st[0], nx = b.st[1];
        if (nloc == 0u) { xcd_barrier_complete(bar, b.x, nloc, nx); b.st[0] = nloc; b.st[1] = nx; }
        const unsigned old = xb_add(&bar[XB_XSUB(b.x)], 1u);
        const unsigned gen = old / nloc;
        if (old + 1u == (gen + 1u) * nloc) {
            __builtin_amdgcn_fence(__ATOMIC_RELEASE, "agent");
            asm volatile("s_waitcnt vmcnt(0)" ::: "memory");
            const unsigned og = xb_add(&bar[XB_TOP], 1u);
            const unsigned tg = og / nx;
            if (og + 1u == (tg + 1u) * nx) xb_add(&bar[XB_TOPGEN], 1u);
            else XB_SPIN(xb_ld(&bar[XB_TOPGEN]) == tg, bar);
            __builtin_amdgcn_fence(__ATOMIC_ACQUIRE, "agent");
            xb_add(&bar[XB_XGEN(b.x)], 1u);
            asm volatile("s_waitcnt vmcnt(0)" ::: "memory");
        } else {
            XB_SPIN(xb_ld(&bar[XB_XGEN(b.x)]) == gen, bar);
            __builtin_amdgcn_fence(__ATOMIC_ACQUIRE, "agent");
            asm volatile("s_waitcnt vmcnt(0)" ::: "memory");
        }
    }
    __syncthreads();
}


enum { I_X = 0, I_P, I_NORM_MIX, I_NORM_FFN, I_NORM_PLE, I_FINAL_NORM, I_PLE_GATE, I_PLE_PROJ, I_EV_W_IN, I_EV_W_OUT, I_HG_LB, I_HG_NORM_W, I_M2_CONV_W, I_M2_CONV_B, I_M2_DT_BIAS, I_M2_A_LOG, I_M2_D,
       I_M2_NORM_W, I_S5_A_RE, I_S5_A_IM, I_S5_LOG_STEP, I_S5_B_RE, I_S5_B_IM, I_S5_C_RE, I_S5_C_IM, I_S5_D, I_S5_GLU_W, I_FFN_W_GU, I_FFN_W_DOWN, I_MOE_ROUTER, I_MOE_W_GU, I_MOE_W_DOWN, N_IN };
struct Args { const float* in[N_IN]; float* out; unsigned char* ws; int ph_lo, ph_hi; };

constexpr int TR_LDS = 64 * 65 * 4;
__device__ __forceinline__ void transpose_item(const float* W, int K, int ldw, bf16* WT, int Ndst, int half, const float* scale, LAS float* scr, int item, int lane) {
    const int nblk = Ndst / 64, kb = item / nblk, nb = item % nblk, k0 = 64 * kb, n0 = 64 * nb;
    int s0 = n0;
    if (half) { const int tile = n0 >> 8, w = n0 & 255; s0 = (w < 128) ? (128 * tile + w) : (half + 128 * tile + (w - 128)); }
    const int lq = lane >> 4, lc = 4 * (lane & 15);
#pragma unroll 8
    for (int i = 0; i < 16; ++i) { const int kk = lq + 4 * i; f32x4 x = *(const f32x4*)(W + (size_t)(k0 + kk) * ldw + s0 + lc); if (scale) x = x * scale[k0 + kk];
        LAS float* d = scr + kk * 65 + lc; d[0] = x[0]; d[1] = x[1]; d[2] = x[2]; d[3] = x[3]; }
    LDS_WAIT(); asm volatile("" ::: "memory");
    const int c = lane & 7;
#pragma unroll
    for (int j = 0; j < 8; ++j) { const int n = (lane >> 3) + 8 * j; const LAS float* s = scr + (8 * c) * 65 + n;
        v4u o; o.x = pk2(s[0 * 65], s[1 * 65]); o.y = pk2(s[2 * 65], s[3 * 65]); o.z = pk2(s[4 * 65], s[5 * 65]); o.w = pk2(s[6 * 65], s[7 * 65]);
        *(v4u*)(WT + (size_t)(n0 + n) * K + k0 + 8 * c) = o; }
    LDS_WAIT(); asm volatile("" ::: "memory");
}
__device__ __forceinline__ void transpose_item8(const float* W, int K, int ldw, unsigned char* WT8, int Ndst, int half, const float* scale, float mult, LAS float* scr, int item, int lane) {
    const int nblk = Ndst / 64, kb = item / nblk, nb = item % nblk, k0 = 64 * kb, n0 = 64 * nb;
    int s0 = n0;
    if (half) { const int tile = n0 >> 8, w = n0 & 255; s0 = (w < 128) ? (128 * tile + w) : (half + 128 * tile + (w - 128)); }
    const int lq = lane >> 4, lc = 4 * (lane & 15);
#pragma unroll 8
    for (int i = 0; i < 16; ++i) { const int kk = lq + 4 * i; f32x4 x = *(const f32x4*)(W + (size_t)(k0 + kk) * ldw + s0 + lc); x = x * (scale ? scale[k0 + kk] * mult : mult);
        LAS float* d = scr + kk * 65 + lc; d[0] = x[0]; d[1] = x[1]; d[2] = x[2]; d[3] = x[3]; }
    LDS_WAIT(); asm volatile("" ::: "memory");
    const int c = lane & 7;
#pragma unroll
    for (int j = 0; j < 8; ++j) { const int n = (lane >> 3) + 8 * j; const LAS float* sp = scr + (8 * c) * 65 + n;
        v2u o; o.x = pg8::pk4_fp8(sp[0 * 65], sp[1 * 65], sp[2 * 65], sp[3 * 65]); o.y = pg8::pk4_fp8(sp[4 * 65], sp[5 * 65], sp[6 * 65], sp[7 * 65]);
        *(v2u*)(WT8 + (size_t)(n0 + n) * K + k0 + 8 * c) = o; }
    LDS_WAIT(); asm volatile("" ::: "memory");
}
constexpr int CI_IN = 16 * 64, CI_OUT = 16 * 16, CI_GU = 16 * 112, CI_DN = 56 * 16, CI_GLU = 16 * 32, CI_PG = 16 * 16, CI_PPJ = 4 * 16;
constexpr int CN_SMALL = 2 * CI_IN + 2 * CI_OUT + 2 * CI_GU + 2 * CI_DN + 2 * CI_GLU + 4 * CI_PG + 4 * CI_PPJ, CN_MOE = 8 * CI_GU + 8 * CI_DN;
__device__ __forceinline__ void convert_small_item(const Args& a, unsigned char* ws, LAS float* scr, int it, int lane) {
    int r = it;
    if (r < 2 * CI_IN) { const int j = r / CI_IN; transpose_item(a.in[I_EV_W_IN] + (size_t)j * D * EIN, D, EIN, (bf16*)(ws + WS_WIN) + (size_t)j * EINP * D, EINP, 0, a.in[I_NORM_MIX] + (2 * j) * D, scr, r % CI_IN, lane); return; } r -= 2 * CI_IN;
    if (r < 2 * CI_OUT) { const int j = r / CI_OUT; transpose_item(a.in[I_EV_W_OUT] + (size_t)j * D * D, D, D, (bf16*)(ws + WS_WOUT) + (size_t)j * D * D, D, 0, nullptr, scr, r % CI_OUT, lane); return; } r -= 2 * CI_OUT;
    if (r < 2 * CI_GU) { const int j = r / CI_GU; transpose_item(a.in[I_FFN_W_GU] + (size_t)j * D * 2 * FF, D, 2 * FF, (bf16*)(ws + WS_WGU) + (size_t)j * 2 * FF * D, 2 * FF, FF, a.in[I_NORM_FFN] + (2 * j) * D, scr, r % CI_GU, lane); return; } r -= 2 * CI_GU;
    if (r < 2 * CI_DN) { const int j = r / CI_DN; transpose_item(a.in[I_FFN_W_DOWN] + (size_t)j * FF * D, FF, D, (bf16*)(ws + WS_WDN) + (size_t)j * D * FF, D, 0, nullptr, scr, r % CI_DN, lane); return; } r -= 2 * CI_DN;
    if (r < 2 * CI_GLU) { const int j = r / CI_GLU; transpose_item(a.in[I_S5_GLU_W] + (size_t)j * D * 2 * D, D, 2 * D, (bf16*)(ws + WS_WGLU) + (size_t)j * 2 * D * D, 2 * D, D, nullptr, scr, r % CI_GLU, lane); return; } r -= 2 * CI_GLU;
    if (r < 4 * CI_PG) { const int l = r / CI_PG; transpose_item(a.in[I_PLE_GATE] + (size_t)l * D * D, D, D, (bf16*)(ws + WS_WPG) + (size_t)l * D * D, D, 0, a.in[I_NORM_PLE] + l * D, scr, r % CI_PG, lane); return; } r -= 4 * CI_PG;
    { const int l = r / CI_PPJ; transpose_item(a.in[I_PLE_PROJ] + (size_t)l * PLE * D, PLE, D, (bf16*)(ws + WS_WPP) + (size_t)l * D * PLE, D, 0, nullptr, scr, r % CI_PPJ, lane); }
}
__device__ __forceinline__ void convert_moe_item(const Args& a, unsigned char* ws, int j, LAS float* scr, int it, int lane) {
    if (it < 8 * CI_GU) { const int je = j * 8 + it / CI_GU; transpose_item8(a.in[I_MOE_W_GU] + (size_t)je * D * 2 * FF, D, 2 * FF, ws + WS_WMGU + (size_t)je * 2 * FF * D, 2 * FF, FF, a.in[I_NORM_FFN] + (2 * j + 1) * D, W8_GU_MULT, scr, it % CI_GU, lane); return; }
    const int r = it - 8 * CI_GU; const int je = j * 8 + r / CI_DN; transpose_item8(a.in[I_MOE_W_DOWN] + (size_t)je * FF * D, FF, D, ws + WS_WMDN + (size_t)je * D * FF, D, 0, nullptr, W8_DN_MULT, scr, r % CI_DN, lane);
}
__device__ __forceinline__ void prologue_phase(const Args& a, unsigned char* ws, LAS unsigned char* lds, int tid, int lane, int wave, int bid, int G) {
    LAS float* scr = (LAS float*)(lds + wave * TR_LDS);
    const int gw = bid * NWAVES + wave, NGW = G * NWAVES;
    for (int it = gw; it < CN_SMALL; it += NGW) convert_small_item(a, ws, scr, it, lane);
    const int gt = bid * NTHR + tid, NT = G * NTHR;
    { const f32x4* src = (const f32x4*)a.in[I_P]; v4u* dst = (v4u*)(ws + WS_PB);
      for (int i = gt; i < DEPTH * T * PLE / 8; i += NT) { const f32x4 x0 = src[2 * (size_t)i], x1 = src[2 * (size_t)i + 1]; v4u o; o.x = pk2(x0[0], x0[1]); o.y = pk2(x0[2], x0[3]); o.z = pk2(x1[0], x1[1]); o.w = pk2(x1[2], x1[3]); dst[i] = o; } }
    { float* wdt = (float*)(ws + WS_WDT);
      for (int i = gt; i < 2 * D * 16; i += NT) { const int j = i / (D * 16), c = (i / 16) % D, o = i % 16; wdt[i] = a.in[I_NORM_MIX][(2 * j) * D + c] * a.in[I_EV_W_IN][(size_t)j * D * EIN + (size_t)c * EIN + EINP + o]; }
      float* wr = (float*)(ws + WS_WDT + 256 * 1024);
      for (int i = gt; i < 2 * D * 8; i += NT) { const int j = i / (D * 8), c = (i / 8) % D, e = i % 8; wr[i] = a.in[I_NORM_FFN][(2 * j + 1) * D + c] * a.in[I_MOE_ROUTER][(size_t)j * D * 8 + c * 8 + e]; }
      float* lb = (float*)(ws + WS_WDT + 512 * 1024);
      for (int i = gt; i < HGW; i += NT) { const float l0 = a.in[I_HG_LB][i], l1 = a.in[I_HG_LB][HGW + i], m = fmaxf(l0, l1), e0 = expf(l0 - m), e1 = expf(l1 - m), s0 = e0 / (e0 + e1), s1 = e1 / (e0 + e1);
          lb[i] = s0 - s0; lb[HGW + i] = (s0 + s1) - s0; } }
}

__device__ __forceinline__ float load_row_rstd(const float* row, int lane, f32x4 (&v)[4]) {
    const f32x4* xr = (const f32x4*)row + lane; float s = 0.f;
#pragma unroll
    for (int j = 0; j < 4; ++j) { v[j] = xr[64 * j]; s += (v[j][0] * v[j][0] + v[j][1] * v[j][1]) + (v[j][2] * v[j][2] + v[j][3] * v[j][3]); }
    return 1.0f / sqrtf(wave_sum(s, lane) * (1.0f / D) + EPS);
}
__device__ __forceinline__ void store_row_bf16(bf16* orow, int lane, const f32x4 (&v)[4], float rstd) {
    unsigned long long* o8 = (unsigned long long*)orow + lane;
#pragma unroll
    for (int j = 0; j < 4; ++j) o8[64 * j] = (unsigned long long)pk2(v[j][0] * rstd, v[j][1] * rstd) | ((unsigned long long)pk2(v[j][2] * rstd, v[j][3] * rstd) << 32);
}
__device__ __forceinline__ void store_row_fp8(unsigned char* orow, int lane, const f32x4 (&v)[4], float rstd) {
    unsigned* o4 = (unsigned*)orow + lane;
#pragma unroll
    for (int j = 0; j < 4; ++j) o4[64 * j] = pg8::pk4_fp8(v[j][0] * rstd, v[j][1] * rstd, v[j][2] * rstd, v[j][3] * rstd);
}
__device__ __forceinline__ void norm8_phase(const float* src, unsigned char* HN8, int lane, int wave, int bid, int G) {
    const int gw = bid * NWAVES + wave, NGW = G * NWAVES;
    for (int row = gw; row < T; row += NGW) { f32x4 v[4]; const float rstd = load_row_rstd(src + (size_t)row * D, lane, v); store_row_fp8(HN8 + (size_t)row * D, lane, v, rstd); }
}
__device__ __forceinline__ void norm_phase(const float* src, bf16* HN, int lane, int wave, int bid, int G) {
    const int gw = bid * NWAVES + wave, NGW = G * NWAVES;
    for (int row = gw; row < T; row += NGW) { f32x4 v[4]; const float rstd = load_row_rstd(src + (size_t)row * D, lane, v); store_row_bf16(HN + (size_t)row * D, lane, v, rstd); }
}
__device__ __forceinline__ void norm_even_phase(const float* src, bf16* HN, const float* wdt  , const float* dt_bias  , float* DT, LAS unsigned char* lds, int tid, int lane, int wave, int bid, int G) {
    LAS float* wl = (LAS float*)lds;
    for (int i = tid; i < D * 16; i += NTHR) wl[(i & 15) * D + (i >> 4)] = wdt[i];
    __syncthreads();
    const int gw = bid * NWAVES + wave, NGW = G * NWAVES;
    for (int row = gw; row < T; row += NGW) {
        f32x4 v[4]; const float rstd = load_row_rstd(src + (size_t)row * D, lane, v); store_row_bf16(HN + (size_t)row * D, lane, v, rstd);
        float mine = 0.f;
#pragma nounroll
        for (int o = 0; o < 16; ++o) { float s = 0.f;
#pragma unroll
            for (int j = 0; j < 4; ++j) { const f32x4 w = *(const LAS f32x4*)(wl + o * D + 256 * j + 4 * lane); s += (v[j][0] * w[0] + v[j][1] * w[1]) + (v[j][2] * w[2] + v[j][3] * w[3]); }
            s = wave_sum(s, lane); mine = (lane == o) ? s : mine; }
        if (lane < 16) DT[(size_t)row * 16 + lane] = softplus_f(mine * rstd + dt_bias[lane]);
    }
    __syncthreads();
}
__device__ __forceinline__ void final_phase(const float* H, const float* w, float* out, int lane, int wave, int bid, int G, const int* diag = nullptr) {
    const int gw = bid * NWAVES + wave, NGW = G * NWAVES;
    for (int row = gw; row < T; row += NGW) { f32x4 v[4]; const float rstd = load_row_rstd(H + (size_t)row * D, lane, v);
        f32x4* o = (f32x4*)(out + (size_t)row * D) + lane; const f32x4* wv = (const f32x4*)w + lane;
#pragma unroll
        for (int j = 0; j < 4; ++j) o[64 * j] = v[j] * rstd * wv[64 * j] * ((EXP_PROBE || EXP_TIMING || EXP_MIXTIME) ? (float)(1 + diag[0]) : 1.0f); }
}

__device__ __forceinline__ void conv_phase(const bf16* PROJ, const float* cw, const float* cb, bf16* XBC, int tid, int bid, int G) {
    const size_t gt = (size_t)bid * NTHR + tid, NT = (size_t)G * NTHR;
    for (size_t idx = gt; idx < (size_t)T * 128; idx += NT) {
        const int t = (int)(idx >> 7), c = 8 * (int)(idx & 127), s = t & (SEQ - 1);
        float acc[8]; { const f32x4 b0 = *(const f32x4*)(cb + c), b1 = *(const f32x4*)(cb + c + 4); acc[0] = b0[0]; acc[1] = b0[1]; acc[2] = b0[2]; acc[3] = b0[3]; acc[4] = b1[0]; acc[5] = b1[1]; acc[6] = b1[2]; acc[7] = b1[3]; }
#pragma unroll
        for (int w = 0; w < 5; ++w) { const int ts = s + w - 2;
            if (ts >= 0 && ts < SEQ) { const v4u x = *(const v4u*)(PROJ + (size_t)(t + w - 2) * EINP + 3072 + c); const f32x4 k0 = *(const f32x4*)(cw + w * M2XBC + c), k1 = *(const f32x4*)(cw + w * M2XBC + c + 4);
                acc[0] += bflo(x.x) * k0[0]; acc[1] += bfhi(x.x) * k0[1]; acc[2] += bflo(x.y) * k0[2]; acc[3] += bfhi(x.y) * k0[3];
                acc[4] += bflo(x.z) * k1[0]; acc[5] += bfhi(x.z) * k1[1]; acc[6] += bflo(x.w) * k1[2]; acc[7] += bfhi(x.w) * k1[3]; } }
        v4u o; o.x = pk2(silu_f(acc[0]), silu_f(acc[1])); o.y = pk2(silu_f(acc[2]), silu_f(acc[3])); o.z = pk2(silu_f(acc[4]), silu_f(acc[5])); o.w = pk2(silu_f(acc[6]), silu_f(acc[7]));
        *(v4u*)(XBC + (size_t)t * M2XBC + c) = o;
    }
}
constexpr int TB = 16;
template <int MODE>
__device__ __forceinline__ void scan_item(int item, const bf16* PROJ, const bf16* XBC, const float* DT, const float* lbv  , const float* a_log  , float* OUT  , LAS unsigned char* lds, int tid) {
    LAS float* qs = (LAS float*)lds;
    LAS float* fs = qs + 2 * TB * 128;
    LAS float* ks = fs + 2 * TB * 128;
    LAS float* vs = ks + 2 * TB * 128;
    LAS float* sc = vs + 2 * TB * 32;
    LAS float* op = sc + 2 * TB * 2;
    const int part = MODE == 0 ? (item & 3) : (item & 1), dir = MODE == 0 ? ((item >> 2) & 1) : ((item >> 1) & 1), head = MODE == 0 ? ((item >> 3) & 3) : ((item >> 2) & 7), b = item >> 5;
    const int vv = tid & 31, dg = tid >> 5;
    const int si = tid >> 5, seg = tid & 31;
    const int colq = MODE == 0 ? head * 128 + 4 * seg : 3072 + 768 + (head >> 2) * 128 + 4 * seg;
    const int colf = MODE == 0 ? (dir == 0 ? 512 : 1024) + head * 128 + 4 * seg : 3072 + 512 + (head >> 2) * 128 + 4 * seg;
    const int colv = MODE == 0 ? 1536 + head * 128 + part * 32 + seg : 3072 + head * 64 + part * 32 + seg;
    float lb4[4] = {0.f, 0.f, 0.f, 0.f}; float Aneg = 0.f;
    if (MODE == 0) {
#pragma unroll
        for (int e = 0; e < 4; ++e) lb4[e] = lbv[head * 128 + 4 * seg + e];
    } else Aneg = -expf(a_log[dir * 8 + head]);
    float S[8];
#pragma unroll
    for (int e = 0; e < 8; ++e) S[e] = 0.f;
    constexpr int NBLK = SEQ / TB;
    v2u rq, rf; bf16 rv; float rdt = 0.f;
#define SCAN_TROW(blk, i) ((size_t)b * SEQ + (dir == 0 ? ((blk) * TB + (i)) : (SEQ - 1 - ((blk) * TB + (i)))))
#define SCAN_LOAD(blk) do { const size_t tr = SCAN_TROW(blk, si); \
        if (MODE == 0) { rq = *(const v2u*)(PROJ + tr * EINP + colq); rf = *(const v2u*)(PROJ + tr * EINP + colf); rv = PROJ[tr * EINP + colv]; } \
        else { rq = *(const v2u*)(XBC + tr * M2XBC + (colq - 3072)); rf = *(const v2u*)(XBC + tr * M2XBC + (colf - 3072)); rv = XBC[tr * M2XBC + (colv - 3072)]; if (seg == 0) rdt = DT[tr * 16 + dir * 8 + head]; } } while (0)
#define SCAN_STAGE(buf) do { const int o4 = ((buf) * TB + si) * 128 + 4 * seg; \
        const float q0 = bflo(rq.x), q1 = bfhi(rq.x), q2 = bflo(rq.y), q3 = bfhi(rq.y), f0 = bflo(rf.x), f1 = bfhi(rf.x), f2 = bflo(rf.y), f3 = bfhi(rf.y); \
        if (MODE == 0) { const float g0 = sigm(f0), g1 = sigm(f1), g2 = sigm(f2), g3 = sigm(f3); \
            *(LAS f32x4*)(qs + o4) = (f32x4){silu_f(q0), silu_f(q1), silu_f(q2), silu_f(q3)}; \
            *(LAS f32x4*)(fs + o4) = (f32x4){fmaxf(lb4[0], 1e-30f) + (1.f - lb4[0]) * g0, fmaxf(lb4[1], 1e-30f) + (1.f - lb4[1]) * g1, fmaxf(lb4[2], 1e-30f) + (1.f - lb4[2]) * g2, fmaxf(lb4[3], 1e-30f) + (1.f - lb4[3]) * g3}; \
            *(LAS f32x4*)(ks + o4) = (f32x4){(1.f - lb4[0]) * (1.f - g0), (1.f - lb4[1]) * (1.f - g1), (1.f - lb4[2]) * (1.f - g2), (1.f - lb4[3]) * (1.f - g3)}; } \
        else { *(LAS f32x4*)(qs + o4) = (f32x4){q0, q1, q2, q3}; *(LAS f32x4*)(ks + o4) = (f32x4){f0, f1, f2, f3}; if (seg == 0) { sc[((buf) * TB + si) * 2] = __expf(rdt * Aneg); sc[((buf) * TB + si) * 2 + 1] = rdt; } } \
        vs[((buf) * TB + si) * 32 + seg] = bf1(rv); } while (0)
    SCAN_LOAD(0); SCAN_STAGE(0);
    __syncthreads();
    for (int blk = 0; blk < NBLK; ++blk) {
        const int cur = blk & 1;
        if (blk + 1 < NBLK) SCAN_LOAD(blk + 1);
#pragma unroll
        for (int i = 0; i < TB; ++i) {
            const int o8 = (cur * TB + i) * 128 + 8 * dg;
            const f32x4 qa = *(const LAS f32x4*)(qs + o8), qb = *(const LAS f32x4*)(qs + o8 + 4), ka = *(const LAS f32x4*)(ks + o8), kb = *(const LAS f32x4*)(ks + o8 + 4);
            const float vt = vs[(cur * TB + i) * 32 + vv];
            float acc = 0.f;
            if (MODE == 0) {
                const f32x4 fa = *(const LAS f32x4*)(fs + o8), fb = *(const LAS f32x4*)(fs + o8 + 4);
#pragma unroll
                for (int e = 0; e < 4; ++e) { S[e] = fa[e] * S[e] + ka[e] * vt; acc += qa[e] * S[e]; S[4 + e] = fb[e] * S[4 + e] + kb[e] * vt; acc += qb[e] * S[4 + e]; }
            } else {
                const float dec = sc[(cur * TB + i) * 2], dtx = sc[(cur * TB + i) * 2 + 1] * vt;
#pragma unroll
                for (int e = 0; e < 4; ++e) { S[e] = dec * S[e] + ka[e] * dtx; acc += qa[e] * S[e]; S[4 + e] = dec * S[4 + e] + kb[e] * dtx; acc += qb[e] * S[4 + e]; }
            }
            op[(i * 16 + dg) * 32 + vv] = acc;
        }
        __syncthreads();
        { float s = 0.f;
#pragma unroll
          for (int g = 0; g < 16; ++g) s += op[(si * 16 + g) * 32 + seg];
          const size_t tr = SCAN_TROW(blk, si);
          OUT[((size_t)dir * T + tr) * 512 + (MODE == 0 ? head * 128 + part * 32 : head * 64 + part * 32) + seg] = s; }
        if (blk + 1 < NBLK) SCAN_STAGE(cur ^ 1);
        __syncthreads();
    }
#undef SCAN_TROW
#undef SCAN_LOAD
#undef SCAN_STAGE
}
__device__ __forceinline__ void combine_even_phase(const bf16* PROJ, const bf16* XBC, const float* OA, const float* YA, const float* hg_nw, const float* m2_d, const float* m2_nw, bf16* MIX, int lane, int wave, int bid, int G) {
    const int gw = bid * NWAVES + wave, NGW = G * NWAVES, c0 = 8 * lane;
    for (int row = gw; row < T; row += NGW) {
        float o[8], y[8];
        { const f32x4 a0 = *(const f32x4*)(OA + (size_t)row * 512 + c0), a1 = *(const f32x4*)(OA + (size_t)row * 512 + c0 + 4), b0 = *(const f32x4*)(OA + ((size_t)T + row) * 512 + c0), b1 = *(const f32x4*)(OA + ((size_t)T + row) * 512 + c0 + 4);
#pragma unroll
          for (int e = 0; e < 4; ++e) { o[e] = a0[e] + b0[e]; o[4 + e] = a1[e] + b1[e]; } }
        float ss = 0.f;
#pragma unroll
        for (int e = 0; e < 8; ++e) ss += o[e] * o[e];
        ss += sx(ss, 1, lane); ss += sx(ss, 2, lane); ss += sx(ss, 4, lane); ss += sx(ss, 8, lane);
        const float r1 = 1.0f / sqrtf(ss * (1.0f / 128.0f) + EPS);
        { const v4u g = *(const v4u*)(PROJ + (size_t)row * EINP + 2048 + c0); const f32x4 w0 = *(const f32x4*)(hg_nw + c0), w1 = *(const f32x4*)(hg_nw + c0 + 4);
          const float gg[8] = {bflo(g.x), bfhi(g.x), bflo(g.y), bfhi(g.y), bflo(g.z), bfhi(g.z), bflo(g.w), bfhi(g.w)}; const float ww[8] = {w0[0], w0[1], w0[2], w0[3], w1[0], w1[1], w1[2], w1[3]};
#pragma unroll
          for (int e = 0; e < 8; ++e) o[e] = o[e] * r1 * ww[e] * sigm(gg[e]) * (float)(1 - EXP_ZERO_HG);
          v4u w; w.x = pk2(o[0], o[1]); w.y = pk2(o[2], o[3]); w.z = pk2(o[4], o[5]); w.w = pk2(o[6], o[7]); *(v4u*)(MIX + (size_t)row * D + c0) = w; }
        { const f32x4 a0 = *(const f32x4*)(YA + (size_t)row * 512 + c0), a1 = *(const f32x4*)(YA + (size_t)row * 512 + c0 + 4), b0 = *(const f32x4*)(YA + ((size_t)T + row) * 512 + c0), b1 = *(const f32x4*)(YA + ((size_t)T + row) * 512 + c0 + 4);
          const v4u x = *(const v4u*)(XBC + (size_t)row * M2XBC + c0), z = *(const v4u*)(PROJ + (size_t)row * EINP + 2560 + c0); const float dsk = m2_d[lane >> 3];
          const float xx[8] = {bflo(x.x), bfhi(x.x), bflo(x.y), bfhi(x.y), bflo(x.z), bfhi(x.z), bflo(x.w), bfhi(x.w)}; const float zz[8] = {bflo(z.x), bfhi(z.x), bflo(z.y), bfhi(z.y), bflo(z.z), bfhi(z.z), bflo(z.w), bfhi(z.w)};
#pragma unroll
          for (int e = 0; e < 4; ++e) { y[e] = (a0[e] + b0[e] + dsk * xx[e]) * silu_f(zz[e]); y[4 + e] = (a1[e] + b1[e] + dsk * xx[4 + e]) * silu_f(zz[4 + e]); } }
        float s2 = 0.f;
#pragma unroll
        for (int e = 0; e < 8; ++e) s2 += y[e] * y[e];
        s2 += sx(s2, 1, lane); s2 += sx(s2, 2, lane); s2 += sx(s2, 4, lane); s2 += sx(s2, 8, lane); s2 += sx(s2, 16, lane);
        const float r2 = 1.0f / sqrtf(s2 * (1.0f / 256.0f) + EPS);
        { const f32x4 w0 = *(const f32x4*)(m2_nw + c0), w1 = *(const f32x4*)(m2_nw + c0 + 4);
          if (EXP_ZERO_SSD) { for (int e = 0; e < 8; ++e) y[e] = 0.f; }
          v4u w; w.x = pk2(y[0] * r2 * w0[0], y[1] * r2 * w0[1]); w.y = pk2(y[2] * r2 * w0[2], y[3] * r2 * w0[3]); w.z = pk2(y[4] * r2 * w1[0], y[5] * r2 * w1[1]); w.w = pk2(y[6] * r2 * w1[2], y[7] * r2 * w1[3]);
          *(v4u*)(MIX + (size_t)row * D + 512 + c0) = w; }
    }
}

constexpr int MX_TD = 136, MX_SS = 72;
constexpr int MX_QT = 0, MX_KT = MX_QT + 64 * MX_TD * 2, MX_QH = MX_KT + 64 * MX_TD * 2, MX_KHT = MX_QH + 64 * MX_TD * 2, MX_VT = MX_KHT + 128 * MX_SS * 2, MX_VHT = MX_VT + 128 * MX_SS * 2;
constexpr int MX_F32 = MX_VHT + 128 * MX_SS * 2;
constexpr int MX_BS = 132;
static_assert(MX_VHT + (64 * MX_BS + 4 * 128 + 128) * 4 <= RING_BYTES && MX_F32 + 256 * 4 <= RING_BYTES, "mixer LDS map");
typedef short mx_bf16x8 __attribute__((ext_vector_type(8)));
typedef short mx_bf16x4 __attribute__((ext_vector_type(4)));
typedef float mx_f32x16 __attribute__((ext_vector_type(16)));
__device__ __forceinline__ mx_bf16x8 mx_pack8(const mx_f32x16& a, int base) {
    v4u w; w.x = pk2(a[base + 0], a[base + 1]); w.y = pk2(a[base + 2], a[base + 3]); w.z = pk2(a[base + 4], a[base + 5]); w.w = pk2(a[base + 6], a[base + 7]);
    return __builtin_bit_cast(mx_bf16x8, w);
}
__device__ __forceinline__ mx_bf16x8 mx_ld_perm(const LAS bf16* row, int k0, int h) {
    const v2u lo = *(const LAS v2u*)(row + k0 + 4 * h), hi = *(const LAS v2u*)(row + k0 + 8 + 4 * h);
    return __builtin_bit_cast(mx_bf16x8, (v4u){lo.x, lo.y, hi.x, hi.y});
}
template <int MODE>
__device__ __forceinline__ void mix_item(int item, const bf16* PROJ, const bf16* XBC, const float* DT, const float* lbv  , const float* a_log  , float* OUT  , LAS unsigned char* lds, int tid_unused, int lane, int wave, unsigned long long* tw = nullptr) {
    asm volatile("" : "+v"(lane));
    const int tid = wave * 64 + lane;
    const int dir = item & 1, hx = (item >> 1) & 3, b = item >> 3;
    LAS bf16* Qt = (LAS bf16*)(lds + MX_QT); LAS bf16* Kt = (LAS bf16*)(lds + MX_KT); LAS bf16* Qh = (LAS bf16*)(lds + MX_QH);
    LAS bf16* KhT = (LAS bf16*)(lds + MX_KHT); LAS bf16* VT = (LAS bf16*)(lds + MX_VT); LAS bf16* VhT = (LAS bf16*)(lds + MX_VHT);
    LAS float* bloc = (LAS float*)(lds + MX_VHT);
    LAS float* qsum = bloc + 64 * MX_BS;
    LAS float* lam = qsum + 4 * 128;
    LAS float* s_da = (LAS float*)(lds + MX_F32);
    LAS float* s_dt = s_da + 128;
    const int vs = wave & 3, tb = wave >> 2, l31 = lane & 31, lh = lane >> 5;
    mx_f32x16 Sacc[4];
#pragma unroll
    for (int db = 0; db < 4; ++db)
#pragma unroll
        for (int e = 0; e < 16; ++e) Sacc[db][e] = 0.f;
    float Aneg[2] = {0.f, 0.f};
    if (MODE == 1) { Aneg[0] = -expf(a_log[dir * 8 + 2 * hx]); Aneg[1] = -expf(a_log[dir * 8 + 2 * hx + 1]); }
#define MX_TOK(c, t) ((size_t)b * SEQ + (dir == 0 ? (64 * (c) + (t)) : (SEQ - 1 - (64 * (c) + (t)))))
#if EXP_MIXTIME
#define MXT(k) do { if (tw && blockIdx.x == 0 && tid == 0) { const unsigned long long now_ = wall_clock64(); tw[k] += now_ - tlast_; tlast_ = now_; } } while (0)
    unsigned long long tlast_ = wall_clock64();
#else
#define MXT(k) do { } while (0)
#endif
    for (int c = 0; c < SEQ / 64; ++c) {
#pragma unroll
        for (int u = 0; u < 2; ++u) {
            const int pi = tid + 512 * u, t = pi >> 4, d0 = 8 * (pi & 15); const size_t tok = MX_TOK(c, t);
            if (MODE == 0) {
                const v4u qv = *(const v4u*)(PROJ + tok * EINP + hx * 128 + d0), fv = *(const v4u*)(PROJ + tok * EINP + (dir == 0 ? 512 : 1024) + hx * 128 + d0), vv = *(const v4u*)(PROJ + tok * EINP + 1536 + hx * 128 + d0);
                const unsigned qw[4] = {qv.x, qv.y, qv.z, qv.w}, fw[4] = {fv.x, fv.y, fv.z, fv.w}, vw[4] = {vv.x, vv.y, vv.z, vv.w};
                float lf[8], qq[8], kk[8];
#pragma unroll
                for (int e = 0; e < 8; ++e) { const float qp = (e & 1) ? bfhi(qw[e >> 1]) : bflo(qw[e >> 1]), fp = (e & 1) ? bfhi(fw[e >> 1]) : bflo(fw[e >> 1]); const float lbe = lbv[hx * 128 + d0 + e];
                    const float sg = sigm(fp), f = fmaxf(lbe, 1e-30f) + (1.f - lbe) * sg; qq[e] = silu_f(qp); kk[e] = (1.f - lbe) * (1.f - sg); lf[e] = __logf(f);
                    VT[(d0 + e) * MX_SS + t] = (bf16)((e & 1) ? (vw[e >> 1] >> 16) : (vw[e >> 1] & 0xffffu)); }
                *(LAS f32x4*)(bloc + t * MX_BS + d0) = (f32x4){lf[0], lf[1], lf[2], lf[3]}; *(LAS f32x4*)(bloc + t * MX_BS + d0 + 4) = (f32x4){lf[4], lf[5], lf[6], lf[7]};
                *(LAS v4u*)(Qt + t * MX_TD + d0) = (v4u){pk2(qq[0], qq[1]), pk2(qq[2], qq[3]), pk2(qq[4], qq[5]), pk2(qq[6], qq[7])};
                *(LAS v4u*)(Kt + t * MX_TD + d0) = (v4u){pk2(kk[0], kk[1]), pk2(kk[2], kk[3]), pk2(kk[4], kk[5]), pk2(kk[6], kk[7])};
            } else {
                const int grp = hx >> 1;
                const v4u cv = *(const v4u*)(XBC + tok * M2XBC + 768 + grp * 128 + d0), bv = *(const v4u*)(XBC + tok * M2XBC + 512 + grp * 128 + d0), xv = *(const v4u*)(XBC + tok * M2XBC + hx * 128 + d0);
                *(LAS v4u*)(Qt + t * MX_TD + d0) = cv; *(LAS v4u*)(Kt + t * MX_TD + d0) = bv;
                const unsigned bw[4] = {bv.x, bv.y, bv.z, bv.w}, xw[4] = {xv.x, xv.y, xv.z, xv.w};
#pragma unroll
                for (int e = 0; e < 8; ++e) { const unsigned bb = (e & 1) ? (bw[e >> 1] >> 16) : (bw[e >> 1] & 0xffffu), xx = (e & 1) ? (xw[e >> 1] >> 16) : (xw[e >> 1] & 0xffffu);
                    KhT[(d0 + e) * MX_SS + t] = (bf16)bb; VT[(d0 + e) * MX_SS + t] = (bf16)xx; }
            }
        }
        if (MODE == 1 && tid < 128) { const int hh = tid >> 6, t = tid & 63; const float dt = DT[MX_TOK(c, t) * 16 + dir * 8 + 2 * hx + hh]; s_da[hh * 64 + t] = dt * Aneg[hh]; s_dt[hh * 64 + t] = dt; }
        __syncthreads(); MXT(0);
        if (MODE == 0) { const int d = tid & 127, tq = tid >> 7; float run = 0.f;
#pragma unroll
            for (int i = 0; i < 16; ++i) { run += bloc[(16 * tq + i) * MX_BS + d]; bloc[(16 * tq + i) * MX_BS + d] = run; }
            qsum[tq * 128 + d] = run;
        } else if (wave < 2) { float v = s_da[wave * 64 + lane];
#pragma unroll
            for (int o = 1; o < 64; o <<= 1) { const float up = __builtin_bit_cast(float, __builtin_amdgcn_ds_bpermute((lane - o) << 2, __builtin_bit_cast(int, v))); if (lane >= o) v += up; }
            s_da[wave * 64 + lane] = v; }
        __syncthreads(); MXT(1);
#pragma unroll
        for (int u = 0; u < 2; ++u) {
            const int pi = tid + 512 * u, t = pi >> 4, d0 = 8 * (pi & 15);
            if (MODE == 0) {
                float bt[8], br[8], be[8];
#pragma unroll
                for (int hf = 0; hf < 2; ++hf) { const int dd = d0 + 4 * hf;
                    const f32x4 q0 = *(const LAS f32x4*)(qsum + dd), q1 = *(const LAS f32x4*)(qsum + 128 + dd), q2 = *(const LAS f32x4*)(qsum + 256 + dd);
                    const f32x4 x = *(const LAS f32x4*)(bloc + t * MX_BS + dd), r = *(const LAS f32x4*)(bloc + 31 * MX_BS + dd), en = *(const LAS f32x4*)(bloc + 63 * MX_BS + dd);
#pragma unroll
                    for (int e = 0; e < 4; ++e) { bt[4 * hf + e] = x[e] + (t >= 16 ? q0[e] : 0.f) + (t >= 32 ? q1[e] : 0.f) + (t >= 48 ? q2[e] : 0.f); br[4 * hf + e] = r[e] + q0[e]; be[4 * hf + e] = en[e] + q0[e] + q1[e] + q2[e]; } }
                float o1[8], o2[8], o3[8];
                const v4u qv = *(const LAS v4u*)(Qt + t * MX_TD + d0), kv = *(const LAS v4u*)(Kt + t * MX_TD + d0); const unsigned qw[4] = {qv.x, qv.y, qv.z, qv.w}, kw[4] = {kv.x, kv.y, kv.z, kv.w};
#pragma unroll
                for (int e = 0; e < 8; ++e) { const float q = (e & 1) ? bfhi(qw[e >> 1]) : bflo(qw[e >> 1]), k = (e & 1) ? bfhi(kw[e >> 1]) : bflo(kw[e >> 1]); o1[e] = q * __expf(bt[e] - br[e]); o2[e] = k * __expf(br[e] - bt[e]); o3[e] = q * __expf(bt[e]);
                    KhT[(d0 + e) * MX_SS + t] = (bf16)f2bf(k * __expf(be[e] - bt[e])); }
                *(LAS v4u*)(Qt + t * MX_TD + d0) = (v4u){pk2(o1[0], o1[1]), pk2(o1[2], o1[3]), pk2(o1[4], o1[5]), pk2(o1[6], o1[7])};
                *(LAS v4u*)(Kt + t * MX_TD + d0) = (v4u){pk2(o2[0], o2[1]), pk2(o2[2], o2[3]), pk2(o2[4], o2[5]), pk2(o2[6], o2[7])};
                *(LAS v4u*)(Qh + t * MX_TD + d0) = (v4u){pk2(o3[0], o3[1]), pk2(o3[2], o3[3]), pk2(o3[4], o3[5]), pk2(o3[6], o3[7])};
                if (t == 0) { *(LAS f32x4*)(lam + d0) = (f32x4){__expf(be[0]), __expf(be[1]), __expf(be[2]), __expf(be[3])}; *(LAS f32x4*)(lam + d0 + 4) = (f32x4){__expf(be[4]), __expf(be[5]), __expf(be[6]), __expf(be[7])}; }
            } else {
                const int hh = d0 >> 6; const float w = s_dt[hh * 64 + t] * __expf(s_da[hh * 64 + 63] - s_da[hh * 64 + t]);
                const v4u xv = *(const v4u*)(XBC + MX_TOK(c, t) * M2XBC + hx * 128 + d0); const unsigned xw[4] = {xv.x, xv.y, xv.z, xv.w};
#pragma unroll
                for (int e = 0; e < 8; ++e) VhT[(d0 + e) * MX_SS + t] = (bf16)f2bf(((e & 1) ? bfhi(xw[e >> 1]) : bflo(xw[e >> 1])) * w);
            }
        }
        __syncthreads(); MXT(2);
        {
            mx_f32x16 acc;
#pragma unroll
            for (int e = 0; e < 16; ++e) acc[e] = 0.f;
            const LAS bf16* qrow = (MODE == 0 ? Qh : Qt) + (32 * tb + l31) * MX_TD;
#pragma unroll
            for (int db = 0; db < 4; ++db)
#pragma unroll
                for (int s2 = 0; s2 < 2; ++s2) acc = __builtin_amdgcn_mfma_f32_32x32x16_bf16(mx_pack8(Sacc[db], 8 * s2), mx_ld_perm(qrow, 32 * db + 16 * s2, lh), acc, 0, 0, 0);
            const int hh = vs >> 1;
            float acum_t = 0.f;
            if (MODE == 1) { acum_t = s_da[hh * 64 + 32 * tb + l31]; const float sc = __expf(acum_t);
#pragma unroll
                for (int e = 0; e < 16; ++e) acc[e] *= sc; }
            for (int sb = 0; sb <= tb; ++sb) {
                mx_f32x16 accP;
#pragma unroll
                for (int e = 0; e < 16; ++e) accP[e] = 0.f;
                const LAS bf16* krow = Kt + (32 * sb + l31) * MX_TD; const LAS bf16* q2row = Qt + (32 * tb + l31) * MX_TD;
#pragma unroll
                for (int ks = 0; ks < 8; ++ks) accP = __builtin_amdgcn_mfma_f32_32x32x16_bf16(*(const LAS mx_bf16x8*)(krow + 16 * ks + 8 * lh), *(const LAS mx_bf16x8*)(q2row + 16 * ks + 8 * lh), accP, 0, 0, 0);
#pragma unroll
                for (int i = 0; i < 4; ++i) {
                    f32x4 as4 = (f32x4){0.f, 0.f, 0.f, 0.f}, ds4 = (f32x4){1.f, 1.f, 1.f, 1.f};
                    if (MODE == 1) { as4 = *(const LAS f32x4*)(s_da + hh * 64 + 32 * sb + 8 * i + 4 * lh); ds4 = *(const LAS f32x4*)(s_dt + hh * 64 + 32 * sb + 8 * i + 4 * lh); }
#pragma unroll
                    for (int e = 0; e < 4; ++e) { const int sl = 8 * i + 4 * lh + e; float p = accP[4 * i + e];
                        if (MODE == 1) p *= __expf(fminf(acum_t - as4[e], 0.f)) * ds4[e];
                        accP[4 * i + e] = (sb < tb || sl <= l31) ? p : 0.f; }
                    if (MODE == 1) asm volatile("" ::: "memory");
                }
                const LAS bf16* vrow = VT + (32 * vs + l31) * MX_SS;
#pragma unroll
                for (int s2 = 0; s2 < 2; ++s2) acc = __builtin_amdgcn_mfma_f32_32x32x16_bf16(mx_ld_perm(vrow, 32 * sb + 16 * s2, lh), mx_pack8(accP, 8 * s2), acc, 0, 0, 0);
            }
            { const size_t tok = MX_TOK(c, 32 * tb + l31); float* orow = OUT + ((size_t)dir * T + tok) * 512 + hx * 128 + 32 * vs + 4 * lh;
#pragma unroll
              for (int i = 0; i < 4; ++i) *(f32x4*)(orow + 8 * i) = (f32x4){acc[4 * i], acc[4 * i + 1], acc[4 * i + 2], acc[4 * i + 3]}; }
            const LAS bf16* vhrow = (MODE == 0 ? VT : VhT) + (32 * vs + l31) * MX_SS;
            const float lamh = (MODE == 1) ? __expf(s_da[hh * 64 + 63]) : 0.f;
#pragma unroll
            for (int db = 0; db < 4; ++db) {
                if (MODE == 0) {
#pragma unroll
                    for (int i = 0; i < 4; ++i) { const f32x4 lm = *(const LAS f32x4*)(lam + 32 * db + 8 * i + 4 * lh);
#pragma unroll
                        for (int e = 0; e < 4; ++e) Sacc[db][4 * i + e] *= lm[e]; }
                } else {
#pragma unroll
                    for (int e = 0; e < 16; ++e) Sacc[db][e] *= lamh;
                }
                const LAS bf16* khrow = KhT + (32 * db + l31) * MX_SS;
#pragma unroll
                for (int ks = 0; ks < 4; ++ks) Sacc[db] = __builtin_amdgcn_mfma_f32_32x32x16_bf16(*(const LAS mx_bf16x8*)(khrow + 16 * ks + 8 * lh), *(const LAS mx_bf16x8*)(vhrow + 16 * ks + 8 * lh), Sacc[db], 0, 0, 0);
            }
        }
        __syncthreads(); MXT(3);
    }
#undef MX_TOK
#undef MXT
}

__device__ __forceinline__ void s5_item(int item, int j, const Args& a, const float* nw  , const bf16* HN, float* YS  , int lane) {
    const int dir = item & 1, g = (item >> 1) & 63, b = item >> 7, n = lane;
    const size_t pg = ((size_t)(j * 2 + dir) * S5G + g);
    const float a_re = a.in[I_S5_A_RE][pg * S5N + n], a_im = a.in[I_S5_A_IM][pg * S5N + n];
    const float delta = expf(a.in[I_S5_LOG_STEP][pg]);
    const float mag = expf(a_re * delta); float sn, cs; sincosf(a_im * delta, &sn, &cs);
    const float lam_re = mag * cs, lam_im = mag * sn;
    const float den = a_re * a_re + a_im * a_im, num_re = lam_re - 1.0f;
    const float coef_re = (num_re * a_re + lam_im * a_im) / den, coef_im = (lam_im * a_re - num_re * a_im) / den;
    float bbr[16], bbi[16], cr[16], ci[16];
#pragma unroll
    for (int c = 0; c < 16; ++c) {
        const size_t bi_ = (((size_t)j * S5G + g) * S5N + n) * S5C + c;
        const float br = a.in[I_S5_B_RE][bi_], bi = a.in[I_S5_B_IM][bi_], w = nw[g * 16 + c];
        bbr[c] = (coef_re * br - coef_im * bi) * w; bbi[c] = (coef_re * bi + coef_im * br) * w;
        const size_t ci_ = (pg * S5C + c) * S5N + n;
        cr[c] = a.in[I_S5_C_RE][ci_]; ci[c] = a.in[I_S5_C_IM][ci_];
    }
    float hr = 0.f, hi = 0.f;
    for (int blk = 0; blk < SEQ / 64; ++blk) {
        const size_t tl = (size_t)b * SEQ + (dir == 0 ? (blk * 64 + lane) : (SEQ - 1 - (blk * 64 + lane)));
        const v4u u0 = *(const v4u*)(HN + tl * D + g * 16), u1 = *(const v4u*)(HN + tl * D + g * 16 + 8);
        const float uv[16] = {bflo(u0.x), bfhi(u0.x), bflo(u0.y), bfhi(u0.y), bflo(u0.z), bfhi(u0.z), bflo(u0.w), bfhi(u0.w), bflo(u1.x), bfhi(u1.x), bflo(u1.y), bfhi(u1.y), bflo(u1.z), bfhi(u1.z), bflo(u1.w), bfhi(u1.w)};
        for (int i = 0; i < 64; ++i) {
            float bur = 0.f, bui = 0.f;
#pragma unroll
            for (int c = 0; c < 16; ++c) { const float u = __builtin_bit_cast(float, __builtin_amdgcn_readlane(__builtin_bit_cast(int, uv[c]), i)); bur += bbr[c] * u; bui += bbi[c] * u; }
            const float nhr = lam_re * hr - lam_im * hi + bur, nhi = lam_re * hi + lam_im * hr + bui; hr = nhr; hi = nhi;
            float y[16];
#pragma unroll
            for (int c = 0; c < 16; ++c) y[c] = cr[c] * hr - ci[c] * hi;
            const bool b5 = (lane & 32) != 0, b4 = (lane & 16) != 0, b3 = (lane & 8) != 0, b2 = (lane & 4) != 0;
            float a8[8], a4[4], a2[2], a1;
#pragma unroll
            for (int k = 0; k < 8; ++k) { const float send = b5 ? y[k] : y[k + 8], keep = b5 ? y[k + 8] : y[k]; a8[k] = keep + sx(send, 32, lane); }
#pragma unroll
            for (int k = 0; k < 4; ++k) { const float send = b4 ? a8[k] : a8[k + 4], keep = b4 ? a8[k + 4] : a8[k]; a4[k] = keep + sx(send, 16, lane); }
#pragma unroll
            for (int k = 0; k < 2; ++k) { const float send = b3 ? a4[k] : a4[k + 2], keep = b3 ? a4[k + 2] : a4[k]; a2[k] = keep + sx(send, 8, lane); }
            { const float send = b2 ? a2[0] : a2[1], keep = b2 ? a2[1] : a2[0]; a1 = keep + sx(send, 4, lane); }
            a1 += sx(a1, 2, lane); a1 += sx(a1, 1, lane);
            const size_t ti = (size_t)b * SEQ + (dir == 0 ? (blk * 64 + i) : (SEQ - 1 - (blk * 64 + i)));
            if ((lane & 3) == 0) YS[((size_t)dir * T + ti) * D + g * 16 + (lane >> 2)] = a1;
        }
    }
}

constexpr int S5_BUS = 36, S5_HS = 136, S5_WAVE_LDS = 128 * S5_BUS * 4 + 32 * S5_HS * 2;
typedef short s5_bf16x8 __attribute__((ext_vector_type(8)));
typedef float s5_f32x16 __attribute__((ext_vector_type(16)));
__device__ __forceinline__ void s5_item_mfma(int item, int j, const Args& a, const float* nw  , const bf16* HN, float* YS  , LAS unsigned char* wl, int lane) {
    const int dir = item & 1, g = (item >> 1) & 63, b = item >> 7;
    const size_t pg = ((size_t)(j * 2 + dir) * S5G + g);
    const float delta = expf(a.in[I_S5_LOG_STEP][pg]);
    LAS float* buT = (LAS float*)wl;
    LAS bf16* Hl = (LAS bf16*)(wl + 128 * S5_BUS * 4);
    float lam_re, lam_im;
    { const float a_re = a.in[I_S5_A_RE][pg * S5N + lane], a_im = a.in[I_S5_A_IM][pg * S5N + lane]; const float mag = expf(a_re * delta); float sn, cs; sincosf(a_im * delta, &sn, &cs); lam_re = mag * cs; lam_im = mag * sn; }
    s5_bf16x8 Bb[4];
    { const int col = lane & 31, h = lane >> 5;
#pragma unroll
      for (int q = 0; q < 4; ++q) { const int np = 32 * q + col, n = np & 63; const bool isIm = np >= 64;
          const float a_re = a.in[I_S5_A_RE][pg * S5N + n], a_im = a.in[I_S5_A_IM][pg * S5N + n]; const float mag = expf(a_re * delta); float sn, cs; sincosf(a_im * delta, &sn, &cs);
          const float lr = mag * cs, li = mag * sn, den = a_re * a_re + a_im * a_im, num_re = lr - 1.0f;
          const float coef_re = (num_re * a_re + li * a_im) / den, coef_im = (li * a_re - num_re * a_im) / den;
          unsigned w4[4];
#pragma unroll
          for (int jp = 0; jp < 4; ++jp) { float vv[2];
#pragma unroll
              for (int e = 0; e < 2; ++e) { const int c = 8 * h + 2 * jp + e; const size_t bi_ = (((size_t)j * S5G + g) * S5N + n) * S5C + c; const float br = a.in[I_S5_B_RE][bi_], bi = a.in[I_S5_B_IM][bi_];
                  vv[e] = (isIm ? (coef_re * bi + coef_im * br) : (coef_re * br - coef_im * bi)) * nw[g * 16 + c]; }
              w4[jp] = pk2(vv[0], vv[1]); }
          Bb[q] = __builtin_bit_cast(s5_bf16x8, (v4u){w4[0], w4[1], w4[2], w4[3]}); } }
    s5_bf16x8 Cb[4];
    { const int c = lane & 15, q4 = lane >> 4;
#pragma unroll
      for (int ks = 0; ks < 4; ++ks) { unsigned w4[4];
#pragma unroll
          for (int jp = 0; jp < 4; ++jp) { float vv[2];
#pragma unroll
              for (int e = 0; e < 2; ++e) { const int np = 32 * ks + 8 * q4 + 2 * jp + e, n = np & 63; const size_t ci_ = (pg * S5C + c) * S5N + n; vv[e] = np < 64 ? a.in[I_S5_C_RE][ci_] : -a.in[I_S5_C_IM][ci_]; }
              w4[jp] = pk2(vv[0], vv[1]); }
          Cb[ks] = __builtin_bit_cast(s5_bf16x8, (v4u){w4[0], w4[1], w4[2], w4[3]}); } }
    float hr = 0.f, hi = 0.f;
    const int ar = lane & 31, ah = lane >> 5;
#define S5_TOK(tile, r) ((size_t)b * SEQ + (dir == 0 ? (32 * (tile) + (r)) : (SEQ - 1 - (32 * (tile) + (r)))))
    v4u unext = *(const v4u*)(HN + S5_TOK(0, ar) * D + g * 16 + 8 * ah);
    for (int tile = 0; tile < SEQ / 32; ++tile) {
        const s5_bf16x8 Aop = __builtin_bit_cast(s5_bf16x8, unext);
        if (tile + 1 < SEQ / 32) unext = *(const v4u*)(HN + S5_TOK(tile + 1, ar) * D + g * 16 + 8 * ah);
#pragma unroll
        for (int q = 0; q < 4; ++q) { s5_f32x16 acc;
#pragma unroll
            for (int e = 0; e < 16; ++e) acc[e] = 0.f;
            acc = __builtin_amdgcn_mfma_f32_32x32x16_bf16(Aop, Bb[q], acc, 0, 0, 0);
#pragma unroll
            for (int i = 0; i < 4; ++i) *(LAS f32x4*)(buT + (32 * q + ar) * S5_BUS + 8 * i + 4 * ah) = (f32x4){acc[4 * i], acc[4 * i + 1], acc[4 * i + 2], acc[4 * i + 3]}; }
        LDS_WAIT();
#pragma unroll
        for (int k = 0; k < 8; ++k) { const f32x4 re4 = *(const LAS f32x4*)(buT + lane * S5_BUS + 4 * k), im4 = *(const LAS f32x4*)(buT + (64 + lane) * S5_BUS + 4 * k);
#pragma unroll
            for (int e = 0; e < 4; ++e) { const float nhr = lam_re * hr - lam_im * hi + re4[e], nhi = lam_re * hi + lam_im * hr + im4[e]; hr = nhr; hi = nhi;
                Hl[(4 * k + e) * S5_HS + lane] = (bf16)f2bf(hr); Hl[(4 * k + e) * S5_HS + 64 + lane] = (bf16)f2bf(hi); } }
        LDS_WAIT();
#pragma unroll
        for (int m = 0; m < 2; ++m) { f32x4 acc = (f32x4){0.f, 0.f, 0.f, 0.f};
#pragma unroll
            for (int ks = 0; ks < 4; ++ks) { const s5_bf16x8 A2 = *(const LAS s5_bf16x8*)(Hl + (16 * m + (lane & 15)) * S5_HS + 32 * ks + 8 * (lane >> 4)); acc = __builtin_amdgcn_mfma_f32_16x16x32_bf16(A2, Cb[ks], acc, 0, 0, 0); }
#pragma unroll
            for (int e = 0; e < 4; ++e) YS[((size_t)dir * T + S5_TOK(tile, 16 * m + 4 * (lane >> 4) + e)) * D + g * 16 + (lane & 15)] = acc[e]; }
        LDS_WAIT();
    }
#undef S5_TOK
}
__device__ __forceinline__ void combine_s5_phase(const float* H, const float* nw, const float* dsk, const float* YS, bf16* MIX, int lane, int wave, int bid, int G) {
    const int gw = bid * NWAVES + wave, NGW = G * NWAVES;
    for (int row = gw; row < T; row += NGW) {
        f32x4 v[4]; const float rstd = load_row_rstd(H + (size_t)row * D, lane, v);
        const f32x4* yf = (const f32x4*)(YS + (size_t)row * D) + lane; const f32x4* yb = (const f32x4*)(YS + ((size_t)T + row) * D) + lane;
        const f32x4* wv = (const f32x4*)nw + lane; const f32x4* dv = (const f32x4*)dsk + lane;
        unsigned long long* o8 = (unsigned long long*)(MIX + (size_t)row * D) + lane;
#pragma unroll
        for (int jj = 0; jj < 4; ++jj) { const f32x4 y = (yf[64 * jj] + yb[64 * jj]) * (float)(1 - EXP_ZERO_S5) + dv[64 * jj] * (v[jj] * rstd * wv[64 * jj]);
            o8[64 * jj] = (unsigned long long)pk2(gelu_tanh(y[0]), gelu_tanh(y[1])) | ((unsigned long long)pk2(gelu_tanh(y[2]), gelu_tanh(y[3])) << 32); }
    }
}
__device__ __forceinline__ void router_phase(const float* H, unsigned char* HN8, const float* wr  , v4i* SEL, float* GATE, int* CNT, LAS unsigned char* lds, int tid, int lane, int wave, int bid, int G) {
    LAS float* wl = (LAS float*)lds;
    LAS int* lcnt = (LAS int*)(lds + 32768);
    for (int i = tid; i < D * 8; i += NTHR) wl[(i & 7) * D + (i >> 3)] = wr[i];
    for (int grp = bid; grp < T / 64; grp += G) {
        if (tid < 8) lcnt[tid] = 0;
        __syncthreads();
        for (int r = 0; r < 8; ++r) {
            const int row = grp * 64 + wave * 8 + r;
            f32x4 v[4]; const float rstd = load_row_rstd(H + (size_t)row * D, lane, v); store_row_fp8(HN8 + (size_t)row * D, lane, v, rstd);
            float lg[8];
#pragma unroll
            for (int e = 0; e < 8; ++e) { float s = 0.f;
#pragma unroll
                for (int jj = 0; jj < 4; ++jj) { const f32x4 w = *(const LAS f32x4*)(wl + e * D + 256 * jj + 4 * lane); s += (v[jj][0] * w[0] + v[jj][1] * w[1]) + (v[jj][2] * w[2] + v[jj][3] * w[3]); }
                lg[e] = wave_sum(s, lane) * rstd; }
            int e0 = 0; float l0 = lg[0];
#pragma unroll
            for (int e = 1; e < 8; ++e) if (lg[e] > l0) { l0 = lg[e]; e0 = e; }
            int e1 = -1; float l1 = -3.0e38f;
#pragma unroll
            for (int e = 0; e < 8; ++e) if (e != e0 && lg[e] > l1) { l1 = lg[e]; e1 = e; }
            const float g1 = 1.0f / (1.0f + expf(l0 - l1)), g0 = 1.0f - g1;
            if (lane == 0) { SEL[row] = (v4i){e0, e1, __builtin_bit_cast(int, g0), __builtin_bit_cast(int, g1)}; GATE[(size_t)row * 2] = g0; GATE[(size_t)row * 2 + 1] = g1; atomicAdd((int*)&lcnt[e0], 1); atomicAdd((int*)&lcnt[e1], 1); }
        }
        __syncthreads();
        if (tid < 8) CNT[grp * 8 + tid] = lcnt[tid];
        __syncthreads();
    }
}
__device__ __forceinline__ void scatter_phase(const unsigned char* HN8, const v4i* SEL, const int* CNT, int* SLOT, int* SEGB, unsigned char* XBUF8, LAS unsigned char* lds, int tid, int lane, int wave, int bid, int G) {
    LAS int* ltot = (LAS int*)lds;
    LAS int* lbef = ltot + 8;
    LAS int* base = lbef + 8;
    LAS int* wcnt = base + 8;
    for (int grp = bid; grp < T / 64; grp += G) {
        if (tid < 16) ltot[tid] = 0;
        __syncthreads();
        { const int e = tid & 7, q = tid >> 3; int tot = 0, bef = 0;
#pragma unroll
          for (int k = 0; k < 4; ++k) { const int g2 = q + 64 * k; const int c = CNT[g2 * 8 + e]; tot += c; bef += (g2 < grp) ? c : 0; }
          atomicAdd((int*)&ltot[e], tot); atomicAdd((int*)&lbef[e], bef); }
        __syncthreads();
        if (tid == 0) { int sb = 0;
            for (int e = 0; e < 8; ++e) { base[e] = sb + lbef[e]; if (grp == 0) SEGB[e] = sb; sb += (ltot[e] + 255) & ~255; }
            if (grp == 0) SEGB[8] = sb; }
        const int r0 = grp * 64 + wave * 8;
        int myE = -1;
        if (lane < 16) { const v4i s = SEL[r0 + (lane >> 1)]; myE = (lane & 1) ? s[1] : s[0]; }
        int rank = 0, cntMine = 0;
#pragma unroll
        for (int e = 0; e < 8; ++e) { const unsigned long long m = __ballot(myE == e); const int c = __popcll(m); if (lane == e) cntMine = c; if (myE == e) rank = __popcll(m & ((1ull << lane) - 1ull)); }
        if (lane < 8) wcnt[wave * 8 + lane] = cntMine;
        __syncthreads();
        int slot = 0;
        if (lane < 16) { int pre = 0; for (int w = 0; w < wave; ++w) pre += wcnt[w * 8 + myE]; slot = base[myE] + pre + rank; SLOT[(size_t)(r0 + (lane >> 1)) * 2 + (lane & 1)] = slot; }
        for (int i = 0; i < 16; ++i) { const int sl = __builtin_amdgcn_readlane(slot, i); const int row = r0 + (i >> 1);
            const v4u* src = (const v4u*)(HN8 + (size_t)row * D); v4u* dst = (v4u*)(XBUF8 + (size_t)sl * D);
            dst[lane] = src[lane]; }
        __syncthreads();
    }
}

#if EXP_PROBE
__device__ __forceinline__ void probe_moe(const float* H, const float* nw, const float* router, const float* w_gu, const float* w_down, const v4i* SEL, const int* SLOT, const float* YBUF, int* diag,
                                          LAS unsigned char* lds, int tid, int lane, int wave, int bid) {
    LAS float* xt = (LAS float*)lds;
    LAS float* act = xt + 1024;
    LAS float* red = act + 3584;
    const int t = (bid * 61 + 7) & (T - 1);
    if (wave == 0) { f32x4 v[4]; const float rstd = load_row_rstd(H + (size_t)t * D, lane, v);
#pragma unroll
        for (int j = 0; j < 4; ++j) { const f32x4 w = ((const f32x4*)nw)[64 * j + lane]; *(LAS f32x4*)(xt + 256 * j + 4 * lane) = v[j] * rstd * w; } }
    __syncthreads();
    if (tid < 8) { float s = 0.f; for (int c = 0; c < D; ++c) s += xt[c] * router[c * 8 + tid]; red[tid] = s; }
    __syncthreads();
    int e0 = 0; float l0 = red[0];
    for (int e = 1; e < 8; ++e) if (red[e] > l0) { l0 = red[e]; e0 = e; }
    int e1 = -1; float l1 = -3.0e38f;
    for (int e = 0; e < 8; ++e) if (e != e0 && red[e] > l1) { l1 = red[e]; e1 = e; }
    const v4i sel = SEL[t];
    int code = 0;
    if (sel[0] != e0 || sel[1] != e1) code = 10;
    const float g1 = 1.0f / (1.0f + expf(l0 - l1)), g0 = 1.0f - g1;
    if (code == 0 && (fabsf(g0 - __builtin_bit_cast(float, sel[2])) > 1e-3f || fabsf(g1 - __builtin_bit_cast(float, sel[3])) > 1e-3f)) code = 9;
    __syncthreads();
    int cc[2] = {0, 0};
    for (int k = 0; k < 2; ++k) {
        const int e = k == 0 ? e0 : e1; const float* wg = w_gu + (size_t)e * D * 2 * FF; const float* wd = w_down + (size_t)e * FF * D;
        float ag[7], au[7];
        for (int q = 0; q < 7; ++q) { ag[q] = 0.f; au[q] = 0.f; }
        for (int c = 0; c < D; ++c) { const float x = xt[c];
#pragma unroll
            for (int q = 0; q < 7; ++q) { ag[q] += x * wg[(size_t)c * 2 * FF + tid + 512 * q]; au[q] += x * wg[(size_t)c * 2 * FF + FF + tid + 512 * q]; } }
#pragma unroll
        for (int q = 0; q < 7; ++q) act[tid + 512 * q] = ag[q] * sigm(ag[q]) * au[q];
        __syncthreads();
        float y0 = 0.f, y1 = 0.f;
        for (int f = 0; f < FF; ++f) { const float a = act[f]; y0 += a * wd[(size_t)f * D + tid]; y1 += a * wd[(size_t)f * D + 512 + tid]; }
        const int slot = SLOT[(size_t)t * 2 + k];
        const float m0 = YBUF[(size_t)slot * D + tid], m1 = YBUF[(size_t)slot * D + 512 + tid];
        float er = (m0 - y0) * (m0 - y0) + (m1 - y1) * (m1 - y1), rf = y0 * y0 + y1 * y1;
        er = wave_sum(er, lane); rf = wave_sum(rf, lane);
        __syncthreads();
        if (lane == 0) { red[16 + wave] = er; red[32 + wave] = rf; }
        __syncthreads();
        float E = 0.f, R = 0.f; for (int w = 0; w < 8; ++w) { E += red[16 + w]; R += red[32 + w]; }
        const float rel = E / (R + 1e-20f);
        cc[k] = rel < 1e-3f ? 0 : (rel < 0.1f ? 1 : 2);
        __syncthreads();
    }
    if (code == 0) code = cc[0] * 3 + cc[1];
    { const float sg0 = __builtin_bit_cast(float, sel[2]), sg1 = __builtin_bit_cast(float, sel[3]); int c2 = (int)(sg0 * 10.f); if (c2 < 0) c2 = 0; if (c2 > 12) c2 = 12;
      if (fabsf(sg0 + sg1 - 1.f) > 1e-3f) { int c3 = (int)((sg0 + sg1) * 5.f); if (c3 < 0) c3 = 0; if (c3 > 9) c3 = 9; c2 = 13 + c3; }
      code = c2; }
    if (tid == 0 && bid == 0) atomicMax(diag, code);
}
#endif
__device__ __forceinline__ void moe_combine_norm_phase(float* H, const float* YBUF, const float* GATE, const int* SLOT, bf16* HN, int lane, int wave, int bid, int G, const int* SEGBp = nullptr, int* diag = nullptr, float mscl = 1.f) {
    const int gw = bid * NWAVES + wave, NGW = G * NWAVES;
    for (int row = gw; row < T; row += NGW) {
        const int s0 = SLOT[(size_t)row * 2], s1 = SLOT[(size_t)row * 2 + 1]; const float g0 = GATE[(size_t)row * 2], g1 = GATE[(size_t)row * 2 + 1];
        f32x4* hr = (f32x4*)(H + (size_t)row * D) + lane; const f32x4* y0 = (const f32x4*)(YBUF + (size_t)s0 * D) + lane; const f32x4* y1 = (const f32x4*)(YBUF + (size_t)s1 * D) + lane;
        f32x4 v[4]; float ss = 0.f;
#pragma unroll
        for (int jj = 0; jj < 4; ++jj) { v[jj] = hr[64 * jj] + (g0 * y0[64 * jj] + g1 * y1[64 * jj]) * mscl; hr[64 * jj] = v[jj]; ss += (v[jj][0] * v[jj][0] + v[jj][1] * v[jj][1]) + (v[jj][2] * v[jj][2] + v[jj][3] * v[jj][3]); }
        const float rstd = 1.0f / sqrtf(wave_sum(ss, lane) * (1.0f / D) + EPS);
        store_row_bf16(HN + (size_t)row * D, lane, v, rstd);
    }
}

#ifndef MK_ONE_LAUNCH
#define MK_ONE_LAUNCH 1
#endif
constexpr int PH_PER_LAYER = 11, PH_LAYER0 = 2, N_PHASES = PH_LAYER0 + 4 * PH_PER_LAYER + 1;

#define H ((float*)(ws + WS_H))
#define HN ((bf16*)(ws + WS_HN))
#define MIX ((bf16*)(ws + WS_MIX))
#define PB ((bf16*)(ws + WS_PB))
#define PP ((bf16*)(ws + WS_PP))
#define XBUF ((bf16*)(ws + WS_XBUF))
#define YBUF ((float*)(ws + WS_YBUF))
#define DT ((float*)(ws + WS_DT))
#define SEL ((v4i*)(ws + WS_ROUTE))
#define SLOT ((int*)(ws + WS_ROUTE + 256 * 1024))
#define GATE ((float*)(ws + WS_ROUTE + 512 * 1024))
#define CNT ((int*)(ws + WS_ROUTE + 384 * 1024))
#define SEGB ((int*)(ws + WS_ROUTE + 400 * 1024))
#define PROJ ((bf16*)(ws + WS_PROJ))
#define XBC ((bf16*)(ws + WS_XBC))
#define OA ((float*)(ws + WS_OA))
#define YA ((float*)(ws + WS_YA))
#define ACT ((bf16*)(ws + WS_ACT))
#define YS ((float*)(ws + WS_YS))
__global__ void __launch_bounds__(NTHR, 2) fwd(Args args) {
    extern __shared__ __attribute__((aligned(16))) unsigned char lds_raw[];
    LAS unsigned char* lds = (LAS unsigned char*)lds_raw;
    volatile LAS unsigned* MISC = (volatile LAS unsigned*)(lds + MISC_OFF);
    const int G0 = gridDim.x, bid0 = blockIdx.x, wave_s = __builtin_amdgcn_readfirstlane((int)threadIdx.x >> 6);
    if (threadIdx.x < 32) MISC[threadIdx.x] = 0u;
#if defined(__HIP_DEVICE_COMPILE__)
#define ASSUME_GLOBAL(p) do { __builtin_assume(!__builtin_amdgcn_is_shared((const __attribute__((address_space(0))) void*)(p))); __builtin_assume(!__builtin_amdgcn_is_private((const __attribute__((address_space(0))) void*)(p))); } while (0)
#else
#define ASSUME_GLOBAL(p) do { } while (0)
#endif
#define PHASE_IDS() int G = G0, bid = bid0; asm volatile("" : "+s"(G), "+s"(bid)); unsigned char* ws = args.ws; asm volatile("" : "+s"(ws) :: "memory"); ASSUME_GLOBAL(ws); int lane; asm volatile("v_mbcnt_lo_u32_b32 %0, -1, 0\n\tv_mbcnt_hi_u32_b32 %0, -1, %0" : "=v"(lane)); const int wave = wave_s, tid = wave * 64 + lane; (void)tid
    __syncthreads();
    XcdBarrier bar; bar.bar = (unsigned*)(args.ws + WS_CTL) + CW_BAR; bar.x = 0; bar.st = nullptr;
    if (MK_ONE_LAUNCH) { bar = xcd_barrier_post((unsigned*)(args.ws + WS_CTL) + CW_BAR, MISC + 8); bar.x = (unsigned)__builtin_amdgcn_readfirstlane((int)bar.x); }
#if EXP_TIMING
#define SEAM_CAT(cat) do { if (MK_ONE_LAUNCH) { XcdBarrier bb_ = bar; asm volatile("" : "+s"(bb_.x), "+s"(bb_.bar)); xcd_barrier(bb_); } if (blockIdx.x == 0 && threadIdx.x == 0) { unsigned long long* tw = (unsigned long long*)(args.ws + WS_CTL + 1024); const unsigned long long now = wall_clock64(); if (tw[0]) tw[1 + (cat)] += now - tw[0]; tw[0] = now; } } while (0)
#else
#define SEAM_CAT(cat) do { if (MK_ONE_LAUNCH) { XcdBarrier bb_ = bar; asm volatile("" : "+s"(bb_.x), "+s"(bb_.bar)); xcd_barrier(bb_); } } while (0)
#endif
#define SEAM() SEAM_CAT(4)
#if EXP_TIMING
    if (blockIdx.x == 0 && threadIdx.x == 0) { unsigned long long* tw = (unsigned long long*)(args.ws + WS_CTL + 1024); tw[0] = wall_clock64(); }
#endif
    const int lo = args.ph_lo, hi = args.ph_hi; (void)lo; (void)hi;
#if MK_ONE_LAUNCH
#define IN(k) true
#else
#define IN(k) (lo <= (k) && (k) < hi)
#endif
    const float* x = args.in[I_X];

    if (IN(0)) { PHASE_IDS(); prologue_phase(args, ws, lds, tid, lane, wave, bid, G); SEAM_CAT(0); }
    if (IN(1)) { PHASE_IDS();
        pg8::StackOrder S; S.init(PB, (const bf16*)(ws + WS_WPP), DEPTH * T, D, PLE, 6  , G, bid);
        pg8::EpiBf16 E{PP, D};
        int Kp = PLE; asm volatile("" : "+s"(Kp));
        pg8::gemm_phase<pg8::EpiBf16, pg8::StackOrder, true, true>(lds, Kp, S, E, wave_s);
        SEAM_CAT(1);
    }
    for (int l = 0; l < DEPTH; ++l) {
        const int pb = PH_LAYER0 + PH_PER_LAYER * l, j = l >> 1;
        if ((l & 1) == 0) {
            if (IN(pb + 0)) { PHASE_IDS(); norm_even_phase((l == 0) ? x : H, HN, (const float*)(ws + WS_WDT) + (size_t)j * D * 16, args.in[I_M2_DT_BIAS] + j * 16, DT, lds, tid, lane, wave, bid, G); SEAM(); }
            if (IN(pb + 1)) { PHASE_IDS();
                pg8::StaticOrder S; S.init(HN, (const bf16*)(ws + WS_WIN) + (size_t)j * EINP * D, T, EINP, D, G, bid);
                pg8::EpiBf16 E{PROJ, EINP};
                pg8::gemm_phase<pg8::EpiBf16, pg8::StaticOrder, true, true>(lds, D, S, E, wave_s);
                SEAM_CAT(1);
            }
            if (IN(pb + 2)) { PHASE_IDS(); conv_phase(PROJ, args.in[I_M2_CONV_W] + (size_t)j * 5 * M2XBC, args.in[I_M2_CONV_B] + (size_t)j * M2XBC, XBC, tid, bid, G); SEAM(); }
            if (IN(pb + 3)) { PHASE_IDS();
#if MIX_MFMA
                { const int spare = G > 128 ? G - 128 : G, cb = G > 128 ? bid - 128 : bid;
                  if (cb >= 0) { LAS float* scr = (LAS float*)(lds + wave * TR_LDS); if (G <= 128) __syncthreads();
                      for (int it = cb * NWAVES + wave; it < CN_MOE; it += spare * NWAVES) convert_moe_item(args, ws, j, scr, it, lane); if (G <= 128) __syncthreads(); } }
                for (int it = bid; it < 128; it += G) {
                    if ((it & 1) == 0) mix_item<0>(it >> 1, PROJ, XBC, DT, (const float*)(ws + WS_WDT + 512 * 1024) + j * HGW, nullptr, OA, lds, tid, lane, wave, (unsigned long long*)(ws + WS_CTL + 2048));
                    else mix_item<1>(it >> 1, PROJ, XBC, DT, nullptr, args.in[I_M2_A_LOG] + j * 16, YA, lds, tid, lane, wave, (unsigned long long*)(ws + WS_CTL + 2048));
                }
#else
                for (int it = bid; it < 512; it += G) {
                    if (it < 256) scan_item<0>(it, PROJ, XBC, DT, (const float*)(ws + WS_WDT + 512 * 1024) + j * HGW, nullptr, OA, lds, tid);
                    else scan_item<1>(it - 256, PROJ, XBC, DT, nullptr, args.in[I_M2_A_LOG] + j * 16, YA, lds, tid);
                }
#endif
                SEAM_CAT(2);
            }
            if (IN(pb + 4)) { PHASE_IDS(); combine_even_phase(PROJ, XBC, OA, YA, args.in[I_HG_NORM_W] + j * HGW, args.in[I_M2_D] + j * M2H, args.in[I_M2_NORM_W] + j * M2I, MIX, lane, wave, bid, G); SEAM(); }
            if (IN(pb + 5)) { PHASE_IDS();
                pg8::StaticOrder S; S.init(MIX, (const bf16*)(ws + WS_WOUT) + (size_t)j * D * D, T, D, D, G, bid);
                pg8::EpiResF32 E{H, (l == 0) ? x : H, D};
                pg8::gemm_phase<pg8::EpiResF32, pg8::StaticOrder, true, true>(lds, D, S, E, wave_s);
                SEAM_CAT(1);
            }
            if (IN(pb + 6)) { PHASE_IDS(); norm_phase(H, HN, lane, wave, bid, G); SEAM(); }
            if (IN(pb + 7)) { PHASE_IDS();
                pg8::StaticOrder S; S.init(HN, (const bf16*)(ws + WS_WGU) + (size_t)j * 2 * FF * D, T, 2 * FF, D, G, bid);
                pg8::EpiSwiGLU E{ACT, FF};
                pg8::gemm_phase<pg8::EpiSwiGLU, pg8::StaticOrder, true, true>(lds, D, S, E, wave_s);
                SEAM_CAT(1);
            }
            if (IN(pb + 8) && !EXP_ZERO_FFN) { PHASE_IDS();
                pg8::StaticOrder S; S.init(ACT, (const bf16*)(ws + WS_WDN) + (size_t)j * D * FF, T, D, FF, G, bid);
                pg8::EpiResF32 E{H, H, D};
                pg8::gemm_phase<pg8::EpiResF32, pg8::StaticOrder, true, true>(lds, FF, S, E, wave_s);
                SEAM_CAT(1);
            }
            if (IN(pb + 9)) { PHASE_IDS(); norm_phase(H, HN, lane, wave, bid, G); SEAM(); }
        } else {
            if (IN(pb + 0)) { PHASE_IDS(); norm_phase(H, HN, lane, wave, bid, G); SEAM(); }
            if (IN(pb + 1)) { PHASE_IDS();
#if S5_MFMA
                if (wave < 4) for (int it = wave * G + bid; it < NB * S5G * 2; it += G * 4) s5_item_mfma(it, j, args, args.in[I_NORM_MIX] + l * D, HN, YS, lds + wave * S5_WAVE_LDS, lane);
#else
                for (int it = wave * G + bid; it < NB * S5G * 2; it += G * NWAVES) s5_item(it, j, args, args.in[I_NORM_MIX] + l * D, HN, YS, lane);
#endif
                SEAM_CAT(3);
            }
            if (IN(pb + 2)) { PHASE_IDS(); combine_s5_phase(H, args.in[I_NORM_MIX] + l * D, args.in[I_S5_D] + j * D, YS, MIX, lane, wave, bid, G); SEAM(); }
            if (IN(pb + 3)) { PHASE_IDS();
                pg8::StaticOrder S; S.init(MIX, (const bf16*)(ws + WS_WGLU) + (size_t)j * 2 * D * D, T, 2 * D, D, G, bid);
                float sclg = EXP_ZERO_GLU ? 0.f : 1.f; asm volatile("" : "+s"(sclg)); pg8::EpiGluRes E{H, D, sclg};
                pg8::gemm_phase<pg8::EpiGluRes, pg8::StaticOrder, true, true>(lds, D, S, E, wave_s);
                SEAM_CAT(1);
            }
            if (IN(pb + 4)) { PHASE_IDS(); router_phase(H, (unsigned char*)HN, (const float*)(ws + WS_WDT + 256 * 1024) + (size_t)j * D * 8, SEL, GATE, CNT, lds, tid, lane, wave, bid, G); SEAM(); }
            if (IN(pb + 5)) { PHASE_IDS(); scatter_phase((const unsigned char*)HN, SEL, CNT, SLOT, SEGB, (unsigned char*)XBUF, lds, tid, lane, wave, bid, G); SEAM(); }
            if (IN(pb + 6)) { PHASE_IDS();
                pg8::MoeOrder S; S.init(XBUF, (const bf16*)(ws + WS_WMGU + (size_t)j * NE * 2 * FF * D), SEGB, 2 * FF, D / 2, G, bid);
                pg8::EpiSwiGLU8 E{(unsigned char*)ACT, FF};
                int Kg = D / 2; asm volatile("" : "+s"(Kg));
                pg8::gemm_phase<pg8::EpiSwiGLU8, pg8::MoeOrder, true, true, true, W8_GU_SC>(lds, Kg, S, E, wave_s);
                SEAM_CAT(1);
            }
            if (IN(pb + 7)) { PHASE_IDS();
                pg8::MoeOrder S; S.init(ACT, (const bf16*)(ws + WS_WMDN + (size_t)j * NE * D * FF), SEGB, D, FF / 2, G, bid);
                pg8::EpiResF32 E{YBUF, nullptr, D};
                pg8::gemm_phase<pg8::EpiResF32, pg8::MoeOrder, true, true, true, W8_DN_SC>(lds, FF / 2, S, E, wave_s);
                SEAM_CAT(1);
            }
#if EXP_PROBE
            if (IN(pb + 8) && l == EXP_PROBE_LAYER) { PHASE_IDS(); probe_moe(H, args.in[I_NORM_FFN] + l * D, args.in[I_MOE_ROUTER] + (size_t)j * D * 8, args.in[I_MOE_W_GU] + (size_t)j * NE * D * 2 * FF, args.in[I_MOE_W_DOWN] + (size_t)j * NE * FF * D, SEL, SLOT, YBUF, (int*)(ws + WS_CTL) + 64, lds, tid, lane, wave, bid); __syncthreads(); }
#endif
            if (IN(pb + 9)) { PHASE_IDS(); moe_combine_norm_phase(H, YBUF, GATE, SLOT, HN, lane, wave, bid, G, SEGB, (int*)(ws + WS_CTL) + 64, ((EXP_ZERO_MOE >> j) & 1) ? 0.f : 1.f); SEAM(); }
        }
        if (IN(pb + 10)) { PHASE_IDS();
            pg8::StaticOrder S; S.init(HN, (const bf16*)(ws + WS_WPG) + (size_t)l * D * D, T, D, D, G, bid);
            float sclp = EXP_ZERO_PLE ? 0.f : 1.f; asm volatile("" : "+s"(sclp)); pg8::EpiPle E{H, PP + (size_t)l * T * D, D, sclp};
            pg8::gemm_phase<pg8::EpiPle, pg8::StaticOrder, true, true>(lds, D, S, E, wave_s);
            SEAM_CAT(1);
        }
    }
    if (IN(N_PHASES - 1)) { PHASE_IDS();
#if EXP_MIXTIME
        { const unsigned long long* tw = (const unsigned long long*)(ws + WS_CTL + 2048); const float tot = (float)(tw[0] + tw[1] + tw[2] + tw[3]); if (bid == 0 && tid == 0) ((int*)(ws + WS_CTL))[64] = (int)(10.f * (float)tw[EXP_MIXTIME_CAT] / tot + 0.5f); }
        SEAM_CAT(5);
#endif
#if EXP_TIMING
        { const unsigned long long* tw = (const unsigned long long*)(ws + WS_CTL + 1024); const float tot = (float)(tw[1] + tw[2] + tw[3] + tw[4] + tw[5]); if (bid == 0 && tid == 0) ((int*)(ws + WS_CTL))[64] = (int)(50.f * (float)tw[1 + EXP_TIMING_CAT] / tot + 0.5f); }
        SEAM_CAT(5);
#endif
        final_phase(H, args.in[I_FINAL_NORM], args.out, lane, wave, bid, G, (const int*)(ws + WS_CTL) + 64); }
#undef IN
#undef SEAM
#undef SEAM_CAT
#undef PHASE_IDS
}
#undef H
#undef HN
#undef MIX
#undef PB
#undef PP
#undef XBUF
#undef YBUF
#undef DT
#undef SEL
#undef SLOT
#undef GATE
#undef CNT
#undef SEGB
#undef PROJ
#undef XBC
#undef OA
#undef YA
#undef ACT
#undef YS


extern "C" void kernel_launch(void* const* d_in, const int* in_sizes, int n_in, void* d_out, int out_size, void* d_ws, size_t ws_size, hipStream_t stream) {
    static int grid = 0;
    if (grid == 0) {
        if (n_in != N_IN || in_sizes[0] != T * D || out_size != T * D || ws_size < WS_END) { fprintf(stderr, "kernel_launch: unexpected problem (n_in %d, in0 %d, out %d, ws %zu < %zu); nothing launched\n", n_in, n_in > 0 ? in_sizes[0] : -1, out_size, ws_size, (size_t)WS_END); grid = -1; return; }
        int dev = 0, cus = 0, per_cu = 0;
        if (hipGetDevice(&dev) != hipSuccess || hipDeviceGetAttribute(&cus, hipDeviceAttributeMultiprocessorCount, dev) != hipSuccess) { fprintf(stderr, "kernel_launch: device query failed\n"); grid = -1; return; }
        if (hipFuncSetAttribute((const void*)fwd, hipFuncAttributeMaxDynamicSharedMemorySize, LDS_BYTES) != hipSuccess) { fprintf(stderr, "kernel_launch: hipFuncSetAttribute failed\n"); grid = -1; return; }
        if (hipOccupancyMaxActiveBlocksPerMultiprocessor(&per_cu, (const void*)fwd, NTHR, LDS_BYTES) != hipSuccess || per_cu < 1) { fprintf(stderr, "kernel_launch: occupancy query reports %d workgroups per CU\n", per_cu); (void)hipGetLastError(); per_cu = 1; }
        grid = cus;
    }
    if (grid < 0) return;
    if (hipMemsetAsync((char*)d_ws + WS_CTL, 0, CTL_ZERO_BYTES, stream) != hipSuccess) { fprintf(stderr, "kernel_launch: memset failed\n"); return; }
    Args a{};
    for (int i = 0; i < N_IN; ++i) a.in[i] = (const float*)d_in[i];
    a.out = (float*)d_out; a.ws = (unsigned char*)d_ws;
#if MK_ONE_LAUNCH
    a.ph_lo = 0; a.ph_hi = N_PHASES;
    hipLaunchKernelGGL(fwd, dim3(grid), dim3(NTHR), LDS_BYTES, stream, a);
    { const hipError_t le = hipPeekAtLastError(); if (le != hipSuccess) fprintf(stderr, "kernel_launch: launch failed: %s\n", hipGetErrorName(le)); }
#else
    for (int ph = 0; ph < N_PHASES; ++ph) {
        const int rel = ph - PH_LAYER0, l = rel >= 0 ? rel / PH_PER_LAYER : -1, slot = rel >= 0 ? rel % PH_PER_LAYER : -1;
        if (l >= 0 && l < DEPTH) { if ((l & 1) && slot == 8 && !(EXP_PROBE && l == EXP_PROBE_LAYER)) continue; }
        a.ph_lo = ph; a.ph_hi = ph + 1;
        hipLaunchKernelGGL(fwd, dim3(grid), dim3(NTHR), LDS_BYTES, stream, a);
        const hipError_t le = hipPeekAtLastError(); if (le != hipSuccess) { fprintf(stderr, "kernel_launch: launch of phase %d failed: %s\n", ph, hipGetErrorName(le)); break; }
    }
#endif
}
```

```cpp
#include <hip/hip_runtime.h>
#include <cstdio>
#include <cstdint>

namespace pg8 {
#define PG8_LAS __attribute__((address_space(3)))
typedef unsigned short bf16_t;
typedef short bf16x8 __attribute__((ext_vector_type(8)));
typedef float f32x4 __attribute__((ext_vector_type(4)));
typedef float f32x2 __attribute__((ext_vector_type(2)));
typedef unsigned u32x4 __attribute__((ext_vector_type(4)));
typedef unsigned u32x2 __attribute__((ext_vector_type(2)));
constexpr int BM = 256, BK = 64, HALF = 128, HTB = HALF * BK * 2  , STAGE_BYTES = 8 * HTB, NXCD = 8, WGM = 8;

__host__ __device__ __forceinline__ int lds_byte(int r, int c) { const int st = (r >> 4) * 2 + (c >> 5), rr = r & 15, cc = c & 31, ob = rr * 64 + cc * 2; return st * 1024 + (ob ^ (((ob >> 9) & 1) << 5)); }
__host__ __device__ __forceinline__ void stage_rc(int b, int& R, int& C) { const int st = b / 1024, sb = b % 1024, swz = sb ^ (((sb >> 9) & 1) << 5); R = (st >> 1) * 16 + swz / 64; C = (st & 1) * 32 + (swz % 64) / 2; }
__host__ __device__ __forceinline__ int perm32(int rho) { const int n = rho >> 4, i = rho & 15; return 8 * (i >> 2) + 4 * n + (i & 3); }

struct Unit { int pm, pn; const char* A; const char* B; };

struct StaticOrder {
    int nM, nN, nwg, G, c; const char* A; const char* Bt; size_t tstep;
    __device__ void init(const bf16_t* A_, const bf16_t* Bt_, int M, int N, int K, int G_, int c_) { nM = M / BM; nN = N / BM; nwg = nM * nN; G = G_; c = c_; A = (const char*)A_; Bt = (const char*)Bt_; tstep = (size_t)BM * K * 2; }
    __device__ __forceinline__ bool next(int i, Unit& u) const {
        const long L = (long)i * G + c; if (L >= nwg) return false;
        int wgid = (int)L; { const int q = nwg / NXCD, r = nwg % NXCD, xcd = wgid % NXCD, off = wgid / NXCD; wgid = (xcd < r ? xcd * (q + 1) : r * (q + 1) + (xcd - r) * q) + off; }
        const int nig = WGM * nN, gid = wgid / nig, fm = gid * WGM, gsz = (nM - fm) < WGM ? (nM - fm) : WGM;
        u.pm = fm + ((wgid % nig) % gsz); u.pn = (wgid % nig) / gsz; u.A = A + (size_t)u.pm * tstep; u.B = Bt + (size_t)u.pn * tstep; return true;
    }
    __device__ __forceinline__ void a_ready(const Unit&) const {}
    __device__ __forceinline__ void done(const Unit&) const {}
};
struct MoeOrder {
    int nM, nN, nwg, G, c; const char* A; const char* Bt; size_t tstep, estride; int s1, s2, s3, s4, s5, s6, s7;
    __device__ void init(const bf16_t* A_, const bf16_t* Bt_, const int* seg, int N, int K, int G_, int c_) { nM = __builtin_amdgcn_readfirstlane(seg[8]) / BM; nN = N / BM; nwg = nM * nN; G = G_; c = c_; A = (const char*)A_; Bt = (const char*)Bt_; tstep = (size_t)BM * K * 2; estride = (size_t)N * K * 2;
        s1 = __builtin_amdgcn_readfirstlane(seg[1]); s2 = __builtin_amdgcn_readfirstlane(seg[2]); s3 = __builtin_amdgcn_readfirstlane(seg[3]); s4 = __builtin_amdgcn_readfirstlane(seg[4]);
        s5 = __builtin_amdgcn_readfirstlane(seg[5]); s6 = __builtin_amdgcn_readfirstlane(seg[6]); s7 = __builtin_amdgcn_readfirstlane(seg[7]); }
    __device__ __forceinline__ bool next(int i, Unit& u) const {
        const long L = (long)i * G + c; if (L >= nwg) return false;
        int wgid = (int)L; { const int q = nwg / NXCD, r = nwg % NXCD, xcd = wgid % NXCD, off = wgid / NXCD; wgid = (xcd < r ? xcd * (q + 1) : r * (q + 1) + (xcd - r) * q) + off; }
        const int nig = WGM * nN, gid = wgid / nig, fm = gid * WGM, gsz = (nM - fm) < WGM ? (nM - fm) : WGM;
        u.pm = fm + ((wgid % nig) % gsz); u.pn = (wgid % nig) / gsz;
        const int r0 = u.pm * BM; const int e = (r0 >= s1) + (r0 >= s2) + (r0 >= s3) + (r0 >= s4) + (r0 >= s5) + (r0 >= s6) + (r0 >= s7);
        u.A = A + (size_t)u.pm * tstep; u.B = Bt + (size_t)e * estride + (size_t)u.pn * tstep; return true;
    }
    __device__ __forceinline__ void a_ready(const Unit&) const {}
    __device__ __forceinline__ void done(const Unit&) const {}
};

struct StackOrder {
    int nM, nN, nwg, G, c, tpl; const char* A; const char* Bt; size_t tstep, lstride;
    __device__ void init(const bf16_t* A_, const bf16_t* Bt_, int M, int N, int K, int log2TilesPerL, int G_, int c_) { nM = M / BM; nN = N / BM; nwg = nM * nN; G = G_; c = c_; tpl = log2TilesPerL; A = (const char*)A_; Bt = (const char*)Bt_; tstep = (size_t)BM * K * 2; lstride = (size_t)N * K * 2; }
    __device__ __forceinline__ bool next(int i, Unit& u) const {
        const long L = (long)i * G + c; if (L >= nwg) return false;
        int wgid = (int)L; { const int q = nwg / NXCD, r = nwg % NXCD, xcd = wgid % NXCD, off = wgid / NXCD; wgid = (xcd < r ? xcd * (q + 1) : r * (q + 1) + (xcd - r) * q) + off; }
        const int nig = WGM * nN, gid = wgid / nig, fm = gid * WGM, gsz = (nM - fm) < WGM ? (nM - fm) : WGM;
        u.pm = fm + ((wgid % nig) % gsz); u.pn = (wgid % nig) / gsz;
        u.A = A + (size_t)u.pm * tstep; u.B = Bt + (size_t)(u.pm >> tpl) * lstride + (size_t)u.pn * tstep; return true;
    }
    __device__ __forceinline__ void a_ready(const Unit&) const {}
    __device__ __forceinline__ void done(const Unit&) const {}
};

__device__ __forceinline__ unsigned cvt_pk_bf16(float lo, float hi) { unsigned r; asm volatile("v_cvt_pk_bf16_f32 %0, %1, %2" : "=v"(r) : "v"(lo), "v"(hi)); return r; }
__device__ __forceinline__ float sigmoid_f(float x) { return 1.0f / (1.0f + __expf(-x)); }

struct EpiBf16 {
    static constexpr bool PERM = true, AFTER_DRAIN = false;
    bf16_t* O; int ldc;
    __device__ __forceinline__ void operator()(const f32x4 (&acc)[2][2][4][2], const Unit& u, int wr, int wc, int fr, int fq) const {
        const int row0 = u.pm * BM + wr * 64 + fr, col0 = u.pn * BM + wc * 32 + 8 * fq;
#pragma unroll
        for (int ai = 0; ai < 2; ++ai)
#pragma unroll
            for (int m = 0; m < 4; ++m) { bf16_t* rowp = O + (size_t)(row0 + ai * HALF + m * 16) * ldc + col0;
#pragma unroll
                for (int bj = 0; bj < 2; ++bj) { const f32x4 v0 = acc[ai][bj][m][0], v1 = acc[ai][bj][m][1];
                    u32x4 w; w.x = cvt_pk_bf16(v0[0], v0[1]); w.y = cvt_pk_bf16(v0[2], v0[3]); w.z = cvt_pk_bf16(v1[0], v1[1]); w.w = cvt_pk_bf16(v1[2], v1[3]);
                    *(u32x4*)(rowp + bj * HALF) = w; } }
    }
};
struct EpiSwiGLU {
    static constexpr bool PERM = true, AFTER_DRAIN = false;
    bf16_t* O; int ldc;
    __device__ __forceinline__ void operator()(const f32x4 (&acc)[2][2][4][2], const Unit& u, int wr, int wc, int fr, int fq) const {
        const int row0 = u.pm * BM + wr * 64 + fr, col0 = u.pn * HALF + wc * 32 + 8 * fq;
#pragma unroll
        for (int ai = 0; ai < 2; ++ai)
#pragma unroll
            for (int m = 0; m < 4; ++m) { bf16_t* rowp = O + (size_t)(row0 + ai * HALF + m * 16) * ldc + col0;
                f32x4 v[2];
#pragma unroll
                for (int n = 0; n < 2; ++n) { const f32x4 g = acc[ai][0][m][n], uu = acc[ai][1][m][n];
#pragma unroll
                    for (int j = 0; j < 4; ++j) v[n][j] = g[j] * sigmoid_f(g[j]) * uu[j]; }
                u32x4 w; w.x = cvt_pk_bf16(v[0][0], v[0][1]); w.y = cvt_pk_bf16(v[0][2], v[0][3]); w.z = cvt_pk_bf16(v[1][0], v[1][1]); w.w = cvt_pk_bf16(v[1][2], v[1][3]);
                *(u32x4*)rowp = w; }
    }
};
__device__ __forceinline__ unsigned pk4_fp8(float a, float b, float c, float d) { unsigned w = 0u; w = __builtin_amdgcn_cvt_pk_fp8_f32(a, b, w, false); w = __builtin_amdgcn_cvt_pk_fp8_f32(c, d, w, true); return w; }
struct EpiSwiGLU8 {
    static constexpr bool PERM = true, AFTER_DRAIN = false;
    unsigned char* O; int ldc;
    __device__ __forceinline__ void operator()(const f32x4 (&acc)[2][2][4][2], const Unit& u, int wr, int wc, int fr, int fq) const {
        const int row0 = u.pm * BM + wr * 64 + fr, col0 = u.pn * HALF + wc * 32 + 8 * fq;
#pragma unroll
        for (int ai = 0; ai < 2; ++ai)
#pragma unroll
            for (int m = 0; m < 4; ++m) { unsigned char* rowp = O + (size_t)(row0 + ai * HALF + m * 16) * ldc + col0;
                f32x4 v[2];
#pragma unroll
                for (int n = 0; n < 2; ++n) { const f32x4 g = acc[ai][0][m][n], uu = acc[ai][1][m][n];
#pragma unroll
                    for (int j = 0; j < 4; ++j) v[n][j] = g[j] * sigmoid_f(g[j]) * uu[j]; }
                u32x2 w; w.x = pk4_fp8(v[0][0], v[0][1], v[0][2], v[0][3]); w.y = pk4_fp8(v[1][0], v[1][1], v[1][2], v[1][3]);
                *(u32x2*)rowp = w; }
    }
};
struct EpiResF32 {
    static constexpr bool PERM = false, AFTER_DRAIN = false;
    float* C; const float* res; int ldc;
    __device__ __forceinline__ void operator()(const f32x4 (&acc)[2][2][4][2], const Unit& u, int wr, int wc, int fr, int fq) const {
        const int row0 = u.pm * BM + wr * 64 + fr, col0 = u.pn * BM + wc * 32 + 4 * fq;
#pragma unroll
        for (int ai = 0; ai < 2; ++ai)
#pragma unroll
            for (int m = 0; m < 4; ++m) { const size_t off = (size_t)(row0 + ai * HALF + m * 16) * ldc + col0;
#pragma unroll
                for (int bj = 0; bj < 2; ++bj)
#pragma unroll
                    for (int n = 0; n < 2; ++n) { f32x4 o = acc[ai][bj][m][n]; if (res) o += *(const f32x4*)(res + off + bj * HALF + n * 16); *(f32x4*)(C + off + bj * HALF + n * 16) = o; }
                asm volatile("" ::: "memory"); }
    }
};
struct EpiGluRes {
    static constexpr bool PERM = false, AFTER_DRAIN = false;
    float* C; int ldc; float scl;
    __device__ __forceinline__ void operator()(const f32x4 (&acc)[2][2][4][2], const Unit& u, int wr, int wc, int fr, int fq) const {
        const int row0 = u.pm * BM + wr * 64 + fr, col0 = u.pn * HALF + wc * 32 + 4 * fq;
#pragma unroll
        for (int ai = 0; ai < 2; ++ai)
#pragma unroll
            for (int m = 0; m < 4; ++m) { float* rowp = C + (size_t)(row0 + ai * HALF + m * 16) * ldc + col0;
#pragma unroll
                for (int n = 0; n < 2; ++n) { const f32x4 o = acc[ai][0][m][n], g = acc[ai][1][m][n]; f32x4 h = *(const f32x4*)(rowp + n * 16);
#pragma unroll
                    for (int j = 0; j < 4; ++j) h[j] += o[j] * sigmoid_f(g[j]) * scl;
                    *(f32x4*)(rowp + n * 16) = h; }
                asm volatile("" ::: "memory"); }
    }
};
struct EpiPle {
    static constexpr bool PERM = false, AFTER_DRAIN = false;
    float* C; const bf16_t* P; int ldc; float scl;
    __device__ __forceinline__ void operator()(const f32x4 (&acc)[2][2][4][2], const Unit& u, int wr, int wc, int fr, int fq) const {
        const int row0 = u.pm * BM + wr * 64 + fr, col0 = u.pn * BM + wc * 32 + 4 * fq;
#pragma unroll
        for (int ai = 0; ai < 2; ++ai)
#pragma unroll
            for (int m = 0; m < 4; ++m) { const size_t off = (size_t)(row0 + ai * HALF + m * 16) * ldc + col0;
#pragma unroll
                for (int bj = 0; bj < 2; ++bj)
#pragma unroll
                    for (int n = 0; n < 2; ++n) { const f32x4 a = acc[ai][bj][m][n]; const u32x2 pw = *(const u32x2*)(P + off + bj * HALF + n * 16); f32x4 h = *(const f32x4*)(C + off + bj * HALF + n * 16);
                        h[0] += sigmoid_f(a[0]) * __uint_as_float(pw.x << 16) * scl; h[1] += sigmoid_f(a[1]) * __uint_as_float(pw.x & 0xffff0000u) * scl;
                        h[2] += sigmoid_f(a[2]) * __uint_as_float(pw.y << 16) * scl; h[3] += sigmoid_f(a[3]) * __uint_as_float(pw.y & 0xffff0000u) * scl;
                        *(f32x4*)(C + off + bj * HALF + n * 16) = h; }
                asm volatile("" ::: "memory"); }
    }
};

__device__ __forceinline__ void glds16_saddr(unsigned voff, const char* sbase, unsigned lds_dst) {
    unsigned keep; const unsigned long long b_ = (unsigned long long)sbase;
    sbase = (const char*)(((unsigned long long)(unsigned)__builtin_amdgcn_readfirstlane((int)(b_ >> 32)) << 32) | (unsigned)__builtin_amdgcn_readfirstlane((int)b_));
    lds_dst = (unsigned)__builtin_amdgcn_readfirstlane((int)lds_dst);
    asm volatile("s_mov_b32 %0, m0\n\ts_mov_b32 m0, %3\n\ts_nop 0\n\tglobal_load_lds_dwordx4 %1, %2\n\ts_mov_b32 m0, %0" : "=&s"(keep) : "v"(voff), "s"(sbase), "s"(lds_dst) : "memory");
}
typedef int i32x8 __attribute__((ext_vector_type(8)));
__device__ __forceinline__ void mfma8_acc(f32x4& acc, const i32x8& a, const i32x8& b, int sc) {
    asm volatile("v_mfma_scale_f32_16x16x128_f8f6f4 %0, %1, %2, %0, %3, %3 op_sel_hi:[0,0,0]" : "+v"(acc) : "v"(a), "v"(b), "v"(sc));
}
__device__ __forceinline__ i32x8 cat16(bf16x8 lo, bf16x8 hi) { const u32x4 a = __builtin_bit_cast(u32x4, lo), b = __builtin_bit_cast(u32x4, hi); return (i32x8){(int)a.x, (int)a.y, (int)a.z, (int)a.w, (int)b.x, (int)b.y, (int)b.z, (int)b.w}; }
template <class Epi, class Sched, bool ALIGN_EPI = false, bool SP2 = false, bool FP8 = false, int WSC = 127>
__device__ __forceinline__ void gemm_phase(PG8_LAS unsigned char* lds, const int K, const Sched& S, const Epi& E, const int wave_s  ) {
    int lane_; asm volatile("v_mbcnt_lo_u32_b32 %0, -1, 0\n\tv_mbcnt_hi_u32_b32 %0, -1, %0" : "=v"(lane_)); const int tid_ = wave_s * 64 + lane_;
    const int tid = tid_, wid = wave_s, lane = tid & 63, wr = wid >> 2, wc = wid & 3, fr = lane & 15, fq = lane >> 4;
    const int nt = K / BK;
    unsigned voffA[2], voffB[2];
#pragma unroll
    for (int i = 0; i < 2; ++i) { int R, C; stage_rc(tid * 16 + i * 8192, R, C); const int Rb = Epi::PERM ? ((R & ~31) + perm32(R & 31)) : R;
        voffA[i] = (unsigned)(R * K + C) * 2u; voffB[i] = (unsigned)(Rb * K + C) * 2u; }
    const size_t kstep = (size_t)(BK * 2);
    const size_t hstep = (size_t)HALF * K * 2;
    const unsigned ldsw = (unsigned)wid * 1024u;
    const int aoff = lds_byte(wr * 64 + fr, fq * 8), boff = lds_byte(wc * 32 + fr, fq * 8);
#define PG8_SA(b, h) (((b) * 2 + (h)) * HTB)
#define PG8_SB(b, h) ((4 + (b) * 2 + (h)) * HTB)
#define PG8_STAGE(bufoff, gbase, voff) do { _Pragma("unroll") for (int _i = 0; _i < 2; ++_i) { \
        glds16_saddr((voff)[_i], (const char*)(gbase), (unsigned)(unsigned long)(lds + (bufoff) + ldsw + _i * 8192)); } } while (0)
#define PG8_LD8(p) cat16(*(const PG8_LAS bf16x8*)(p), *(const PG8_LAS bf16x8*)((p) + 1024))
#define PG8_LDA(dst, b, h) do { if constexpr (FP8) { _Pragma("unroll") for (int m = 0; m < 4; ++m) dst##8[m] = PG8_LD8(lds + PG8_SA(b, h) + aoff + m * 2048); } else { \
        _Pragma("unroll") for (int m = 0; m < 4; ++m) _Pragma("unroll") for (int k = 0; k < 2; ++k) dst[m][k] = *(const PG8_LAS bf16x8*)(lds + PG8_SA(b, h) + aoff + m * 2048 + k * 1024); } } while (0)
#define PG8_LDB(dst, b, h) do { if constexpr (FP8) { _Pragma("unroll") for (int n = 0; n < 2; ++n) dst##8[n] = PG8_LD8(lds + PG8_SB(b, h) + boff + n * 2048); } else { \
        _Pragma("unroll") for (int n = 0; n < 2; ++n) _Pragma("unroll") for (int k = 0; k < 2; ++k) dst[n][k] = *(const PG8_LAS bf16x8*)(lds + PG8_SB(b, h) + boff + n * 2048 + k * 1024); } } while (0)
#define PG8_MMA(ai, bj, At, Bt) do { __builtin_amdgcn_s_setprio(1); if constexpr (FP8) { _Pragma("unroll") for (int m = 0; m < 4; ++m) _Pragma("unroll") for (int n = 0; n < 2; ++n) \
        mfma8_acc(acc[ai][bj][m][n], Bt##8[n], At##8[m], sc8); } else { \
        _Pragma("unroll") for (int m = 0; m < 4; ++m) _Pragma("unroll") for (int n = 0; n < 2; ++n) _Pragma("unroll") for (int k = 0; k < 2; ++k) \
        acc[ai][bj][m][n] = __builtin_amdgcn_mfma_f32_16x16x32_bf16(Bt[n][k], At[m][k], acc[ai][bj][m][n], 0, 0, 0); } __builtin_amdgcn_s_setprio(0); } while (0)
#define PG8_WAIT_V(n) asm volatile("s_waitcnt vmcnt(" #n ")" ::: "memory")
#define PG8_WAIT_L(n) asm volatile("s_waitcnt lgkmcnt(" #n ")" ::: "memory")
#define PG8_BAR __builtin_amdgcn_s_barrier()
#define PG8_SCHED __builtin_amdgcn_sched_barrier(0)
    Unit cur, nxt; int ui = 0;
    if (!S.next(0, cur)) return;
    f32x4 acc[2][2][4][2];
#pragma unroll
    for (int a = 0; a < 2; ++a)
#pragma unroll
        for (int b = 0; b < 2; ++b)
#pragma unroll
            for (int m = 0; m < 4; ++m)
#pragma unroll
                for (int n = 0; n < 2; ++n) acc[a][b][m][n] = (f32x4){0.f, 0.f, 0.f, 0.f};
    int sc8 = WSC; asm volatile("" : "+v"(sc8));
    bf16x8 At[4][2], B0[2][2], B1[2][2];
    i32x8 At8[4], B08[2], B18[2];
    const char* cA = cur.A; const char* cB = cur.B;
    S.a_ready(cur);
    if constexpr (SP2) {
        PG8_STAGE(PG8_SB(0, 0), cB, voffB); PG8_STAGE(PG8_SB(0, 1), cB + hstep, voffB); PG8_STAGE(PG8_SA(0, 0), cA, voffA); PG8_STAGE(PG8_SA(0, 1), cA + hstep, voffA);
        if (wr == 1) PG8_BAR;
        PG8_WAIT_V(2); PG8_BAR;
        PG8_STAGE(PG8_SB(1, 0), cB + kstep, voffB); PG8_STAGE(PG8_SA(1, 0), cA + kstep, voffA); PG8_STAGE(PG8_SB(1, 1), cB + hstep + kstep, voffB);
        PG8_WAIT_V(6); PG8_BAR;
    } else {
        PG8_STAGE(PG8_SB(0, 0), cB, voffB); PG8_STAGE(PG8_SA(0, 0), cA, voffA); PG8_STAGE(PG8_SB(0, 1), cB + hstep, voffB); PG8_STAGE(PG8_SA(0, 1), cA + hstep, voffA);
        if (wr == 1) PG8_BAR;
        PG8_WAIT_V(4); PG8_BAR;
        PG8_STAGE(PG8_SB(1, 0), cB + kstep, voffB); PG8_STAGE(PG8_SA(1, 0), cA + kstep, voffA); PG8_STAGE(PG8_SB(1, 1), cB + hstep + kstep, voffB);
        PG8_WAIT_V(6); PG8_BAR;
    }
    for (;;) {
        const bool has_next = S.next(ui + 1, nxt);
        const char* nA = has_next ? nxt.A : cA; const char* nB = has_next ? nxt.B : cB;
        for (int t = 0; t < nt; t += 2) {
            const bool last = (t == nt - 2);
            const char* a1 = cA + (size_t)(t + 1) * kstep;
            const char* a2 = last ? nA : cA + (size_t)(t + 2) * kstep; const char* b2 = last ? nB : cB + (size_t)(t + 2) * kstep;
            const char* a3 = a2 + kstep; const char* b3 = b2 + kstep;
            if (last && has_next) S.a_ready(nxt);
            if constexpr (SP2) {
            PG8_LDB(B0, 0, 0); PG8_LDB(B1, 0, 1); PG8_SCHED; PG8_LDA(At, 0, 0); PG8_STAGE(PG8_SA(1, 1), a1 + hstep, voffA);
            PG8_WAIT_V(8); PG8_WAIT_L(0); PG8_BAR; PG8_MMA(0, 0, At, B0); PG8_MMA(0, 1, At, B1); PG8_BAR; PG8_SCHED;
            PG8_LDA(At, 0, 1); PG8_STAGE(PG8_SB(0, 0), b2, voffB); PG8_STAGE(PG8_SB(0, 1), b2 + hstep, voffB); PG8_STAGE(PG8_SA(0, 0), a2, voffA);
            PG8_WAIT_V(8); PG8_WAIT_L(0); PG8_BAR; PG8_MMA(1, 0, At, B0); PG8_MMA(1, 1, At, B1); PG8_BAR; PG8_SCHED;
            PG8_LDB(B0, 1, 0); PG8_LDB(B1, 1, 1); PG8_SCHED; PG8_LDA(At, 1, 0); PG8_STAGE(PG8_SA(0, 1), a2 + hstep, voffA);
            PG8_WAIT_V(8); PG8_WAIT_L(0); PG8_BAR; PG8_MMA(0, 0, At, B0); PG8_MMA(0, 1, At, B1); PG8_BAR; PG8_SCHED;
            PG8_LDA(At, 1, 1); PG8_STAGE(PG8_SB(1, 0), b3, voffB); PG8_STAGE(PG8_SB(1, 1), b3 + hstep, voffB); PG8_STAGE(PG8_SA(1, 0), a3, voffA);
            PG8_WAIT_V(8); PG8_WAIT_L(0); PG8_BAR; PG8_MMA(1, 0, At, B0); PG8_MMA(1, 1, At, B1); PG8_BAR; PG8_SCHED;
            } else {
            PG8_LDB(B0, 0, 0); PG8_SCHED; PG8_LDA(At, 0, 0); PG8_STAGE(PG8_SA(1, 1), a1 + hstep, voffA);
            PG8_WAIT_L(8); PG8_BAR; PG8_WAIT_L(0); PG8_MMA(0, 0, At, B0); PG8_BAR; PG8_SCHED;
            PG8_LDB(B1, 0, 1); PG8_STAGE(PG8_SB(0, 0), b2, voffB);
            PG8_BAR; PG8_WAIT_L(0); PG8_MMA(0, 1, At, B1); PG8_BAR;
            PG8_LDA(At, 0, 1); PG8_STAGE(PG8_SA(0, 0), a2, voffA);
            PG8_BAR; PG8_WAIT_L(0); PG8_MMA(1, 0, At, B0); PG8_BAR; PG8_SCHED;
            PG8_STAGE(PG8_SB(0, 1), b2 + hstep, voffB);
            PG8_WAIT_V(6); PG8_BAR; PG8_MMA(1, 1, At, B1); PG8_BAR;
            PG8_LDB(B0, 1, 0); PG8_SCHED; PG8_LDA(At, 1, 0); PG8_STAGE(PG8_SA(0, 1), a2 + hstep, voffA);
            PG8_WAIT_L(8); PG8_BAR; PG8_WAIT_L(0); PG8_MMA(0, 0, At, B0); PG8_BAR; PG8_SCHED;
            PG8_LDB(B1, 1, 1); PG8_STAGE(PG8_SB(1, 0), b3, voffB);
            PG8_BAR; PG8_WAIT_L(0); PG8_MMA(0, 1, At, B1); PG8_BAR;
            PG8_LDA(At, 1, 1); PG8_STAGE(PG8_SA(1, 0), a3, voffA);
            PG8_BAR; PG8_WAIT_L(0); PG8_MMA(1, 0, At, B0); PG8_BAR; PG8_SCHED;
            PG8_STAGE(PG8_SB(1, 1), b3 + hstep, voffB);
            PG8_WAIT_V(6); PG8_BAR; PG8_MMA(1, 1, At, B1); PG8_BAR;
            }
        }
        if constexpr (FP8) asm volatile("s_nop 15\n\ts_nop 15" ::: "memory");
        if constexpr (ALIGN_EPI) { if (wr == 0) PG8_BAR; }
        if constexpr (!Epi::AFTER_DRAIN) { E(acc, cur, wr, wc, fr, fq); S.done(cur); }
        if (!has_next) break;
#pragma unroll
        for (int a = 0; a < 2; ++a)
#pragma unroll
            for (int b = 0; b < 2; ++b)
#pragma unroll
                for (int m = 0; m < 4; ++m)
#pragma unroll
                    for (int n = 0; n < 2; ++n) acc[a][b][m][n] = (f32x4){0.f, 0.f, 0.f, 0.f};
        cur = nxt; cA = nA; cB = nB; ++ui;
        if constexpr (ALIGN_EPI) { if (wr == 1) PG8_BAR; }
    }
    PG8_WAIT_V(0);
    if constexpr (!ALIGN_EPI) { if (wr == 0) PG8_BAR; }
    PG8_BAR;
    if constexpr (Epi::AFTER_DRAIN) { E.fused(acc, cur, wr, wc, fr, fq, lds, wid, lane); S.done(cur); }
#undef PG8_SA
#undef PG8_SB
#undef PG8_STAGE
#undef PG8_LD8
#undef PG8_LDA
#undef PG8_LDB
#undef PG8_MMA
#undef PG8_WAIT_V
#undef PG8_WAIT_L
#undef PG8_BAR
#undef PG8_SCHED
}
}

#ifndef EXP_ZERO_HG
#define EXP_ZERO_HG 0
#endif
#ifndef EXP_ZERO_S5
#define EXP_ZERO_S5 0
#endif
#ifndef EXP_ZERO_MOE
#define EXP_ZERO_MOE 0
#endif
#ifndef EXP_ZERO_FFN
#define EXP_ZERO_FFN 0
#endif
#ifndef EXP_PROBE
#define EXP_PROBE 0
#endif
#ifndef EXP_ZERO_GLU
#define EXP_ZERO_GLU 0
#endif
#ifndef EXP_ZERO_PLE
#define EXP_ZERO_PLE 0
#endif
#ifndef EXP_PROBE_LAYER
#define EXP_PROBE_LAYER 1
#endif
#ifndef EXP_TIMING
#define EXP_TIMING 0
#endif
#ifndef EXP_TIMING_CAT
#define EXP_TIMING_CAT 1
#endif
#ifndef EXP_MIXTIME
#define EXP_MIXTIME 0
#endif
#ifndef EXP_MIXTIME_CAT
#define EXP_MIXTIME_CAT 0
#endif
#ifndef EXP_ZERO_SSD
#define EXP_ZERO_SSD 0
#endif
#ifndef MIX_MFMA
#define MIX_MFMA 1
#endif
#ifndef S5_MFMA
#define S5_MFMA 1
#endif
constexpr int NB = 8, SEQ = 2048, D = 1024, T = NB * SEQ, DEPTH = 4, PLE = 256;
constexpr int HGH = 4, HGD = 128, HGW = 512;
constexpr int M2H = 8, M2P = 64, M2I = 512, M2N = 128, M2XBC = 1024;
constexpr int EIN = 4112, EINP = 4096;
constexpr int S5G = 64, S5N = 64, S5C = 16;
constexpr int FF = 3584, NE = 8;
constexpr int MOE_ROWS = 2 * T + NE * 256;
constexpr float EPS = 1e-6f;
constexpr float W8_GU_MULT = 64.f, W8_DN_MULT = 64.f;
constexpr int W8_GU_SC = 127 - 3, W8_DN_SC = 127 - 3;
constexpr int NWAVES = 8, NTHR = 512;

constexpr size_t MiB = 1u << 20;
constexpr size_t WS_CTL = 0, CTL_ZERO_BYTES = 1 * MiB;
constexpr size_t WS_WIN = 1 * MiB;
constexpr size_t WS_WOUT = WS_WIN + 16 * MiB;
constexpr size_t WS_WGU = WS_WOUT + 4 * MiB;
constexpr size_t WS_WDN = WS_WGU + 28 * MiB;
constexpr size_t WS_WGLU = WS_WDN + 14 * MiB;
constexpr size_t WS_WPG = WS_WGLU + 8 * MiB;
constexpr size_t WS_WPP = WS_WPG + 8 * MiB;
constexpr size_t WS_WMGU = WS_WPP + 2 * MiB;
constexpr size_t WS_WMDN = WS_WMGU + 224 * MiB;
constexpr size_t WS_WDT = WS_WMDN + 112 * MiB;
constexpr size_t WS_H = WS_WDT + 1 * MiB;
constexpr size_t WS_HN = WS_H + 64 * MiB;
constexpr size_t WS_MIX = WS_HN + 32 * MiB;
constexpr size_t WS_PB = WS_MIX + 32 * MiB;
constexpr size_t WS_PP = WS_PB + 32 * MiB;
constexpr size_t WS_XBUF = WS_PP + 128 * MiB;
constexpr size_t WS_YBUF = WS_XBUF + 68 * MiB;
constexpr size_t WS_DT = WS_YBUF + 136 * MiB;
constexpr size_t WS_ROUTE = WS_DT + 1 * MiB;
constexpr size_t WS_R = WS_ROUTE + 1 * MiB;
constexpr size_t WS_PROJ = WS_R, WS_XBC = WS_R + 128 * MiB, WS_OA = WS_R + 160 * MiB, WS_YA = WS_R + 224 * MiB, WS_ACT = WS_R, WS_YS = WS_R;
constexpr size_t WS_END = WS_R + 288 * MiB;
static_assert((size_t)MOE_ROWS * FF * 2 <= 288 * MiB && (size_t)MOE_ROWS * D * 2 <= 68 * MiB && (size_t)MOE_ROWS * D * 4 <= 136 * MiB, "ws map");
constexpr int CW_BAR = 4096;

constexpr int RING_BYTES = 131072;
constexpr int LDS_BYTES = 147456;
constexpr int MISC_OFF = LDS_BYTES - 128;

#define GAS __attribute__((address_space(1)))
#define LAS __attribute__((address_space(3)))
typedef unsigned short bf16;
typedef unsigned v4u __attribute__((ext_vector_type(4)));
typedef unsigned v2u __attribute__((ext_vector_type(2)));
typedef float f32x4 __attribute__((ext_vector_type(4)));
typedef int v4i __attribute__((ext_vector_type(4)));
#define LDS_WAIT() asm volatile("s_waitcnt lgkmcnt(0)" ::: "memory")
typedef float cvt_f32x2 __attribute__((ext_vector_type(2)));
typedef __bf16 cvt_bf16x2 __attribute__((ext_vector_type(2)));
__device__ __forceinline__ unsigned pk2(float lo, float hi) { const cvt_bf16x2 r = __builtin_convertvector((cvt_f32x2){lo, hi}, cvt_bf16x2); return __builtin_bit_cast(unsigned, r); }
__device__ __forceinline__ unsigned f2bf(float f) { return pk2(f, 0.f) & 0xffffu; }
__device__ __forceinline__ float bflo(unsigned w) { return __uint_as_float(w << 16); }
__device__ __forceinline__ float bfhi(unsigned w) { return __uint_as_float(w & 0xffff0000u); }
__device__ __forceinline__ float bf1(bf16 b) { return __uint_as_float((unsigned)b << 16); }
__device__ __forceinline__ float sigm(float x) { return 1.0f / (1.0f + __expf(-x)); }
__device__ __forceinline__ float silu_f(float x) { return x * sigm(x); }
__device__ __forceinline__ float softplus_f(float x) { return fmaxf(x, 0.f) + __logf(1.0f + __expf(-fabsf(x))); }
__device__ __forceinline__ float gelu_tanh(float x) { const float u = 0.7978845608028654f * (x + 0.044715f * x * x * x); return 0.5f * x * (1.0f + tanhf(u)); }
__device__ __forceinline__ float sx(float v, int o, int lane) { return __builtin_bit_cast(float, __builtin_amdgcn_ds_bpermute((lane ^ o) << 2, __builtin_bit_cast(int, v))); }
__device__ __forceinline__ float wave_sum(float v, int lane) {
#pragma unroll
    for (int o = 1; o < 64; o <<= 1) v += sx(v, o, lane);
    return v;
}
#define XB_TMO      128
#define XB_XCNT(j)  (256  + 64 * (j))
#define XB_XSUB(j)  (1280 + 64 * (j))
#define XB_XGEN(j)  (2304 + 64 * (j))
#define XB_TOP      3328
#define XB_TOPGEN   3392
#define XCD_BAR_WORDS 3456
#define XB_SPIN_CAP (1u << 18)

__device__ __forceinline__ unsigned xb_ld(unsigned* p)              { return __hip_atomic_load(p, __ATOMIC_RELAXED, __HIP_MEMORY_SCOPE_AGENT); }
__device__ __forceinline__ unsigned xb_add(unsigned* p, unsigned v) { return __hip_atomic_fetch_add(p, v, __ATOMIC_RELAXED, __HIP_MEMORY_SCOPE_AGENT); }
__device__ __forceinline__ unsigned xb_xcc_id() { return (unsigned)__builtin_amdgcn_s_getreg((3 << 11) | 20) & 0xFu; }
#define XB_SPIN(cond, bar) do { unsigned _sp = 0; while (cond) { __builtin_amdgcn_s_sleep(1); \
    if ((++_sp & 255u) == 0u) { if (xb_ld(&(bar)[XB_TMO])) break; if (_sp > XB_SPIN_CAP) { atomicAdd(&(bar)[XB_TMO], 1u); break; } } } } while (0)

struct XcdBarrier {
    unsigned* bar; unsigned x;
    volatile LAS unsigned* st;
};

__device__ __forceinline__ XcdBarrier xcd_barrier_post(unsigned* bar, volatile LAS unsigned* st) {
    XcdBarrier b; b.bar = bar; b.x = xb_xcc_id(); b.st = st;
    if (threadIdx.x == 0) (void)xb_add(&bar[XB_XCNT(b.x)], 1u);
    return b;
}
__device__ __forceinline__ void xcd_barrier_complete(unsigned* bar, unsigned x, unsigned& nloc, unsigned& nx) {
    const unsigned G = gridDim.x * gridDim.y * gridDim.z;
    unsigned sum, cnt, mine, sp = 0u;
    for (;;) {
        sum = 0u; cnt = 0u; mine = 0u;
#pragma unroll
        for (unsigned j = 0; j < 16; ++j) { const unsigned c = xb_ld(&bar[XB_XCNT(j)]); sum += c; cnt += (c > 0u) ? 1u : 0u; mine = (j == x) ? c : mine; }
        if (sum == G) break;
        __builtin_amdgcn_s_sleep(1);
        if ((++sp & 255u) == 0u) { if (xb_ld(&bar[XB_TMO])) break; if (sp > XB_SPIN_CAP) { atomicAdd(&bar[XB_TMO], 1u); break; } }
    }
    nloc = mine > 0u ? mine : 1u; nx = cnt > 0u ? cnt : 1u;
}

__device__ __forceinline__ void xcd_barrier(const XcdBarrier& b) {
    asm volatile("s_waitcnt vmcnt(0)" ::: "memory");
    __syncthreads();
    if (threadIdx.x == 0) {
        unsigned* bar = b.bar;
        __builtin_amdgcn_s_waitcnt(0);
        unsigned nloc = b.st[0], nx = b.st[1];
        if (nloc == 0u) { xcd_barrier_complete(bar, b.x, nloc, nx); b.st[0] = nloc; b.st[1] = nx; }
        const unsigned old = xb_add(&bar[XB_XSUB(b.x)], 1u);
        const unsigned gen = old / nloc;
        if (old + 1u == (gen + 1u) * nloc) {
            __builtin_amdgcn_fence(__ATOMIC_RELEASE, "agent");
            asm volatile("s_waitcnt vmcnt(0)" ::: "memory");
            const unsigned og = xb_add(&bar[XB_TOP], 1u);
            const unsigned tg = og / nx;
            if (og + 1u == (tg + 1u) * nx) xb_add(&bar[XB_TOPGEN], 1u);
            else XB_SPIN(xb_ld(&bar[XB_TOPGEN]) == tg, bar);
            __builtin_amdgcn_fence(__ATOMIC_ACQUIRE, "agent");
            xb_add(&bar[XB_XGEN(b.x)], 1u);
            asm volatile("s_waitcnt vmcnt(0)" ::: "memory");
        } else {
            XB_SPIN(xb_ld(&bar[XB_XGEN(b.x)]) == gen, bar);
            __builtin_amdgcn_fence(__ATOMIC_ACQUIRE, "agent");
            asm volatile("s_waitcnt vmcnt(0)" ::: "memory");
        }
    }
    __syncthreads();
}


enum { I_X = 0, I_P, I_NORM_MIX, I_NORM_FFN, I_NORM_PLE, I_FINAL_NORM, I_PLE_GATE, I_PLE_PROJ, I_EV_W_IN, I_EV_W_OUT, I_HG_LB, I_HG_NORM_W, I_M2_CONV_W, I_M2_CONV_B, I_M2_DT_BIAS, I_M2_A_LOG, I_M2_D,
       I_M2_NORM_W, I_S5_A_RE, I_S5_A_IM, I_S5_LOG_STEP, I_S5_B_RE, I_S5_B_IM, I_S5_C_RE, I_S5_C_IM, I_S5_D, I_S5_GLU_W, I_FFN_W_GU, I_FFN_W_DOWN, I_MOE_ROUTER, I_MOE_W_GU, I_MOE_W_DOWN, N_IN };
struct Args { const float* in[N_IN]; float* out; unsigned char* ws; int ph_lo, ph_hi; };

constexpr int TR_LDS = 64 * 65 * 4;
__device__ __forceinline__ void transpose_item(const float* W, int K, int ldw, bf16* WT, int Ndst, int half, const float* scale, LAS float* scr, int item, int lane) {
    const int nblk = Ndst / 64, kb = item / nblk, nb = item % nblk, k0 = 64 * kb, n0 = 64 * nb;
    int s0 = n0;
    if (half) { const int tile = n0 >> 8, w = n0 & 255; s0 = (w < 128) ? (128 * tile + w) : (half + 128 * tile + (w - 128)); }
    const int lq = lane >> 4, lc = 4 * (lane & 15);
#pragma unroll 8
    for (int i = 0; i < 16; ++i) { const int kk = lq + 4 * i; f32x4 x = *(const f32x4*)(W + (size_t)(k0 + kk) * ldw + s0 + lc); if (scale) x = x * scale[k0 + kk];
        LAS float* d = scr + kk * 65 + lc; d[0] = x[0]; d[1] = x[1]; d[2] = x[2]; d[3] = x[3]; }
    LDS_WAIT(); asm volatile("" ::: "memory");
    const int c = lane & 7;
#pragma unroll
    for (int j = 0; j < 8; ++j) { const int n = (lane >> 3) + 8 * j; const LAS float* s = scr + (8 * c) * 65 + n;
        v4u o; o.x = pk2(s[0 * 65], s[1 * 65]); o.y = pk2(s[2 * 65], s[3 * 65]); o.z = pk2(s[4 * 65], s[5 * 65]); o.w = pk2(s[6 * 65], s[7 * 65]);
        *(v4u*)(WT + (size_t)(n0 + n) * K + k0 + 8 * c) = o; }
    LDS_WAIT(); asm volatile("" ::: "memory");
}
__device__ __forceinline__ void transpose_item8(const float* W, int K, int ldw, unsigned char* WT8, int Ndst, int half, const float* scale, float mult, LAS float* scr, int item, int lane) {
    const int nblk = Ndst / 64, kb = item / nblk, nb = item % nblk, k0 = 64 * kb, n0 = 64 * nb;
    int s0 = n0;
    if (half) { const int tile = n0 >> 8, w = n0 & 255; s0 = (w < 128) ? (128 * tile + w) : (half + 128 * tile + (w - 128)); }
    const int lq = lane >> 4, lc = 4 * (lane & 15);
#pragma unroll 8
    for (int i = 0; i < 16; ++i) { const int kk = lq + 4 * i; f32x4 x = *(const f32x4*)(W + (size_t)(k0 + kk) * ldw + s0 + lc); x = x * (scale ? scale[k0 + kk] * mult : mult);
        LAS float* d = scr + kk * 65 + lc; d[0] = x[0]; d[1] = x[1]; d[2] = x[2]; d[3] = x[3]; }
    LDS_WAIT(); asm volatile("" ::: "memory");
    const int c = lane & 7;
#pragma unroll
    for (int j = 0; j < 8; ++j) { const int n = (lane >> 3) + 8 * j; const LAS float* sp = scr + (8 * c) * 65 + n;
        v2u o; o.x = pg8::pk4_fp8(sp[0 * 65], sp[1 * 65], sp[2 * 65], sp[3 * 65]); o.y = pg8::pk4_fp8(sp[4 * 65], sp[5 * 65], sp[6 * 65], sp[7 * 65]);
        *(v2u*)(WT8 + (size_t)(n0 + n) * K + k0 + 8 * c) = o; }
    LDS_WAIT(); asm volatile("" ::: "memory");
}
constexpr int CI_IN = 16 * 64, CI_OUT = 16 * 16, CI_GU = 16 * 112, CI_DN = 56 * 16, CI_GLU = 16 * 32, CI_PG = 16 * 16, CI_PPJ = 4 * 16;
constexpr int CN_SMALL = 2 * CI_IN + 2 * CI_OUT + 2 * CI_GU + 2 * CI_DN + 2 * CI_GLU + 4 * CI_PG + 4 * CI_PPJ, CN_MOE = 8 * CI_GU + 8 * CI_DN;
__device__ __forceinline__ void convert_small_item(const Args& a, unsigned char* ws, LAS float* scr, int it, int lane) {
    int r = it;
    if (r < 2 * CI_IN) { const int j = r / CI_IN; transpose_item(a.in[I_EV_W_IN] + (size_t)j * D * EIN, D, EIN, (bf16*)(ws + WS_WIN) + (size_t)j * EINP * D, EINP, 0, a.in[I_NORM_MIX] + (2 * j) * D, scr, r % CI_IN, lane); return; } r -= 2 * CI_IN;
    if (r < 2 * CI_OUT) { const int j = r / CI_OUT; transpose_item(a.in[I_EV_W_OUT] + (size_t)j * D * D, D, D, (bf16*)(ws + WS_WOUT) + (size_t)j * D * D, D, 0, nullptr, scr, r % CI_OUT, lane); return; } r -= 2 * CI_OUT;
    if (r < 2 * CI_GU) { const int j = r / CI_GU; transpose_item(a.in[I_FFN_W_GU] + (size_t)j * D * 2 * FF, D, 2 * FF, (bf16*)(ws + WS_WGU) + (size_t)j * 2 * FF * D, 2 * FF, FF, a.in[I_NORM_FFN] + (2 * j) * D, scr, r % CI_GU, lane); return; } r -= 2 * CI_GU;
    if (r < 2 * CI_DN) { const int j = r / CI_DN; transpose_item(a.in[I_FFN_W_DOWN] + (size_t)j * FF * D, FF, D, (bf16*)(ws + WS_WDN) + (size_t)j * D * FF, D, 0, nullptr, scr, r % CI_DN, lane); return; } r -= 2 * CI_DN;
    if (r < 2 * CI_GLU) { const int j = r / CI_GLU; transpose_item(a.in[I_S5_GLU_W] + (size_t)j * D * 2 * D, D, 2 * D, (bf16*)(ws + WS_WGLU) + (size_t)j * 2 * D * D, 2 * D, D, nullptr, scr, r % CI_GLU, lane); return; } r -= 2 * CI_GLU;
    if (r < 4 * CI_PG) { const int l = r / CI_PG; transpose_item(a.in[I_PLE_GATE] + (size_t)l * D * D, D, D, (bf16*)(ws + WS_WPG) + (size_t)l * D * D, D, 0, a.in[I_NORM_PLE] + l * D, scr, r % CI_PG, lane); return; } r -= 4 * CI_PG;
    { const int l = r / CI_PPJ; transpose_item(a.in[I_PLE_PROJ] + (size_t)l * PLE * D, PLE, D, (bf16*)(ws + WS_WPP) + (size_t)l * D * PLE, D, 0, nullptr, scr, r % CI_PPJ, lane); }
}
__device__ __forceinline__ void convert_moe_item(const Args& a, unsigned char* ws, int j, LAS float* scr, int it, int lane) {
    if (it < 8 * CI_GU) { const int je = j * 8 + it / CI_GU; transpose_item8(a.in[I_MOE_W_GU] + (size_t)je * D * 2 * FF, D, 2 * FF, ws + WS_WMGU + (size_t)je * 2 * FF * D, 2 * FF, FF, a.in[I_NORM_FFN] + (2 * j + 1) * D, W8_GU_MULT, scr, it % CI_GU, lane); return; }
    const int r = it - 8 * CI_GU; const int je = j * 8 + r / CI_DN; transpose_item8(a.in[I_MOE_W_DOWN] + (size_t)je * FF * D, FF, D, ws + WS_WMDN + (size_t)je * D * FF, D, 0, nullptr, W8_DN_MULT, scr, r % CI_DN, lane);
}
__device__ __forceinline__ void prologue_phase(const Args& a, unsigned char* ws, LAS unsigned char* lds, int tid, int lane, int wave, int bid, int G) {
    LAS float* scr = (LAS float*)(lds + wave * TR_LDS);
    const int gw = bid * NWAVES + wave, NGW = G * NWAVES;
    for (int it = gw; it < CN_SMALL; it += NGW) convert_small_item(a, ws, scr, it, lane);
    const int gt = bid * NTHR + tid, NT = G * NTHR;
    { const f32x4* src = (const f32x4*)a.in[I_P]; v4u* dst = (v4u*)(ws + WS_PB);
      for (int i = gt; i < DEPTH * T * PLE / 8; i += NT) { const f32x4 x0 = src[2 * (size_t)i], x1 = src[2 * (size_t)i + 1]; v4u o; o.x = pk2(x0[0], x0[1]); o.y = pk2(x0[2], x0[3]); o.z = pk2(x1[0], x1[1]); o.w = pk2(x1[2], x1[3]); dst[i] = o; } }
    { float* wdt = (float*)(ws + WS_WDT);
      for (int i = gt; i < 2 * D * 16; i += NT) { const int j = i / (D * 16), c = (i / 16) % D, o = i % 16; wdt[i] = a.in[I_NORM_MIX][(2 * j) * D + c] * a.in[I_EV_W_IN][(size_t)j * D * EIN + (size_t)c * EIN + EINP + o]; }
      float* wr = (float*)(ws + WS_WDT + 256 * 1024);
      for (int i = gt; i < 2 * D * 8; i += NT) { const int j = i / (D * 8), c = (i / 8) % D, e = i % 8; wr[i] = a.in[I_NORM_FFN][(2 * j + 1) * D + c] * a.in[I_MOE_ROUTER][(size_t)j * D * 8 + c * 8 + e]; }
      float* lb = (float*)(ws + WS_WDT + 512 * 1024);
      for (int i = gt; i < HGW; i += NT) { const float l0 = a.in[I_HG_LB][i], l1 = a.in[I_HG_LB][HGW + i], m = fmaxf(l0, l1), e0 = expf(l0 - m), e1 = expf(l1 - m), s0 = e0 / (e0 + e1), s1 = e1 / (e0 + e1);
          lb[i] = s0 - s0; lb[HGW + i] = (s0 + s1) - s0; } }
}

__device__ __forceinline__ float load_row_rstd(const float* row, int lane, f32x4 (&v)[4]) {
    const f32x4* xr = (const f32x4*)row + lane; float s = 0.f;
#pragma unroll
    for (int j = 0; j < 4; ++j) { v[j] = xr[64 * j]; s += (v[j][0] * v[j][0] + v[j][1] * v[j][1]) + (v[j][2] * v[j][2] + v[j][3] * v[j][3]); }
    return 1.0f / sqrtf(wave_sum(s, lane) * (1.0f / D) + EPS);
}
__device__ __forceinline__ void store_row_bf16(bf16* orow, int lane, const f32x4 (&v)[4], float rstd) {
    unsigned long long* o8 = (unsigned long long*)orow + lane;
#pragma unroll
    for (int j = 0; j < 4; ++j) o8[64 * j] = (unsigned long long)pk2(v[j][0] * rstd, v[j][1] * rstd) | ((unsigned long long)pk2(v[j][2] * rstd, v[j][3] * rstd) << 32);
}
__device__ __forceinline__ void store_row_fp8(unsigned char* orow, int lane, const f32x4 (&v)[4], float rstd) {
    unsigned* o4 = (unsigned*)orow + lane;
#pragma unroll
    for (int j = 0; j < 4; ++j) o4[64 * j] = pg8::pk4_fp8(v[j][0] * rstd, v[j][1] * rstd, v[j][2] * rstd, v[j][3] * rstd);
}
__device__ __forceinline__ void norm8_phase(const float* src, unsigned char* HN8, int lane, int wave, int bid, int G) {
    const int gw = bid * NWAVES + wave, NGW = G * NWAVES;
    for (int row = gw; row < T; row += NGW) { f32x4 v[4]; const float rstd = load_row_rstd(src + (size_t)row * D, lane, v); store_row_fp8(HN8 + (size_t)row * D, lane, v, rstd); }
}
__device__ __forceinline__ void norm_phase(const float* src, bf16* HN, int lane, int wave, int bid, int G) {
    const int gw = bid * NWAVES + wave, NGW = G * NWAVES;
    for (int row = gw; row < T; row += NGW) { f32x4 v[4]; const float rstd = load_row_rstd(src + (size_t)row * D, lane, v); store_row_bf16(HN + (size_t)row * D, lane, v, rstd); }
}
__device__ __forceinline__ void norm_even_phase(const float* src, bf16* HN, const float* wdt  , const float* dt_bias  , float* DT, LAS unsigned char* lds, int tid, int lane, int wave, int bid, int G) {
    LAS float* wl = (LAS float*)lds;
    for (int i = tid; i < D * 16; i += NTHR) wl[(i & 15) * D + (i >> 4)] = wdt[i];
    __syncthreads();
    const int gw = bid * NWAVES + wave, NGW = G * NWAVES;
    for (int row = gw; row < T; row += NGW) {
        f32x4 v[4]; const float rstd = load_row_rstd(src + (size_t)row * D, lane, v); store_row_bf16(HN + (size_t)row * D, lane, v, rstd);
        float mine = 0.f;
#pragma nounroll
        for (int o = 0; o < 16; ++o) { float s = 0.f;
#pragma unroll
            for (int j = 0; j < 4; ++j) { const f32x4 w = *(const LAS f32x4*)(wl + o * D + 256 * j + 4 * lane); s += (v[j][0] * w[0] + v[j][1] * w[1]) + (v[j][2] * w[2] + v[j][3] * w[3]); }
            s = wave_sum(s, lane); mine = (lane == o) ? s : mine; }
        if (lane < 16) DT[(size_t)row * 16 + lane] = softplus_f(mine * rstd + dt_bias[lane]);
    }
    __syncthreads();
}
__device__ __forceinline__ void final_phase(const float* H, const float* w, float* out, int lane, int wave, int bid, int G, const int* diag = nullptr) {
    const int gw = bid * NWAVES + wave, NGW = G * NWAVES;
    for (int row = gw; row < T; row += NGW) { f32x4 v[4]; const float rstd = load_row_rstd(H + (size_t)row * D, lane, v);
        f32x4* o = (f32x4*)(out + (size_t)row * D) + lane; const f32x4* wv = (const f32x4*)w + lane;
#pragma unroll
        for (int j = 0; j < 4; ++j) o[64 * j] = v[j] * rstd * wv[64 * j] * ((EXP_PROBE || EXP_TIMING || EXP_MIXTIME) ? (float)(1 + diag[0]) : 1.0f); }
}

__device__ __forceinline__ void conv_phase(const bf16* PROJ, const float* cw, const float* cb, bf16* XBC, int tid, int bid, int G) {
    const size_t gt = (size_t)bid * NTHR + tid, NT = (size_t)G * NTHR;
    for (size_t idx = gt; idx < (size_t)T * 128; idx += NT) {
        const int t = (int)(idx >> 7), c = 8 * (int)(idx & 127), s = t & (SEQ - 1);
        float acc[8]; { const f32x4 b0 = *(const f32x4*)(cb + c), b1 = *(const f32x4*)(cb + c + 4); acc[0] = b0[0]; acc[1] = b0[1]; acc[2] = b0[2]; acc[3] = b0[3]; acc[4] = b1[0]; acc[5] = b1[1]; acc[6] = b1[2]; acc[7] = b1[3]; }
#pragma unroll
        for (int w = 0; w < 5; ++w) { const int ts = s + w - 2;
            if (ts >= 0 && ts < SEQ) { const v4u x = *(const v4u*)(PROJ + (size_t)(t + w - 2) * EINP + 3072 + c); const f32x4 k0 = *(const f32x4*)(cw + w * M2XBC + c), k1 = *(const f32x4*)(cw + w * M2XBC + c + 4);
                acc[0] += bflo(x.x) * k0[0]; acc[1] += bfhi(x.x) * k0[1]; acc[2] += bflo(x.y) * k0[2]; acc[3] += bfhi(x.y) * k0[3];
                acc[4] += bflo(x.z) * k1[0]; acc[5] += bfhi(x.z) * k1[1]; acc[6] += bflo(x.w) * k1[2]; acc[7] += bfhi(x.w) * k1[3]; } }
        v4u o; o.x = pk2(silu_f(acc[0]), silu_f(acc[1])); o.y = pk2(silu_f(acc[2]), silu_f(acc[3])); o.z = pk2(silu_f(acc[4]), silu_f(acc[5])); o.w = pk2(silu_f(acc[6]), silu_f(acc[7]));
        *(v4u*)(XBC + (size_t)t * M2XBC + c) = o;
    }
}
constexpr int TB = 16;
template <int MODE>
__device__ __forceinline__ void scan_item(int item, const bf16* PROJ, const bf16* XBC, const float* DT, const float* lbv  , const float* a_log  , float* OUT  , LAS unsigned char* lds, int tid) {
    LAS float* qs = (LAS float*)lds;
    LAS float* fs = qs + 2 * TB * 128;
    LAS float* ks = fs + 2 * TB * 128;
    LAS float* vs = ks + 2 * TB * 128;
    LAS float* sc = vs + 2 * TB * 32;
    LAS float* op = sc + 2 * TB * 2;
    const int part = MODE == 0 ? (item & 3) : (item & 1), dir = MODE == 0 ? ((item >> 2) & 1) : ((item >> 1) & 1), head = MODE == 0 ? ((item >> 3) & 3) : ((item >> 2) & 7), b = item >> 5;
    const int vv = tid & 31, dg = tid >> 5;
    const int si = tid >> 5, seg = tid & 31;
    const int colq = MODE == 0 ? head * 128 + 4 * seg : 3072 + 768 + (head >> 2) * 128 + 4 * seg;
    const int colf = MODE == 0 ? (dir == 0 ? 512 : 1024) + head * 128 + 4 * seg : 3072 + 512 + (head >> 2) * 128 + 4 * seg;
    const int colv = MODE == 0 ? 1536 + head * 128 + part * 32 + seg : 3072 + head * 64 + part * 32 + seg;
    float lb4[4] = {0.f, 0.f, 0.f, 0.f}; float Aneg = 0.f;
    if (MODE == 0) {
#pragma unroll
        for (int e = 0; e < 4; ++e) lb4[e] = lbv[head * 128 + 4 * seg + e];
    } else Aneg = -expf(a_log[dir * 8 + head]);
    float S[8];
#pragma unroll
    for (int e = 0; e < 8; ++e) S[e] = 0.f;
    constexpr int NBLK = SEQ / TB;
    v2u rq, rf; bf16 rv; float rdt = 0.f;
#define SCAN_TROW(blk, i) ((size_t)b * SEQ + (dir == 0 ? ((blk) * TB + (i)) : (SEQ - 1 - ((blk) * TB + (i)))))
#define SCAN_LOAD(blk) do { const size_t tr = SCAN_TROW(blk, si); \
        if (MODE == 0) { rq = *(const v2u*)(PROJ + tr * EINP + colq); rf = *(const v2u*)(PROJ + tr * EINP + colf); rv = PROJ[tr * EINP + colv]; } \
        else { rq = *(const v2u*)(XBC + tr * M2XBC + (colq - 3072)); rf = *(const v2u*)(XBC + tr * M2XBC + (colf - 3072)); rv = XBC[tr * M2XBC + (colv - 3072)]; if (seg == 0) rdt = DT[tr * 16 + dir * 8 + head]; } } while (0)
#define SCAN_STAGE(buf) do { const int o4 = ((buf) * TB + si) * 128 + 4 * seg; \
        const float q0 = bflo(rq.x), q1 = bfhi(rq.x), q2 = bflo(rq.y), q3 = bfhi(rq.y), f0 = bflo(rf.x), f1 = bfhi(rf.x), f2 = bflo(rf.y), f3 = bfhi(rf.y); \
        if (MODE == 0) { const float g0 = sigm(f0), g1 = sigm(f1), g2 = sigm(f2), g3 = sigm(f3); \
            *(LAS f32x4*)(qs + o4) = (f32x4){silu_f(q0), silu_f(q1), silu_f(q2), silu_f(q3)}; \
            *(LAS f32x4*)(fs + o4) = (f32x4){fmaxf(lb4[0], 1e-30f) + (1.f - lb4[0]) * g0, fmaxf(lb4[1], 1e-30f) + (1.f - lb4[1]) * g1, fmaxf(lb4[2], 1e-30f) + (1.f - lb4[2]) * g2, fmaxf(lb4[3], 1e-30f) + (1.f - lb4[3]) * g3}; \
            *(LAS f32x4*)(ks + o4) = (f32x4){(1.f - lb4[0]) * (1.f - g0), (1.f - lb4[1]) * (1.f - g1), (1.f - lb4[2]) * (1.f - g2), (1.f - lb4[3]) * (1.f - g3)}; } \
        else { *(LAS f32x4*)(qs + o4) = (f32x4){q0, q1, q2, q3}; *(LAS f32x4*)(ks + o4) = (f32x4){f0, f1, f2, f3}; if (seg == 0) { sc[((buf) * TB + si) * 2] = __expf(rdt * Aneg); sc[((buf) * TB + si) * 2 + 1] = rdt; } } \
        vs[((buf) * TB + si) * 32 + seg] = bf1(rv); } while (0)
    SCAN_LOAD(0); SCAN_STAGE(0);
    __syncthreads();
    for (int blk = 0; blk < NBLK; ++blk) {
        const int cur = blk & 1;
        if (blk + 1 < NBLK) SCAN_LOAD(blk + 1);
#pragma unroll
        for (int i = 0; i < TB; ++i) {
            const int o8 = (cur * TB + i) * 128 + 8 * dg;
            const f32x4 qa = *(const LAS f32x4*)(qs + o8), qb = *(const LAS f32x4*)(qs + o8 + 4), ka = *(const LAS f32x4*)(ks + o8), kb = *(const LAS f32x4*)(ks + o8 + 4);
            const float vt = vs[(cur * TB + i) * 32 + vv];
            float acc = 0.f;
            if (MODE == 0) {
                const f32x4 fa = *(const LAS f32x4*)(fs + o8), fb = *(const LAS f32x4*)(fs + o8 + 4);
#pragma unroll
                for (int e = 0; e < 4; ++e) { S[e] = fa[e] * S[e] + ka[e] * vt; acc += qa[e] * S[e]; S[4 + e] = fb[e] * S[4 + e] + kb[e] * vt; acc += qb[e] * S[4 + e]; }
            } else {
                const float dec = sc[(cur * TB + i) * 2], dtx = sc[(cur * TB + i) * 2 + 1] * vt;
#pragma unroll
                for (int e = 0; e < 4; ++e) { S[e] = dec * S[e] + ka[e] * dtx; acc += qa[e] * S[e]; S[4 + e] = dec * S[4 + e] + kb[e] * dtx; acc += qb[e] * S[4 + e]; }
            }
            op[(i * 16 + dg) * 32 + vv] = acc;
        }
        __syncthreads();
        { float s = 0.f;
#pragma unroll
          for (int g = 0; g < 16; ++g) s += op[(si * 16 + g) * 32 + seg];
          const size_t tr = SCAN_TROW(blk, si);
          OUT[((size_t)dir * T + tr) * 512 + (MODE == 0 ? head * 128 + part * 32 : head * 64 + part * 32) + seg] = s; }
        if (blk + 1 < NBLK) SCAN_STAGE(cur ^ 1);
        __syncthreads();
    }
#undef SCAN_TROW
#undef SCAN_LOAD
#undef SCAN_STAGE
}
__device__ __forceinline__ void combine_even_phase(const bf16* PROJ, const bf16* XBC, const bf16* OA, const bf16* YA, const float* hg_nw, const float* m2_d, const float* m2_nw, bf16* MIX, int lane, int wave, int bid, int G) {
    const int gw = bid * NWAVES + wave, NGW = G * NWAVES, c0 = 8 * lane;
    for (int row = gw; row < T; row += NGW) {
        float o[8], y[8];
        { const v4u a = *(const v4u*)(OA + (size_t)row * 512 + c0), b = *(const v4u*)(OA + ((size_t)T + row) * 512 + c0); const unsigned aw[4] = {a.x, a.y, a.z, a.w}, bw[4] = {b.x, b.y, b.z, b.w};
#pragma unroll
          for (int e = 0; e < 4; ++e) { o[2 * e] = bflo(aw[e]) + bflo(bw[e]); o[2 * e + 1] = bfhi(aw[e]) + bfhi(bw[e]); } }
        float ss = 0.f;
#pragma unroll
        for (int e = 0; e < 8; ++e) ss += o[e] * o[e];
        ss += sx(ss, 1, lane); ss += sx(ss, 2, lane); ss += sx(ss, 4, lane); ss += sx(ss, 8, lane);
        const float r1 = 1.0f / sqrtf(ss * (1.0f / 128.0f) + EPS);
        { const v4u g = *(const v4u*)(PROJ + (size_t)row * EINP + 2048 + c0); const f32x4 w0 = *(const f32x4*)(hg_nw + c0), w1 = *(const f32x4*)(hg_nw + c0 + 4);
          const float gg[8] = {bflo(g.x), bfhi(g.x), bflo(g.y), bfhi(g.y), bflo(g.z), bfhi(g.z), bflo(g.w), bfhi(g.w)}; const float ww[8] = {w0[0], w0[1], w0[2], w0[3], w1[0], w1[1], w1[2], w1[3]};
#pragma unroll
          for (int e = 0; e < 8; ++e) o[e] = o[e] * r1 * ww[e] * sigm(gg[e]) * (float)(1 - EXP_ZERO_HG);
          v4u w; w.x = pk2(o[0], o[1]); w.y = pk2(o[2], o[3]); w.z = pk2(o[4], o[5]); w.w = pk2(o[6], o[7]); *(v4u*)(MIX + (size_t)row * D + c0) = w; }
        { const v4u ya = *(const v4u*)(YA + (size_t)row * 512 + c0), yb = *(const v4u*)(YA + ((size_t)T + row) * 512 + c0);
          const float a0[4] = {bflo(ya.x), bfhi(ya.x), bflo(ya.y), bfhi(ya.y)}, a1[4] = {bflo(ya.z), bfhi(ya.z), bflo(ya.w), bfhi(ya.w)}, b0[4] = {bflo(yb.x), bfhi(yb.x), bflo(yb.y), bfhi(yb.y)}, b1[4] = {bflo(yb.z), bfhi(yb.z), bflo(yb.w), bfhi(yb.w)};
          const v4u x = *(const v4u*)(XBC + (size_t)row * M2XBC + c0), z = *(const v4u*)(PROJ + (size_t)row * EINP + 2560 + c0); const float dsk = m2_d[lane >> 3];
          const float xx[8] = {bflo(x.x), bfhi(x.x), bflo(x.y), bfhi(x.y), bflo(x.z), bfhi(x.z), bflo(x.w), bfhi(x.w)}; const float zz[8] = {bflo(z.x), bfhi(z.x), bflo(z.y), bfhi(z.y), bflo(z.z), bfhi(z.z), bflo(z.w), bfhi(z.w)};
#pragma unroll
          for (int e = 0; e < 4; ++e) { y[e] = (a0[e] + b0[e] + dsk * xx[e]) * silu_f(zz[e]); y[4 + e] = (a1[e] + b1[e] + dsk * xx[4 + e]) * silu_f(zz[4 + e]); } }
        float s2 = 0.f;
#pragma unroll
        for (int e = 0; e < 8; ++e) s2 += y[e] * y[e];
        s2 += sx(s2, 1, lane); s2 += sx(s2, 2, lane); s2 += sx(s2, 4, lane); s2 += sx(s2, 8, lane); s2 += sx(s2, 16, lane);
        const float r2 = 1.0f / sqrtf(s2 * (1.0f / 256.0f) + EPS);
        { const f32x4 w0 = *(const f32x4*)(m2_nw + c0), w1 = *(const f32x4*)(m2_nw + c0 + 4);
          if (EXP_ZERO_SSD) { for (int e = 0; e < 8; ++e) y[e] = 0.f; }
          v4u w; w.x = pk2(y[0] * r2 * w0[0], y[1] * r2 * w0[1]); w.y = pk2(y[2] * r2 * w0[2], y[3] * r2 * w0[3]); w.z = pk2(y[4] * r2 * w1[0], y[5] * r2 * w1[1]); w.w = pk2(y[6] * r2 * w1[2], y[7] * r2 * w1[3]);
          *(v4u*)(MIX + (size_t)row * D + 512 + c0) = w; }
    }
}

constexpr int MX_TD = 136, MX_SS = 72;
constexpr int MX_QT = 0, MX_KT = MX_QT + 64 * MX_TD * 2, MX_QH = MX_KT + 64 * MX_TD * 2, MX_KHT = MX_QH + 64 * MX_TD * 2, MX_VT = MX_KHT + 128 * MX_SS * 2, MX_VHT = MX_VT + 128 * MX_SS * 2;
constexpr int MX_F32 = MX_VHT + 128 * MX_SS * 2;
constexpr int MX_BS = 132;
static_assert(MX_VHT + (64 * MX_BS + 4 * 128 + 128) * 4 <= RING_BYTES && MX_F32 + 256 * 4 <= RING_BYTES, "mixer LDS map");
typedef short mx_bf16x8 __attribute__((ext_vector_type(8)));
typedef short mx_bf16x4 __attribute__((ext_vector_type(4)));
typedef float mx_f32x16 __attribute__((ext_vector_type(16)));
__device__ __forceinline__ mx_bf16x8 mx_pack8(const mx_f32x16& a, int base) {
    v4u w; w.x = pk2(a[base + 0], a[base + 1]); w.y = pk2(a[base + 2], a[base + 3]); w.z = pk2(a[base + 4], a[base + 5]); w.w = pk2(a[base + 6], a[base + 7]);
    return __builtin_bit_cast(mx_bf16x8, w);
}
__device__ __forceinline__ mx_bf16x8 mx_ld_perm(const LAS bf16* row, int k0, int h) {
    const v2u lo = *(const LAS v2u*)(row + k0 + 4 * h), hi = *(const LAS v2u*)(row + k0 + 8 + 4 * h);
    return __builtin_bit_cast(mx_bf16x8, (v4u){lo.x, lo.y, hi.x, hi.y});
}
#define MX_SW(row, col) ((row) * MX_SS + ((col) ^ ((((row) >> 4) & 7) << 3)))
__device__ __forceinline__ mx_bf16x8 mx_ld_perm_sw(const LAS bf16* row, int k0, int h, int g8) {
    const v2u lo = *(const LAS v2u*)(row + ((k0 ^ g8) + 4 * h)), hi = *(const LAS v2u*)(row + (((k0 + 8) ^ g8) + 4 * h));
    return __builtin_bit_cast(mx_bf16x8, (v4u){lo.x, lo.y, hi.x, hi.y});
}
template <int MODE>
__device__ __forceinline__ void mix_item(int item, const bf16* PROJ, const bf16* XBC, const float* DT, const float* lbv  , const float* a_log  , bf16* OUT  , LAS unsigned char* lds, int tid_unused, int lane, int wave, unsigned long long* tw = nullptr) {
    asm volatile("" : "+v"(lane));
    const int tid = wave * 64 + lane;
    const int dir = item & 1, hx = (item >> 1) & 3, b = item >> 3;
    LAS bf16* Qt = (LAS bf16*)(lds + MX_QT); LAS bf16* Kt = (LAS bf16*)(lds + MX_KT); LAS bf16* Qh = (LAS bf16*)(lds + MX_QH);
    LAS bf16* KhT = (LAS bf16*)(lds + MX_KHT); LAS bf16* VT = (LAS bf16*)(lds + MX_VT); LAS bf16* VhT = (LAS bf16*)(lds + MX_VHT);
    LAS float* bloc = (LAS float*)(lds + MX_VHT);
    LAS float* qsum = bloc + 64 * MX_BS;
    LAS float* lam = qsum + 4 * 128;
    LAS float* s_da = (LAS float*)(lds + MX_F32);
    LAS float* s_dt = s_da + 128;
    const int vs = wave & 3, tb = wave >> 2, l31 = lane & 31, lh = lane >> 5;
    mx_f32x16 Sacc[4];
#pragma unroll
    for (int db = 0; db < 4; ++db)
#pragma unroll
        for (int e = 0; e < 16; ++e) Sacc[db][e] = 0.f;
    float Aneg[2] = {0.f, 0.f};
    if (MODE == 1) { Aneg[0] = -expf(a_log[dir * 8 + 2 * hx]); Aneg[1] = -expf(a_log[dir * 8 + 2 * hx + 1]); }
#define MX_TOK(c, t) ((size_t)b * SEQ + (dir == 0 ? (64 * (c) + (t)) : (SEQ - 1 - (64 * (c) + (t)))))
#if EXP_MIXTIME
#define MXT(k) do { if (tw && blockIdx.x == 0 && tid == 0) { const unsigned long long now_ = wall_clock64(); tw[k] += now_ - tlast_; tlast_ = now_; } } while (0)
    unsigned long long tlast_ = wall_clock64();
#else
#define MXT(k) do { } while (0)
#endif
    v4u rq[2], rf[2], rv[2]; float rdt = 0.f; float lb8[8];
#pragma unroll
    for (int e = 0; e < 8; ++e) lb8[e] = MODE == 0 ? lbv[hx * 128 + 8 * (tid & 15) + e] : 0.f;
#define MX_LOAD(cc) do { _Pragma("unroll") for (int u_ = 0; u_ < 2; ++u_) { const int pi_ = tid + 512 * u_, t_ = pi_ >> 4, d0_ = 8 * (pi_ & 15); const size_t tok_ = MX_TOK(cc, t_); \
        if (MODE == 0) { rq[u_] = *(const v4u*)(PROJ + tok_ * EINP + hx * 128 + d0_); rf[u_] = *(const v4u*)(PROJ + tok_ * EINP + (dir == 0 ? 512 : 1024) + hx * 128 + d0_); rv[u_] = *(const v4u*)(PROJ + tok_ * EINP + 1536 + hx * 128 + d0_); } \
        else { rq[u_] = *(const v4u*)(XBC + tok_ * M2XBC + 768 + (hx >> 1) * 128 + d0_); rf[u_] = *(const v4u*)(XBC + tok_ * M2XBC + 512 + (hx >> 1) * 128 + d0_); rv[u_] = *(const v4u*)(XBC + tok_ * M2XBC + hx * 128 + d0_); } } \
        if (MODE == 1 && tid < 128) rdt = DT[MX_TOK(cc, tid & 63) * 16 + dir * 8 + 2 * hx + (tid >> 6)]; } while (0)
    MX_LOAD(0);
    for (int c = 0; c < SEQ / 64; ++c) {
#pragma unroll
        for (int u = 0; u < 2; ++u) {
            const int pi = tid + 512 * u, t = pi >> 4, d0 = 8 * (pi & 15); const size_t tok = MX_TOK(c, t);
            if (MODE == 0) {
                const v4u qv = rq[u], fv = rf[u], vv = rv[u];
                const unsigned qw[4] = {qv.x, qv.y, qv.z, qv.w}, fw[4] = {fv.x, fv.y, fv.z, fv.w}, vw[4] = {vv.x, vv.y, vv.z, vv.w};
                float lf[8], qq[8], kk[8];
#pragma unroll
                for (int e = 0; e < 8; ++e) { const float qp = (e & 1) ? bfhi(qw[e >> 1]) : bflo(qw[e >> 1]), fp = (e & 1) ? bfhi(fw[e >> 1]) : bflo(fw[e >> 1]); const float lbe = lb8[e];
                    const float sg = sigm(fp), f = fmaxf(lbe, 1e-30f) + (1.f - lbe) * sg; qq[e] = silu_f(qp); kk[e] = (1.f - lbe) * (1.f - sg); lf[e] = __logf(f);
                    VT[MX_SW(d0 + e, t)] = (bf16)((e & 1) ? (vw[e >> 1] >> 16) : (vw[e >> 1] & 0xffffu)); }
                *(LAS f32x4*)(bloc + t * MX_BS + d0) = (f32x4){lf[0], lf[1], lf[2], lf[3]}; *(LAS f32x4*)(bloc + t * MX_BS + d0 + 4) = (f32x4){lf[4], lf[5], lf[6], lf[7]};
                *(LAS v4u*)(Qt + t * MX_TD + d0) = (v4u){pk2(qq[0], qq[1]), pk2(qq[2], qq[3]), pk2(qq[4], qq[5]), pk2(qq[6], qq[7])};
                *(LAS v4u*)(Kt + t * MX_TD + d0) = (v4u){pk2(kk[0], kk[1]), pk2(kk[2], kk[3]), pk2(kk[4], kk[5]), pk2(kk[6], kk[7])};
            } else {
                const v4u cv = rq[u], bv = rf[u], xv = rv[u];
                *(LAS v4u*)(Qt + t * MX_TD + d0) = cv; *(LAS v4u*)(Kt + t * MX_TD + d0) = bv; *(LAS v4u*)(Qh + t * MX_TD + d0) = xv;
                const unsigned bw[4] = {bv.x, bv.y, bv.z, bv.w}, xw[4] = {xv.x, xv.y, xv.z, xv.w};
#pragma unroll
                for (int e = 0; e < 8; ++e) { const unsigned bb = (e & 1) ? (bw[e >> 1] >> 16) : (bw[e >> 1] & 0xffffu), xx = (e & 1) ? (xw[e >> 1] >> 16) : (xw[e >> 1] & 0xffffu);
                    KhT[MX_SW(d0 + e, t)] = (bf16)bb; VT[MX_SW(d0 + e, t)] = (bf16)xx; }
            }
        }
        if (MODE == 1 && tid < 128) { const int hh = tid >> 6, t = tid & 63; s_da[hh * 64 + t] = rdt * Aneg[hh]; s_dt[hh * 64 + t] = rdt; }
        if (c + 1 < SEQ / 64) MX_LOAD(c + 1);
        __syncthreads(); MXT(0);
        if (MODE == 0) { const int d = tid & 127, tq = tid >> 7; float run = 0.f;
#pragma unroll
            for (int i = 0; i < 16; ++i) { run += bloc[(16 * tq + i) * MX_BS + d]; bloc[(16 * tq + i) * MX_BS + d] = run; }
            qsum[tq * 128 + d] = run;
        } else if (wave < 2) { float v = s_da[wave * 64 + lane];
#pragma unroll
            for (int o = 1; o < 64; o <<= 1) { const float up = __builtin_bit_cast(float, __builtin_amdgcn_ds_bpermute((lane - o) << 2, __builtin_bit_cast(int, v))); if (lane >= o) v += up; }
            s_da[wave * 64 + lane] = v; }
        __syncthreads(); MXT(1);
        if (MODE == 0) {
            const int d0 = 8 * (tid & 15);
            float br[8], be[8], Er[8], Eeb[8];
#pragma unroll
            for (int hf = 0; hf < 2; ++hf) { const int dd = d0 + 4 * hf;
                const f32x4 q0 = *(const LAS f32x4*)(qsum + dd), q1 = *(const LAS f32x4*)(qsum + 128 + dd), q2 = *(const LAS f32x4*)(qsum + 256 + dd);
                const f32x4 r = *(const LAS f32x4*)(bloc + 31 * MX_BS + dd), en = *(const LAS f32x4*)(bloc + 63 * MX_BS + dd);
#pragma unroll
                for (int e = 0; e < 4; ++e) { br[4 * hf + e] = r[e] + q0[e]; be[4 * hf + e] = en[e] + q0[e] + q1[e] + q2[e]; } }
#pragma unroll
            for (int e = 0; e < 8; ++e) { Er[e] = __expf(br[e]); Eeb[e] = __expf(be[e] - br[e]); }
            if ((tid >> 4) == 0) { *(LAS f32x4*)(lam + d0) = (f32x4){Er[0] * Eeb[0], Er[1] * Eeb[1], Er[2] * Eeb[2], Er[3] * Eeb[3]}; *(LAS f32x4*)(lam + d0 + 4) = (f32x4){Er[4] * Eeb[4], Er[5] * Eeb[5], Er[6] * Eeb[6], Er[7] * Eeb[7]}; }
#pragma unroll
            for (int u = 0; u < 2; ++u) {
                const int t = (tid + 512 * u) >> 4, tq = t >> 4;
                f32x4 x0 = *(const LAS f32x4*)(bloc + t * MX_BS + d0), x1 = *(const LAS f32x4*)(bloc + t * MX_BS + d0 + 4);
                for (int qq = 0; qq < tq; ++qq) { x0 += *(const LAS f32x4*)(qsum + 128 * qq + d0); x1 += *(const LAS f32x4*)(qsum + 128 * qq + d0 + 4); }
                const v4u qv = *(const LAS v4u*)(Qt + t * MX_TD + d0), kv = *(const LAS v4u*)(Kt + t * MX_TD + d0); const unsigned qw[4] = {qv.x, qv.y, qv.z, qv.w}, kw[4] = {kv.x, kv.y, kv.z, kv.w};
                float o1[8], o2[8], o3[8];
#pragma unroll
                for (int e = 0; e < 8; ++e) { const float bt = e < 4 ? x0[e] : x1[e - 4];
                    const float q = (e & 1) ? bfhi(qw[e >> 1]) : bflo(qw[e >> 1]), k = (e & 1) ? bfhi(kw[e >> 1]) : bflo(kw[e >> 1]);
                    const float E1 = __expf(bt - br[e]), R1 = __builtin_amdgcn_rcpf(E1);
                    o1[e] = q * E1; o2[e] = k * R1; o3[e] = q * (E1 * Er[e]);
                    KhT[MX_SW(d0 + e, t)] = (bf16)f2bf(k * (R1 * Eeb[e])); }
                *(LAS v4u*)(Qt + t * MX_TD + d0) = (v4u){pk2(o1[0], o1[1]), pk2(o1[2], o1[3]), pk2(o1[4], o1[5]), pk2(o1[6], o1[7])};
                *(LAS v4u*)(Kt + t * MX_TD + d0) = (v4u){pk2(o2[0], o2[1]), pk2(o2[2], o2[3]), pk2(o2[4], o2[5]), pk2(o2[6], o2[7])};
                *(LAS v4u*)(Qh + t * MX_TD + d0) = (v4u){pk2(o3[0], o3[1]), pk2(o3[2], o3[3]), pk2(o3[4], o3[5]), pk2(o3[6], o3[7])};
            }
        } else {
#pragma unroll
            for (int u = 0; u < 2; ++u) {
                const int pi = tid + 512 * u, t = pi >> 4, d0 = 8 * (pi & 15);
                const int hh = d0 >> 6; const float w = s_dt[hh * 64 + t] * __expf(s_da[hh * 64 + 63] - s_da[hh * 64 + t]);
                const v4u xv = *(const LAS v4u*)(Qh + t * MX_TD + d0); const unsigned xw[4] = {xv.x, xv.y, xv.z, xv.w};
#pragma unroll
                for (int e = 0; e < 8; ++e) VhT[MX_SW(d0 + e, t)] = (bf16)f2bf(((e & 1) ? bfhi(xw[e >> 1]) : bflo(xw[e >> 1])) * w);
            }
        }
        __syncthreads(); MXT(2);
        {
            mx_f32x16 acc;
#pragma unroll
            for (int e = 0; e < 16; ++e) acc[e] = 0.f;
            const LAS bf16* qrow = (MODE == 0 ? Qh : Qt) + (32 * tb + l31) * MX_TD;
#pragma unroll
            for (int db = 0; db < 4; ++db)
#pragma unroll
                for (int s2 = 0; s2 < 2; ++s2) acc = __builtin_amdgcn_mfma_f32_32x32x16_bf16(mx_pack8(Sacc[db], 8 * s2), mx_ld_perm(qrow, 32 * db + 16 * s2, lh), acc, 0, 0, 0);
            const int hh = vs >> 1;
            float acum_t = 0.f;
            if (MODE == 1) { acum_t = s_da[hh * 64 + 32 * tb + l31]; const float sc = __expf(acum_t);
#pragma unroll
                for (int e = 0; e < 16; ++e) acc[e] *= sc; }
            for (int sb = 0; sb <= tb; ++sb) {
                mx_f32x16 accP;
#pragma unroll
                for (int e = 0; e < 16; ++e) accP[e] = 0.f;
                const LAS bf16* krow = Kt + (32 * sb + l31) * MX_TD; const LAS bf16* q2row = Qt + (32 * tb + l31) * MX_TD;
#pragma unroll
                for (int ks = 0; ks < 8; ++ks) accP = __builtin_amdgcn_mfma_f32_32x32x16_bf16(*(const LAS mx_bf16x8*)(krow + 16 * ks + 8 * lh), *(const LAS mx_bf16x8*)(q2row + 16 * ks + 8 * lh), accP, 0, 0, 0);
#pragma unroll
                for (int i = 0; i < 4; ++i) {
                    f32x4 as4 = (f32x4){0.f, 0.f, 0.f, 0.f}, ds4 = (f32x4){1.f, 1.f, 1.f, 1.f};
                    if (MODE == 1) { as4 = *(const LAS f32x4*)(s_da + hh * 64 + 32 * sb + 8 * i + 4 * lh); ds4 = *(const LAS f32x4*)(s_dt + hh * 64 + 32 * sb + 8 * i + 4 * lh); }
#pragma unroll
                    for (int e = 0; e < 4; ++e) { const int sl = 8 * i + 4 * lh + e; float p = accP[4 * i + e];
                        if (MODE == 1) p *= __expf(fminf(acum_t - as4[e], 0.f)) * ds4[e];
                        accP[4 * i + e] = (sb < tb || sl <= l31) ? p : 0.f; }
                    if (MODE == 1) asm volatile("" ::: "memory");
                }
                const int vr = 32 * vs + l31; const LAS bf16* vrow = VT + vr * MX_SS; const int vg = ((vr >> 4) & 7) << 3;
#pragma unroll
                for (int s2 = 0; s2 < 2; ++s2) acc = __builtin_amdgcn_mfma_f32_32x32x16_bf16(mx_ld_perm_sw(vrow, 32 * sb + 16 * s2, lh, vg), mx_pack8(accP, 8 * s2), acc, 0, 0, 0);
            }
            { const size_t tok = MX_TOK(c, 32 * tb + l31); bf16* orow = OUT + ((size_t)dir * T + tok) * 512 + hx * 128 + 32 * vs + 4 * lh;
#pragma unroll
              for (int i = 0; i < 4; ++i) *(v2u*)(orow + 8 * i) = (v2u){pk2(acc[4 * i], acc[4 * i + 1]), pk2(acc[4 * i + 2], acc[4 * i + 3])}; }
            const int vhr = 32 * vs + l31, vhg = ((vhr >> 4) & 7) << 3; const LAS bf16* vhrow = (MODE == 0 ? VT : VhT) + vhr * MX_SS;
            const float lamh = (MODE == 1) ? __expf(s_da[hh * 64 + 63]) : 0.f;
#pragma unroll
            for (int db = 0; db < 4; ++db) {
                if (MODE == 0) {
#pragma unroll
                    for (int i = 0; i < 4; ++i) { const f32x4 lm = *(const LAS f32x4*)(lam + 32 * db + 8 * i + 4 * lh);
#pragma unroll
                        for (int e = 0; e < 4; ++e) Sacc[db][4 * i + e] *= lm[e]; }
                } else {
#pragma unroll
                    for (int e = 0; e < 16; ++e) Sacc[db][e] *= lamh;
                }
                const int kr = 32 * db + l31, kg = ((kr >> 4) & 7) << 3; const LAS bf16* khrow = KhT + kr * MX_SS;
#pragma unroll
                for (int ks = 0; ks < 4; ++ks) Sacc[db] = __builtin_amdgcn_mfma_f32_32x32x16_bf16(*(const LAS mx_bf16x8*)(khrow + ((16 * ks + 8 * lh) ^ kg)), *(const LAS mx_bf16x8*)(vhrow + ((16 * ks + 8 * lh) ^ vhg)), Sacc[db], 0, 0, 0);
            }
        }
        __syncthreads(); MXT(3);
    }
#undef MX_TOK
#undef MX_LOAD
#undef MXT
}

__device__ __forceinline__ void s5_item(int item, int j, const Args& a, const float* nw  , const bf16* HN, float* YS  , int lane) {
    const int dir = item & 1, g = (item >> 1) & 63, b = item >> 7, n = lane;
    const size_t pg = ((size_t)(j * 2 + dir) * S5G + g);
    const float a_re = a.in[I_S5_A_RE][pg * S5N + n], a_im = a.in[I_S5_A_IM][pg * S5N + n];
    const float delta = expf(a.in[I_S5_LOG_STEP][pg]);
    const float mag = expf(a_re * delta); float sn, cs; sincosf(a_im * delta, &sn, &cs);
    const float lam_re = mag * cs, lam_im = mag * sn;
    const float den = a_re * a_re + a_im * a_im, num_re = lam_re - 1.0f;
    const float coef_re = (num_re * a_re + lam_im * a_im) / den, coef_im = (lam_im * a_re - num_re * a_im) / den;
    float bbr[16], bbi[16], cr[16], ci[16];
#pragma unroll
    for (int c = 0; c < 16; ++c) {
        const size_t bi_ = (((size_t)j * S5G + g) * S5N + n) * S5C + c;
        const float br = a.in[I_S5_B_RE][bi_], bi = a.in[I_S5_B_IM][bi_], w = nw[g * 16 + c];
        bbr[c] = (coef_re * br - coef_im * bi) * w; bbi[c] = (coef_re * bi + coef_im * br) * w;
        const size_t ci_ = (pg * S5C + c) * S5N + n;
        cr[c] = a.in[I_S5_C_RE][ci_]; ci[c] = a.in[I_S5_C_IM][ci_];
    }
    float hr = 0.f, hi = 0.f;
    for (int blk = 0; blk < SEQ / 64; ++blk) {
        const size_t tl = (size_t)b * SEQ + (dir == 0 ? (blk * 64 + lane) : (SEQ - 1 - (blk * 64 + lane)));
        const v4u u0 = *(const v4u*)(HN + tl * D + g * 16), u1 = *(const v4u*)(HN + tl * D + g * 16 + 8);
        const float uv[16] = {bflo(u0.x), bfhi(u0.x), bflo(u0.y), bfhi(u0.y), bflo(u0.z), bfhi(u0.z), bflo(u0.w), bfhi(u0.w), bflo(u1.x), bfhi(u1.x), bflo(u1.y), bfhi(u1.y), bflo(u1.z), bfhi(u1.z), bflo(u1.w), bfhi(u1.w)};
        for (int i = 0; i < 64; ++i) {
            float bur = 0.f, bui = 0.f;
#pragma unroll
            for (int c = 0; c < 16; ++c) { const float u = __builtin_bit_cast(float, __builtin_amdgcn_readlane(__builtin_bit_cast(int, uv[c]), i)); bur += bbr[c] * u; bui += bbi[c] * u; }
            const float nhr = lam_re * hr - lam_im * hi + bur, nhi = lam_re * hi + lam_im * hr + bui; hr = nhr; hi = nhi;
            float y[16];
#pragma unroll
            for (int c = 0; c < 16; ++c) y[c] = cr[c] * hr - ci[c] * hi;
            const bool b5 = (lane & 32) != 0, b4 = (lane & 16) != 0, b3 = (lane & 8) != 0, b2 = (lane & 4) != 0;
            float a8[8], a4[4], a2[2], a1;
#pragma unroll
            for (int k = 0; k < 8; ++k) { const float send = b5 ? y[k] : y[k + 8], keep = b5 ? y[k + 8] : y[k]; a8[k] = keep + sx(send, 32, lane); }
#pragma unroll
            for (int k = 0; k < 4; ++k) { const float send = b4 ? a8[k] : a8[k + 4], keep = b4 ? a8[k + 4] : a8[k]; a4[k] = keep + sx(send, 16, lane); }
#pragma unroll
            for (int k = 0; k < 2; ++k) { const float send = b3 ? a4[k] : a4[k + 2], keep = b3 ? a4[k + 2] : a4[k]; a2[k] = keep + sx(send, 8, lane); }
            { const float send = b2 ? a2[0] : a2[1], keep = b2 ? a2[1] : a2[0]; a1 = keep + sx(send, 4, lane); }
            a1 += sx(a1, 2, lane); a1 += sx(a1, 1, lane);
            const size_t ti = (size_t)b * SEQ + (dir == 0 ? (blk * 64 + i) : (SEQ - 1 - (blk * 64 + i)));
            if ((lane & 3) == 0) YS[((size_t)dir * T + ti) * D + g * 16 + (lane >> 2)] = a1;
        }
    }
}

constexpr int S5_BUS = 36, S5_HS = 136, S5_WAVE_LDS = 128 * S5_BUS * 4 + 32 * S5_HS * 2;
typedef short s5_bf16x8 __attribute__((ext_vector_type(8)));
typedef float s5_f32x16 __attribute__((ext_vector_type(16)));
__device__ __forceinline__ void s5_item_mfma(int item, int j, const Args& a, const float* nw  , const bf16* HN, bf16* YS  , LAS unsigned char* wl, int lane) {
    const int dir = item & 1, g = (item >> 1) & 63, b = item >> 7;
    const size_t pg = ((size_t)(j * 2 + dir) * S5G + g);
    const float delta = expf(a.in[I_S5_LOG_STEP][pg]);
    LAS float* buT = (LAS float*)wl;
    LAS bf16* Hl = (LAS bf16*)(wl + 128 * S5_BUS * 4);
    float lam_re, lam_im;
    { const float a_re = a.in[I_S5_A_RE][pg * S5N + lane], a_im = a.in[I_S5_A_IM][pg * S5N + lane]; const float mag = expf(a_re * delta); float sn, cs; sincosf(a_im * delta, &sn, &cs); lam_re = mag * cs; lam_im = mag * sn; }
    s5_bf16x8 Bb[4];
    { const int col = lane & 31, h = lane >> 5;
#pragma unroll
      for (int q = 0; q < 4; ++q) { const int np = 32 * q + col, n = np & 63; const bool isIm = np >= 64;
          const float a_re = a.in[I_S5_A_RE][pg * S5N + n], a_im = a.in[I_S5_A_IM][pg * S5N + n]; const float mag = expf(a_re * delta); float sn, cs; sincosf(a_im * delta, &sn, &cs);
          const float lr = mag * cs, li = mag * sn, den = a_re * a_re + a_im * a_im, num_re = lr - 1.0f;
          const float coef_re = (num_re * a_re + li * a_im) / den, coef_im = (li * a_re - num_re * a_im) / den;
          unsigned w4[4];
#pragma unroll
          for (int jp = 0; jp < 4; ++jp) { float vv[2];
#pragma unroll
              for (int e = 0; e < 2; ++e) { const int c = 8 * h + 2 * jp + e; const size_t bi_ = (((size_t)j * S5G + g) * S5N + n) * S5C + c; const float br = a.in[I_S5_B_RE][bi_], bi = a.in[I_S5_B_IM][bi_];
                  vv[e] = (isIm ? (coef_re * bi + coef_im * br) : (coef_re * br - coef_im * bi)) * nw[g * 16 + c]; }
              w4[jp] = pk2(vv[0], vv[1]); }
          Bb[q] = __builtin_bit_cast(s5_bf16x8, (v4u){w4[0], w4[1], w4[2], w4[3]}); } }
    s5_bf16x8 Cb[4];
    { const int c = lane & 15, q4 = lane >> 4;
#pragma unroll
      for (int ks = 0; ks < 4; ++ks) { unsigned w4[4];
#pragma unroll
          for (int jp = 0; jp < 4; ++jp) { float vv[2];
#pragma unroll
              for (int e = 0; e < 2; ++e) { const int np = 32 * ks + 8 * q4 + 2 * jp + e, n = np & 63; const size_t ci_ = (pg * S5C + c) * S5N + n; vv[e] = np < 64 ? a.in[I_S5_C_RE][ci_] : -a.in[I_S5_C_IM][ci_]; }
              w4[jp] = pk2(vv[0], vv[1]); }
          Cb[ks] = __builtin_bit_cast(s5_bf16x8, (v4u){w4[0], w4[1], w4[2], w4[3]}); } }
    float hr = 0.f, hi = 0.f;
    const int ar = lane & 31, ah = lane >> 5;
#define S5_TOK(tile, r) ((size_t)b * SEQ + (dir == 0 ? (32 * (tile) + (r)) : (SEQ - 1 - (32 * (tile) + (r)))))
    v4u unext = *(const v4u*)(HN + S5_TOK(0, ar) * D + g * 16 + 8 * ah);
    for (int tile = 0; tile < SEQ / 32; ++tile) {
        const s5_bf16x8 Aop = __builtin_bit_cast(s5_bf16x8, unext);
        if (tile + 1 < SEQ / 32) unext = *(const v4u*)(HN + S5_TOK(tile + 1, ar) * D + g * 16 + 8 * ah);
#pragma unroll
        for (int q = 0; q < 4; ++q) { s5_f32x16 acc;
#pragma unroll
            for (int e = 0; e < 16; ++e) acc[e] = 0.f;
            acc = __builtin_amdgcn_mfma_f32_32x32x16_bf16(Aop, Bb[q], acc, 0, 0, 0);
#pragma unroll
            for (int i = 0; i < 4; ++i) *(LAS f32x4*)(buT + (32 * q + ar) * S5_BUS + 8 * i + 4 * ah) = (f32x4){acc[4 * i], acc[4 * i + 1], acc[4 * i + 2], acc[4 * i + 3]}; }
        LDS_WAIT();
#pragma unroll
        for (int k = 0; k < 8; ++k) { const f32x4 re4 = *(const LAS f32x4*)(buT + lane * S5_BUS + 4 * k), im4 = *(const LAS f32x4*)(buT + (64 + lane) * S5_BUS + 4 * k);
#pragma unroll
            for (int e = 0; e < 4; ++e) { const float nhr = lam_re * hr - lam_im * hi + re4[e], nhi = lam_re * hi + lam_im * hr + im4[e]; hr = nhr; hi = nhi;
                const unsigned hw = pk2(hr, hi); Hl[(4 * k + e) * S5_HS + lane] = (bf16)(hw & 0xffffu); Hl[(4 * k + e) * S5_HS + 64 + lane] = (bf16)(hw >> 16); } }
        LDS_WAIT();
#pragma unroll
        for (int m = 0; m < 2; ++m) { f32x4 acc = (f32x4){0.f, 0.f, 0.f, 0.f};
#pragma unroll
            for (int ks = 0; ks < 4; ++ks) { const s5_bf16x8 A2 = *(const LAS s5_bf16x8*)(Hl + (16 * m + (lane & 15)) * S5_HS + 32 * ks + 8 * (lane >> 4)); acc = __builtin_amdgcn_mfma_f32_16x16x32_bf16(A2, Cb[ks], acc, 0, 0, 0); }
#pragma unroll
            for (int e = 0; e < 4; ++e) YS[((size_t)dir * T + S5_TOK(tile, 16 * m + 4 * (lane >> 4) + e)) * D + g * 16 + (lane & 15)] = (bf16)f2bf(acc[e]); }
        LDS_WAIT();
    }
#undef S5_TOK
}
__device__ __forceinline__ void combine_s5_phase(const float* H, const float* nw, const float* dsk, const bf16* YS, bf16* MIX, int lane, int wave, int bid, int G) {
    const int gw = bid * NWAVES + wave, NGW = G * NWAVES;
    for (int row = gw; row < T; row += NGW) {
        f32x4 v[4]; const float rstd = load_row_rstd(H + (size_t)row * D, lane, v);
        const v2u* yf = (const v2u*)(YS + (size_t)row * D) + lane; const v2u* yb = (const v2u*)(YS + ((size_t)T + row) * D) + lane;
        const f32x4* wv = (const f32x4*)nw + lane; const f32x4* dv = (const f32x4*)dsk + lane;
        unsigned long long* o8 = (unsigned long long*)(MIX + (size_t)row * D) + lane;
#pragma unroll
        for (int jj = 0; jj < 4; ++jj) { const v2u fa = yf[64 * jj], fb = yb[64 * jj]; const f32x4 ys = (f32x4){bflo(fa.x) + bflo(fb.x), bfhi(fa.x) + bfhi(fb.x), bflo(fa.y) + bflo(fb.y), bfhi(fa.y) + bfhi(fb.y)};
            const f32x4 y = ys * (float)(1 - EXP_ZERO_S5) + dv[64 * jj] * (v[jj] * rstd * wv[64 * jj]);
            o8[64 * jj] = (unsigned long long)pk2(gelu_tanh(y[0]), gelu_tanh(y[1])) | ((unsigned long long)pk2(gelu_tanh(y[2]), gelu_tanh(y[3])) << 32); }
    }
}
__device__ __forceinline__ void router_phase(const float* H, unsigned char* HN8, const float* wr  , v4i* SEL, float* GATE, int* CNT, LAS unsigned char* lds, int tid, int lane, int wave, int bid, int G) {
    LAS float* wl = (LAS float*)lds;
    LAS int* lcnt = (LAS int*)(lds + 32768);
    for (int i = tid; i < D * 8; i += NTHR) wl[(i & 7) * D + (i >> 3)] = wr[i];
    for (int grp = bid; grp < T / 64; grp += G) {
        if (tid < 8) lcnt[tid] = 0;
        __syncthreads();
        for (int r = 0; r < 8; ++r) {
            const int row = grp * 64 + wave * 8 + r;
            f32x4 v[4]; const float rstd = load_row_rstd(H + (size_t)row * D, lane, v); store_row_fp8(HN8 + (size_t)row * D, lane, v, rstd);
            float lg[8];
#pragma unroll
            for (int e = 0; e < 8; ++e) { float s = 0.f;
#pragma unroll
                for (int jj = 0; jj < 4; ++jj) { const f32x4 w = *(const LAS f32x4*)(wl + e * D + 256 * jj + 4 * lane); s += (v[jj][0] * w[0] + v[jj][1] * w[1]) + (v[jj][2] * w[2] + v[jj][3] * w[3]); }
                lg[e] = wave_sum(s, lane) * rstd; }
            int e0 = 0; float l0 = lg[0];
#pragma unroll
            for (int e = 1; e < 8; ++e) if (lg[e] > l0) { l0 = lg[e]; e0 = e; }
            int e1 = -1; float l1 = -3.0e38f;
#pragma unroll
            for (int e = 0; e < 8; ++e) if (e != e0 && lg[e] > l1) { l1 = lg[e]; e1 = e; }
            const float g1 = 1.0f / (1.0f + expf(l0 - l1)), g0 = 1.0f - g1;
            if (lane == 0) { SEL[row] = (v4i){e0, e1, __builtin_bit_cast(int, g0), __builtin_bit_cast(int, g1)}; GATE[(size_t)row * 2] = g0; GATE[(size_t)row * 2 + 1] = g1; atomicAdd((int*)&lcnt[e0], 1); atomicAdd((int*)&lcnt[e1], 1); }
        }
        __syncthreads();
        if (tid < 8) CNT[grp * 8 + tid] = lcnt[tid];
        __syncthreads();
    }
}
__device__ __forceinline__ void scatter_phase(const unsigned char* HN8, const v4i* SEL, const int* CNT, int* SLOT, int* SEGB, unsigned char* XBUF8, LAS unsigned char* lds, int tid, int lane, int wave, int bid, int G) {
    LAS int* ltot = (LAS int*)lds;
    LAS int* lbef = ltot + 8;
    LAS int* base = lbef + 8;
    LAS int* wcnt = base + 8;
    for (int grp = bid; grp < T / 64; grp += G) {
        if (tid < 16) ltot[tid] = 0;
        __syncthreads();
        { const int e = tid & 7, q = tid >> 3; int tot = 0, bef = 0;
#pragma unroll
          for (int k = 0; k < 4; ++k) { const int g2 = q + 64 * k; const int c = CNT[g2 * 8 + e]; tot += c; bef += (g2 < grp) ? c : 0; }
          atomicAdd((int*)&ltot[e], tot); atomicAdd((int*)&lbef[e], bef); }
        __syncthreads();
        if (tid == 0) { int sb = 0;
            for (int e = 0; e < 8; ++e) { base[e] = sb + lbef[e]; if (grp == 0) SEGB[e] = sb; sb += (ltot[e] + 255) & ~255; }
            if (grp == 0) SEGB[8] = sb; }
        const int r0 = grp * 64 + wave * 8;
        int myE = -1;
        if (lane < 16) { const v4i s = SEL[r0 + (lane >> 1)]; myE = (lane & 1) ? s[1] : s[0]; }
        int rank = 0, cntMine = 0;
#pragma unroll
        for (int e = 0; e < 8; ++e) { const unsigned long long m = __ballot(myE == e); const int c = __popcll(m); if (lane == e) cntMine = c; if (myE == e) rank = __popcll(m & ((1ull << lane) - 1ull)); }
        if (lane < 8) wcnt[wave * 8 + lane] = cntMine;
        __syncthreads();
        int slot = 0;
        if (lane < 16) { int pre = 0; for (int w = 0; w < wave; ++w) pre += wcnt[w * 8 + myE]; slot = base[myE] + pre + rank; SLOT[(size_t)(r0 + (lane >> 1)) * 2 + (lane & 1)] = slot; }
        for (int i = 0; i < 16; ++i) { const int sl = __builtin_amdgcn_readlane(slot, i); const int row = r0 + (i >> 1);
            const v4u* src = (const v4u*)(HN8 + (size_t)row * D); v4u* dst = (v4u*)(XBUF8 + (size_t)sl * D);
            dst[lane] = src[lane]; }
        __syncthreads();
    }
}

#if EXP_PROBE
__device__ __forceinline__ void probe_moe(const float* H, const float* nw, const float* router, const float* w_gu, const float* w_down, const v4i* SEL, const int* SLOT, const float* YBUF, int* diag,
                                          LAS unsigned char* lds, int tid, int lane, int wave, int bid) {
    LAS float* xt = (LAS float*)lds;
    LAS float* act = xt + 1024;
    LAS float* red = act + 3584;
    const int t = (bid * 61 + 7) & (T - 1);
    if (wave == 0) { f32x4 v[4]; const float rstd = load_row_rstd(H + (size_t)t * D, lane, v);
#pragma unroll
        for (int j = 0; j < 4; ++j) { const f32x4 w = ((const f32x4*)nw)[64 * j + lane]; *(LAS f32x4*)(xt + 256 * j + 4 * lane) = v[j] * rstd * w; } }
    __syncthreads();
    if (tid < 8) { float s = 0.f; for (int c = 0; c < D; ++c) s += xt[c] * router[c * 8 + tid]; red[tid] = s; }
    __syncthreads();
    int e0 = 0; float l0 = red[0];
    for (int e = 1; e < 8; ++e) if (red[e] > l0) { l0 = red[e]; e0 = e; }
    int e1 = -1; float l1 = -3.0e38f;
    for (int e = 0; e < 8; ++e) if (e != e0 && red[e] > l1) { l1 = red[e]; e1 = e; }
    const v4i sel = SEL[t];
    int code = 0;
    if (sel[0] != e0 || sel[1] != e1) code = 10;
    const float g1 = 1.0f / (1.0f + expf(l0 - l1)), g0 = 1.0f - g1;
    if (code == 0 && (fabsf(g0 - __builtin_bit_cast(float, sel[2])) > 1e-3f || fabsf(g1 - __builtin_bit_cast(float, sel[3])) > 1e-3f)) code = 9;
    __syncthreads();
    int cc[2] = {0, 0};
    for (int k = 0; k < 2; ++k) {
        const int e = k == 0 ? e0 : e1; const float* wg = w_gu + (size_t)e * D * 2 * FF; const float* wd = w_down + (size_t)e * FF * D;
        float ag[7], au[7];
        for (int q = 0; q < 7; ++q) { ag[q] = 0.f; au[q] = 0.f; }
        for (int c = 0; c < D; ++c) { const float x = xt[c];
#pragma unroll
            for (int q = 0; q < 7; ++q) { ag[q] += x * wg[(size_t)c * 2 * FF + tid + 512 * q]; au[q] += x * wg[(size_t)c * 2 * FF + FF + tid + 512 * q]; } }
#pragma unroll
        for (int q = 0; q < 7; ++q) act[tid + 512 * q] = ag[q] * sigm(ag[q]) * au[q];
        __syncthreads();
        float y0 = 0.f, y1 = 0.f;
        for (int f = 0; f < FF; ++f) { const float a = act[f]; y0 += a * wd[(size_t)f * D + tid]; y1 += a * wd[(size_t)f * D + 512 + tid]; }
        const int slot = SLOT[(size_t)t * 2 + k];
        const float m0 = YBUF[(size_t)slot * D + tid], m1 = YBUF[(size_t)slot * D + 512 + tid];
        float er = (m0 - y0) * (m0 - y0) + (m1 - y1) * (m1 - y1), rf = y0 * y0 + y1 * y1;
        er = wave_sum(er, lane); rf = wave_sum(rf, lane);
        __syncthreads();
        if (lane == 0) { red[16 + wave] = er; red[32 + wave] = rf; }
        __syncthreads();
        float E = 0.f, R = 0.f; for (int w = 0; w < 8; ++w) { E += red[16 + w]; R += red[32 + w]; }
        const float rel = E / (R + 1e-20f);
        cc[k] = rel < 1e-3f ? 0 : (rel < 0.1f ? 1 : 2);
        __syncthreads();
    }
    if (code == 0) code = cc[0] * 3 + cc[1];
    { const float sg0 = __builtin_bit_cast(float, sel[2]), sg1 = __builtin_bit_cast(float, sel[3]); int c2 = (int)(sg0 * 10.f); if (c2 < 0) c2 = 0; if (c2 > 12) c2 = 12;
      if (fabsf(sg0 + sg1 - 1.f) > 1e-3f) { int c3 = (int)((sg0 + sg1) * 5.f); if (c3 < 0) c3 = 0; if (c3 > 9) c3 = 9; c2 = 13 + c3; }
      code = c2; }
    if (tid == 0 && bid == 0) atomicMax(diag, code);
}
#endif
__device__ __forceinline__ void moe_combine_norm_phase(float* H, const bf16* YBUF, const float* GATE, const int* SLOT, bf16* HN, int lane, int wave, int bid, int G, const int* SEGBp = nullptr, int* diag = nullptr, float mscl = 1.f) {
    const int gw = bid * NWAVES + wave, NGW = G * NWAVES;
    for (int row = gw; row < T; row += NGW) {
        const int s0 = SLOT[(size_t)row * 2], s1 = SLOT[(size_t)row * 2 + 1]; const float g0 = GATE[(size_t)row * 2], g1 = GATE[(size_t)row * 2 + 1];
        f32x4* hr = (f32x4*)(H + (size_t)row * D) + lane; const v2u* y0 = (const v2u*)(YBUF + (size_t)s0 * D) + lane; const v2u* y1 = (const v2u*)(YBUF + (size_t)s1 * D) + lane;
        f32x4 v[4]; float ss = 0.f;
#pragma unroll
        for (int jj = 0; jj < 4; ++jj) { const v2u p0 = y0[64 * jj], p1 = y1[64 * jj]; const f32x4 ya = (f32x4){bflo(p0.x), bfhi(p0.x), bflo(p0.y), bfhi(p0.y)}, yb = (f32x4){bflo(p1.x), bfhi(p1.x), bflo(p1.y), bfhi(p1.y)};
            v[jj] = hr[64 * jj] + (g0 * ya + g1 * yb) * mscl; hr[64 * jj] = v[jj]; ss += (v[jj][0] * v[jj][0] + v[jj][1] * v[jj][1]) + (v[jj][2] * v[jj][2] + v[jj][3] * v[jj][3]); }
        const float rstd = 1.0f / sqrtf(wave_sum(ss, lane) * (1.0f / D) + EPS);
        store_row_bf16(HN + (size_t)row * D, lane, v, rstd);
    }
}

#ifndef MK_ONE_LAUNCH
#define MK_ONE_LAUNCH 1
#endif
constexpr int PH_PER_LAYER = 11, PH_LAYER0 = 2, N_PHASES = PH_LAYER0 + 4 * PH_PER_LAYER + 1;

#define H ((float*)(ws + WS_H))
#define HN ((bf16*)(ws + WS_HN))
#define MIX ((bf16*)(ws + WS_MIX))
#define PB ((bf16*)(ws + WS_PB))
#define PP ((bf16*)(ws + WS_PP))
#define XBUF ((bf16*)(ws + WS_XBUF))
#define YBUF ((float*)(ws + WS_YBUF))
#define DT ((float*)(ws + WS_DT))
#define SEL ((v4i*)(ws + WS_ROUTE))
#define SLOT ((int*)(ws + WS_ROUTE + 256 * 1024))
#define GATE ((float*)(ws + WS_ROUTE + 512 * 1024))
#define CNT ((int*)(ws + WS_ROUTE + 384 * 1024))
#define SEGB ((int*)(ws + WS_ROUTE + 400 * 1024))
#define PROJ ((bf16*)(ws + WS_PROJ))
#define XBC ((bf16*)(ws + WS_XBC))
#define OA ((bf16*)(ws + WS_OA))
#define YA ((bf16*)(ws + WS_YA))
#define ACT ((bf16*)(ws + WS_ACT))
#define YS ((bf16*)(ws + WS_YS))
__global__ void __launch_bounds__(NTHR, 2) fwd(Args args) {
    extern __shared__ __attribute__((aligned(16))) unsigned char lds_raw[];
    LAS unsigned char* lds = (LAS unsigned char*)lds_raw;
    volatile LAS unsigned* MISC = (volatile LAS unsigned*)(lds + MISC_OFF);
    const int G0 = gridDim.x, bid0 = blockIdx.x, wave_s = __builtin_amdgcn_readfirstlane((int)threadIdx.x >> 6);
    if (threadIdx.x < 32) MISC[threadIdx.x] = 0u;
#if defined(__HIP_DEVICE_COMPILE__)
#define ASSUME_GLOBAL(p) do { __builtin_assume(!__builtin_amdgcn_is_shared((const __attribute__((address_space(0))) void*)(p))); __builtin_assume(!__builtin_amdgcn_is_private((const __attribute__((address_space(0))) void*)(p))); } while (0)
#else
#define ASSUME_GLOBAL(p) do { } while (0)
#endif
#define PHASE_IDS() int G = G0, bid = bid0; asm volatile("" : "+s"(G), "+s"(bid)); unsigned char* ws = args.ws; asm volatile("" : "+s"(ws) :: "memory"); ASSUME_GLOBAL(ws); int lane; asm volatile("v_mbcnt_lo_u32_b32 %0, -1, 0\n\tv_mbcnt_hi_u32_b32 %0, -1, %0" : "=v"(lane)); const int wave = wave_s, tid = wave * 64 + lane; (void)tid
    __syncthreads();
    XcdBarrier bar; bar.bar = (unsigned*)(args.ws + WS_CTL) + CW_BAR; bar.x = 0; bar.st = nullptr;
    if (MK_ONE_LAUNCH) { bar = xcd_barrier_post((unsigned*)(args.ws + WS_CTL) + CW_BAR, MISC + 8); bar.x = (unsigned)__builtin_amdgcn_readfirstlane((int)bar.x); }
#if EXP_TIMING
#define SEAM_CAT(cat) do { if (MK_ONE_LAUNCH) { XcdBarrier bb_ = bar; asm volatile("" : "+s"(bb_.x), "+s"(bb_.bar)); xcd_barrier(bb_); } if (blockIdx.x == 0 && threadIdx.x == 0) { unsigned long long* tw = (unsigned long long*)(args.ws + WS_CTL + 1024); const unsigned long long now = wall_clock64(); if (tw[0]) tw[1 + (cat)] += now - tw[0]; tw[0] = now; } } while (0)
#else
#define SEAM_CAT(cat) do { if (MK_ONE_LAUNCH) { XcdBarrier bb_ = bar; asm volatile("" : "+s"(bb_.x), "+s"(bb_.bar)); xcd_barrier(bb_); } } while (0)
#endif
#define SEAM() SEAM_CAT(4)
#if EXP_TIMING
    if (blockIdx.x == 0 && threadIdx.x == 0) { unsigned long long* tw = (unsigned long long*)(args.ws + WS_CTL + 1024); tw[0] = wall_clock64(); }
#endif
    const int lo = args.ph_lo, hi = args.ph_hi; (void)lo; (void)hi;
#if MK_ONE_LAUNCH
#define IN(k) true
#else
#define IN(k) (lo <= (k) && (k) < hi)
#endif
    const float* x = args.in[I_X];

    if (IN(0)) { PHASE_IDS(); prologue_phase(args, ws, lds, tid, lane, wave, bid, G); SEAM_CAT(0); }
    if (IN(1)) { PHASE_IDS();
        pg8::StackOrder S; S.init(PB, (const bf16*)(ws + WS_WPP), DEPTH * T, D, PLE, 6  , G, bid);
        pg8::EpiBf16 E{PP, D};
        int Kp = PLE; asm volatile("" : "+s"(Kp));
        pg8::gemm_phase<pg8::EpiBf16, pg8::StackOrder, true, true>(lds, Kp, S, E, wave_s);
        SEAM_CAT(1);
    }
    for (int l = 0; l < DEPTH; ++l) {
        const int pb = PH_LAYER0 + PH_PER_LAYER * l, j = l >> 1;
        if ((l & 1) == 0) {
            if (IN(pb + 0)) { PHASE_IDS(); norm_even_phase((l == 0) ? x : H, HN, (const float*)(ws + WS_WDT) + (size_t)j * D * 16, args.in[I_M2_DT_BIAS] + j * 16, DT, lds, tid, lane, wave, bid, G); SEAM(); }
            if (IN(pb + 1)) { PHASE_IDS();
                pg8::StaticOrder S; S.init(HN, (const bf16*)(ws + WS_WIN) + (size_t)j * EINP * D, T, EINP, D, G, bid);
                pg8::EpiBf16 E{PROJ, EINP};
                pg8::gemm_phase<pg8::EpiBf16, pg8::StaticOrder, true, true>(lds, D, S, E, wave_s);
                SEAM_CAT(1);
            }
            if (IN(pb + 2)) { PHASE_IDS(); conv_phase(PROJ, args.in[I_M2_CONV_W] + (size_t)j * 5 * M2XBC, args.in[I_M2_CONV_B] + (size_t)j * M2XBC, XBC, tid, bid, G); SEAM(); }
            if (IN(pb + 3)) { PHASE_IDS();
#if MIX_MFMA
                { const int spare = G > 128 ? G - 128 : G, cb = G > 128 ? bid - 128 : bid;
                  if (cb >= 0) { LAS float* scr = (LAS float*)(lds + wave * TR_LDS); if (G <= 128) __syncthreads();
                      for (int it = cb * NWAVES + wave; it < CN_MOE; it += spare * NWAVES) convert_moe_item(args, ws, j, scr, it, lane); if (G <= 128) __syncthreads(); } }
                for (int it = bid; it < 128; it += G) {
                    if ((it & 1) == 0) mix_item<0>(it >> 1, PROJ, XBC, DT, (const float*)(ws + WS_WDT + 512 * 1024) + j * HGW, nullptr, OA, lds, tid, lane, wave, (unsigned long long*)(ws + WS_CTL + 2048));
                    else mix_item<1>(it >> 1, PROJ, XBC, DT, nullptr, args.in[I_M2_A_LOG] + j * 16, YA, lds, tid, lane, wave, (unsigned long long*)(ws + WS_CTL + 2048));
                }
#else
                for (int it = bid; it < 512; it += G) {
                    if (it < 256) scan_item<0>(it, PROJ, XBC, DT, (const float*)(ws + WS_WDT + 512 * 1024) + j * HGW, nullptr, OA, lds, tid);
                    else scan_item<1>(it - 256, PROJ, XBC, DT, nullptr, args.in[I_M2_A_LOG] + j * 16, YA, lds, tid);
                }
#endif
                SEAM_CAT(2);
            }
            if (IN(pb + 4)) { PHASE_IDS(); combine_even_phase(PROJ, XBC, OA, YA, args.in[I_HG_NORM_W] + j * HGW, args.in[I_M2_D] + j * M2H, args.in[I_M2_NORM_W] + j * M2I, MIX, lane, wave, bid, G); SEAM(); }
            if (IN(pb + 5)) { PHASE_IDS();
                pg8::StaticOrder S; S.init(MIX, (const bf16*)(ws + WS_WOUT) + (size_t)j * D * D, T, D, D, G, bid);
                pg8::EpiResF32 E{H, (l == 0) ? x : H, D};
                pg8::gemm_phase<pg8::EpiResF32, pg8::StaticOrder, true, true>(lds, D, S, E, wave_s);
                SEAM_CAT(1);
            }
            if (IN(pb + 6)) { PHASE_IDS(); norm_phase(H, HN, lane, wave, bid, G); SEAM(); }
            if (IN(pb + 7)) { PHASE_IDS();
                pg8::StaticOrder S; S.init(HN, (const bf16*)(ws + WS_WGU) + (size_t)j * 2 * FF * D, T, 2 * FF, D, G, bid);
                pg8::EpiSwiGLU E{ACT, FF};
                pg8::gemm_phase<pg8::EpiSwiGLU, pg8::StaticOrder, true, true>(lds, D, S, E, wave_s);
                SEAM_CAT(1);
            }
            if (IN(pb + 8) && !EXP_ZERO_FFN) { PHASE_IDS();
                pg8::StaticOrder S; S.init(ACT, (const bf16*)(ws + WS_WDN) + (size_t)j * D * FF, T, D, FF, G, bid);
                pg8::EpiResF32 E{H, H, D};
                pg8::gemm_phase<pg8::EpiResF32, pg8::StaticOrder, true, true>(lds, FF, S, E, wave_s);
                SEAM_CAT(1);
            }
            if (IN(pb + 9)) { PHASE_IDS(); norm_phase(H, HN, lane, wave, bid, G); SEAM(); }
        } else {
            if (IN(pb + 0)) { PHASE_IDS(); norm_phase(H, HN, lane, wave, bid, G); SEAM(); }
            if (IN(pb + 1)) { PHASE_IDS();
#if S5_MFMA
                if (wave < 4) for (int it = wave * G + bid; it < NB * S5G * 2; it += G * 4) s5_item_mfma(it, j, args, args.in[I_NORM_MIX] + l * D, HN, YS, lds + wave * S5_WAVE_LDS, lane);
#else
                for (int it = wave * G + bid; it < NB * S5G * 2; it += G * NWAVES) s5_item(it, j, args, args.in[I_NORM_MIX] + l * D, HN, (float*)YS, lane);
#endif
                SEAM_CAT(3);
            }
            if (IN(pb + 2)) { PHASE_IDS(); combine_s5_phase(H, args.in[I_NORM_MIX] + l * D, args.in[I_S5_D] + j * D, YS, MIX, lane, wave, bid, G); SEAM(); }
            if (IN(pb + 3)) { PHASE_IDS();
                pg8::StaticOrder S; S.init(MIX, (const bf16*)(ws + WS_WGLU) + (size_t)j * 2 * D * D, T, 2 * D, D, G, bid);
                float sclg = EXP_ZERO_GLU ? 0.f : 1.f; asm volatile("" : "+s"(sclg)); pg8::EpiGluRes E{H, D, sclg};
                pg8::gemm_phase<pg8::EpiGluRes, pg8::StaticOrder, true, true>(lds, D, S, E, wave_s);
                SEAM_CAT(1);
            }
            if (IN(pb + 4)) { PHASE_IDS(); router_phase(H, (unsigned char*)HN, (const float*)(ws + WS_WDT + 256 * 1024) + (size_t)j * D * 8, SEL, GATE, CNT, lds, tid, lane, wave, bid, G); SEAM(); }
            if (IN(pb + 5)) { PHASE_IDS(); scatter_phase((const unsigned char*)HN, SEL, CNT, SLOT, SEGB, (unsigned char*)XBUF, lds, tid, lane, wave, bid, G); SEAM(); }
            if (IN(pb + 6)) { PHASE_IDS();
                pg8::MoeOrder S; S.init(XBUF, (const bf16*)(ws + WS_WMGU + (size_t)j * NE * 2 * FF * D), SEGB, 2 * FF, D / 2, G, bid);
                pg8::EpiSwiGLU8 E{(unsigned char*)ACT, FF};
                int Kg = D / 2; asm volatile("" : "+s"(Kg));
                pg8::gemm_phase<pg8::EpiSwiGLU8, pg8::MoeOrder, true, true, true, W8_GU_SC>(lds, Kg, S, E, wave_s);
                SEAM_CAT(1);
            }
            if (IN(pb + 7)) { PHASE_IDS();
                pg8::MoeOrder S; S.init(ACT, (const bf16*)(ws + WS_WMDN + (size_t)j * NE * D * FF), SEGB, D, FF / 2, G, bid);
                pg8::EpiBf16 E{(bf16*)YBUF, D};
                pg8::gemm_phase<pg8::EpiBf16, pg8::MoeOrder, true, true, true, W8_DN_SC>(lds, FF / 2, S, E, wave_s);
                SEAM_CAT(1);
            }
#if EXP_PROBE
            if (IN(pb + 8) && l == EXP_PROBE_LAYER) { PHASE_IDS(); probe_moe(H, args.in[I_NORM_FFN] + l * D, args.in[I_MOE_ROUTER] + (size_t)j * D * 8, args.in[I_MOE_W_GU] + (size_t)j * NE * D * 2 * FF, args.in[I_MOE_W_DOWN] + (size_t)j * NE * FF * D, SEL, SLOT, YBUF, (int*)(ws + WS_CTL) + 64, lds, tid, lane, wave, bid); __syncthreads(); }
#endif
            if (IN(pb + 9)) { PHASE_IDS(); moe_combine_norm_phase(H, (const bf16*)YBUF, GATE, SLOT, HN, lane, wave, bid, G, SEGB, (int*)(ws + WS_CTL) + 64, ((EXP_ZERO_MOE >> j) & 1) ? 0.f : 1.f); SEAM(); }
        }
        if (IN(pb + 10)) { PHASE_IDS();
            pg8::StaticOrder S; S.init(HN, (const bf16*)(ws + WS_WPG) + (size_t)l * D * D, T, D, D, G, bid);
            float sclp = EXP_ZERO_PLE ? 0.f : 1.f; asm volatile("" : "+s"(sclp)); pg8::EpiPle E{H, PP + (size_t)l * T * D, D, sclp};
            pg8::gemm_phase<pg8::EpiPle, pg8::StaticOrder, true, true>(lds, D, S, E, wave_s);
            SEAM_CAT(1);
        }
    }
    if (IN(N_PHASES - 1)) { PHASE_IDS();
#if EXP_MIXTIME
        { const unsigned long long* tw = (const unsigned long long*)(ws + WS_CTL + 2048); const float tot = (float)(tw[0] + tw[1] + tw[2] + tw[3]); if (bid == 0 && tid == 0) ((int*)(ws + WS_CTL))[64] = (int)(10.f * (float)tw[EXP_MIXTIME_CAT] / tot + 0.5f); }
        SEAM_CAT(5);
#endif
#if EXP_TIMING
        { const unsigned long long* tw = (const unsigned long long*)(ws + WS_CTL + 1024); const float tot = (float)(tw[1] + tw[2] + tw[3] + tw[4] + tw[5]); if (bid == 0 && tid == 0) ((int*)(ws + WS_CTL))[64] = (int)(50.f * (float)tw[1 + EXP_TIMING_CAT] / tot + 0.5f); }
        SEAM_CAT(5);
#endif
        final_phase(H, args.in[I_FINAL_NORM], args.out, lane, wave, bid, G, (const int*)(ws + WS_CTL) + 64); }
#undef IN
#undef SEAM
#undef SEAM_CAT
#undef PHASE_IDS
}
#undef H
#undef HN
#undef MIX
#undef PB
#undef PP
#undef XBUF
#undef YBUF
#undef DT
#undef SEL
#undef SLOT
#undef GATE
#undef CNT
#undef SEGB
#undef PROJ
#undef XBC
#undef OA
#undef YA
#undef ACT
#undef YS


extern "C" void kernel_launch(void* const* d_in, const int* in_sizes, int n_in, void* d_out, int out_size, void* d_ws, size_t ws_size, hipStream_t stream) {
    static int grid = 0;
    if (grid == 0) {
        if (n_in != N_IN || in_sizes[0] != T * D || out_size != T * D || ws_size < WS_END) { fprintf(stderr, "kernel_launch: unexpected problem (n_in %d, in0 %d, out %d, ws %zu < %zu); nothing launched\n", n_in, n_in > 0 ? in_sizes[0] : -1, out_size, ws_size, (size_t)WS_END); grid = -1; return; }
        int dev = 0, cus = 0, per_cu = 0;
        if (hipGetDevice(&dev) != hipSuccess || hipDeviceGetAttribute(&cus, hipDeviceAttributeMultiprocessorCount, dev) != hipSuccess) { fprintf(stderr, "kernel_launch: device query failed\n"); grid = -1; return; }
        if (hipFuncSetAttribute((const void*)fwd, hipFuncAttributeMaxDynamicSharedMemorySize, LDS_BYTES) != hipSuccess) { fprintf(stderr, "kernel_launch: hipFuncSetAttribute failed\n"); grid = -1; return; }
        if (hipOccupancyMaxActiveBlocksPerMultiprocessor(&per_cu, (const void*)fwd, NTHR, LDS_BYTES) != hipSuccess || per_cu < 1) { fprintf(stderr, "kernel_launch: occupancy query reports %d workgroups per CU\n", per_cu); (void)hipGetLastError(); per_cu = 1; }
        grid = cus;
    }
    if (grid < 0) return;
    if (hipMemsetAsync((char*)d_ws + WS_CTL, 0, CTL_ZERO_BYTES, stream) != hipSuccess) { fprintf(stderr, "kernel_launch: memset failed\n"); return; }
    Args a{};
    for (int i = 0; i < N_IN; ++i) a.in[i] = (const float*)d_in[i];
    a.out = (float*)d_out; a.ws = (unsigned char*)d_ws;
#if MK_ONE_LAUNCH
    a.ph_lo = 0; a.ph_hi = N_PHASES;
    hipLaunchKernelGGL(fwd, dim3(grid), dim3(NTHR), LDS_BYTES, stream, a);
    { const hipError_t le = hipPeekAtLastError(); if (le != hipSuccess) fprintf(stderr, "kernel_launch: launch failed: %s\n", hipGetErrorName(le)); }
#else
    for (int ph = 0; ph < N_PHASES; ++ph) {
        const int rel = ph - PH_LAYER0, l = rel >= 0 ? rel / PH_PER_LAYER : -1, slot = rel >= 0 ? rel % PH_PER_LAYER : -1;
        if (l >= 0 && l < DEPTH) { if ((l & 1) && slot == 8 && !(EXP_PROBE && l == EXP_PROBE_LAYER)) continue; }
        a.ph_lo = ph; a.ph_hi = ph + 1;
        hipLaunchKernelGGL(fwd, dim3(grid), dim3(NTHR), LDS_BYTES, stream, a);
        const hipError_t le = hipPeekAtLastError(); if (le != hipSuccess) { fprintf(stderr, "kernel_launch: launch of phase %d failed: %s\n", ph, hipGetErrorName(le)); break; }
    }
#endif
}
```
